# Optimizing an MI355X kernel written in HIP

```python
import jax
import jax.numpy as jnp
from jax import lax
import numpy as np

D_MODEL = 1024
BATCH = 2
SEQ = 8192
DEPTH = 2

MIX_HALF = D_MODEL // 2
GMLP_GROUPS = 4
GMLP_DIM = MIX_HALF // GMLP_GROUPS
GMLP_CHUNK = 128
HGRN_HEADS = 4
HGRN_DK = 128
HGRN_DV = MIX_HALF // HGRN_HEADS
HGRN_CHUNK = 32
A_WIDTH = GMLP_GROUPS * GMLP_DIM
B_KWIDTH = HGRN_HEADS * HGRN_DK
B_VWIDTH = HGRN_HEADS * HGRN_DV
MIX_SPLITS = (A_WIDTH, A_WIDTH, B_KWIDTH, B_KWIDTH, B_VWIDTH, B_VWIDTH)
MIX_IN = 2 * A_WIDTH + 2 * B_KWIDTH + 2 * B_VWIDTH
MIX_OUT = A_WIDTH + B_VWIDTH
RWKV_HEAD = 64
RWKV_HEADS = D_MODEL // RWKV_HEAD
RWKV_DECAY_LORA = 64
RWKV_AAA_LORA = 64
RWKV_GATE_LORA = 128
D_FF = ((8 * D_MODEL // 3 + 127) // 128) * 128
N_EXPERTS = 8
TOP_K = 2
D_FF_EXPERT = D_FF // 2
N_EVEN = (DEPTH + 1) // 2
N_ODD = DEPTH // 2
RMS_EPS = 1e-6
LN_EPS = 1e-5
GN_EPS = 64e-5
F32 = jnp.float32

kernel_name = 'hybrid_gmlp_hgrn2_rwkv7_moe'


def rms_norm(x, g):
    xf = x.astype(F32)
    y = xf * lax.rsqrt(jnp.mean(xf * xf, axis=-1, keepdims=True) + RMS_EPS)
    return (y * g.astype(F32)).astype(x.dtype)


def swiglu(h, w_gate, w_up, w_down):
    return (jax.nn.silu(h @ w_gate) * (h @ w_up)) @ w_down


def gmlp_spatial_gate(u, v, norm_g, w_s, b_s):
    bsz, t, g, c = v.shape
    n = t // GMLP_CHUNK
    vf = v.astype(F32)
    mu = jnp.mean(vf, axis=-1, keepdims=True)
    var = jnp.mean(jnp.square(vf - mu), axis=-1, keepdims=True)
    vn = ((vf - mu) * lax.rsqrt(var + LN_EPS) * norm_g.astype(F32)).reshape(bsz, n, GMLP_CHUNK, g, c)
    causal = jnp.tril(jnp.ones((GMLP_CHUNK, GMLP_CHUNK), dtype=bool))
    w = jnp.where(causal[None], w_s.astype(F32), 0.0)
    mixed = jnp.einsum('gts,bnsgc->bntgc', w, vn) + b_s.astype(F32).T[None, None, :, :, None]
    return u * mixed.reshape(bsz, t, g, c).astype(u.dtype)


def hgrn2_chunkwise(q, k, v, log_f):
    bsz, t, h, dk = q.shape
    dv = v.shape[-1]
    c = HGRN_CHUNK
    n = t // c
    q, k, log_f = (a.reshape(bsz, n, c, h, dk) for a in (q, k, log_f))
    v = v.reshape(bsz, n, c, h, dv)
    b = jnp.cumsum(log_f, axis=2)
    b_end = b[:, :, -1:]
    q_dec = q * jnp.exp(b)
    scores = jnp.einsum('bnthk,bnshk->bnhts', q_dec, k * jnp.exp(-b))
    causal = jnp.tril(jnp.ones((c, c), dtype=bool))
    scores = jnp.where(causal, scores, 0.0)
    o_intra = jnp.einsum('bnhts,bnshv->bnthv', scores, v)
    inc = jnp.einsum('bnshk,bnshv->nbhkv', k * jnp.exp(b_end - b), v)
    chunk_decay = jnp.exp(b_end[:, :, 0]).transpose(1, 0, 2, 3)

    def step(s, inp):
        d, ds = inp
        return d[..., None] * s + ds, s

    s0 = jnp.zeros((bsz, h, dk, dv), F32)
    _, s_start = lax.scan(step, s0, (chunk_decay, inc))
    o_inter = jnp.einsum('bnthk,nbhkv->bnthv', q_dec, s_start)
    return (o_intra + o_inter).reshape(bsz, t, h, dv)


def even_mixer(h, w_in, w_out, gmlp_norm_g, gmlp_w_s, gmlp_b_s, lb, onorm_g):
    bsz, t, _ = h.shape
    z = h @ w_in
    cuts = np.cumsum(MIX_SPLITS)[:-1].tolist()
    zu, zv, zq, zf, zi, zg = jnp.split(z, cuts, axis=-1)
    u = jax.nn.gelu(zu).reshape(bsz, t, GMLP_GROUPS, GMLP_DIM)
    v = jax.nn.gelu(zv).reshape(bsz, t, GMLP_GROUPS, GMLP_DIM)
    y_a = gmlp_spatial_gate(u, v, gmlp_norm_g, gmlp_w_s, gmlp_b_s).reshape(bsz, t, A_WIDTH)
    f = lb + (1.0 - lb) * jax.nn.sigmoid(zf.astype(F32))

    def heads(a, d):
        return a.reshape(bsz, t, HGRN_HEADS, d)

    o = hgrn2_chunkwise(heads(jax.nn.silu(zq.astype(F32)), HGRN_DK), heads(1.0 - f, HGRN_DK),
                        heads(zi.astype(F32), HGRN_DV), heads(jnp.log(f), HGRN_DK))
    o = o * lax.rsqrt(jnp.mean(o * o, axis=-1, keepdims=True) + RMS_EPS) * onorm_g.astype(F32)
    o = o * jax.nn.silu(heads(zg.astype(F32), HGRN_DV))
    y = jnp.concatenate([y_a, o.reshape(bsz, t, B_VWIDTH).astype(h.dtype)], axis=-1)
    return y @ w_out


def rwkv7_time_mix(h, mix, w_r, w_k, w_v, w_o, w0, w1, w2, a0, a1, a2, g1, g2,
                   k_k, k_a, r_k, ln_g, ln_b):
    bsz, t, d = h.shape
    nh, hs = RWKV_HEADS, RWKV_HEAD
    dx = jnp.pad(h[:, :-1], ((0, 0), (1, 0), (0, 0))) - h
    xr, xw, xk, xv, xa, xg = (h + dx * mix[i] for i in range(6))
    r = xr @ w_r
    k = xk @ w_k
    v = xv @ w_v
    w_log = -jax.nn.softplus(-(w0 + jnp.tanh(xw @ w1) @ w2)) - 0.5
    a = jax.nn.sigmoid(a0 + (xa @ a1) @ a2)
    g = jax.nn.sigmoid(xg @ g1) @ g2

    def heads(z):
        return z.astype(F32).reshape(bsz, t, nh, hs)

    kk = heads(k * k_k)
    kk = kk / jnp.maximum(jnp.sqrt(jnp.sum(kk * kk, axis=-1, keepdims=True)), 1e-12)
    k = heads(k * (1.0 + (a - 1.0) * k_a))
    r, v, a = heads(r), heads(v), heads(a)
    decay = jnp.exp(-jnp.exp(heads(w_log)))

    def tm(z):
        return jnp.swapaxes(z, 0, 1)

    def step(s, inp):
        r_t, w_t, k_t, v_t, kk_t, b_t = inp
        s = (s * w_t[:, :, None, :]
             - jnp.einsum('bhvk,bhk->bhv', s, kk_t)[..., None] * b_t[:, :, None, :]
             + v_t[..., None] * k_t[:, :, None, :])
        return s, jnp.einsum('bhvk,bhk->bhv', s, r_t)

    s0 = jnp.zeros((bsz, nh, hs, hs), F32)
    _, y = lax.scan(step, s0, (tm(r), tm(decay), tm(k), tm(v), tm(kk), tm(kk * a)))
    y = tm(y)
    mu = jnp.mean(y, axis=-1, keepdims=True)
    var = jnp.mean(jnp.square(y - mu), axis=-1, keepdims=True)
    y = (y - mu) * lax.rsqrt(var + GN_EPS) * ln_g.astype(F32).reshape(nh, hs) + ln_b.astype(F32).reshape(nh, hs)
    y = y + jnp.sum(r * k * r_k.astype(F32), axis=-1, keepdims=True) * v
    return (y.reshape(bsz, t, d).astype(h.dtype) * g) @ w_o


def moe_swiglu(h, router, router_b, w_gate, w_up, w_down):
    logits = (h @ router).astype(F32) + router_b.astype(F32)
    top_logit, top_idx = lax.top_k(logits, TOP_K)
    top_w = jax.nn.softmax(top_logit, axis=-1)
    gates = jnp.sum(jax.nn.one_hot(top_idx, N_EXPERTS, dtype=F32) * top_w[..., None], axis=-2)
    y = jnp.zeros_like(h)
    for e in range(N_EXPERTS):
        y = y + gates[..., e:e + 1].astype(h.dtype) * swiglu(h, w_gate[e], w_up[e], w_down[e])
    return y


def _normal(key, shape, scale):
    return scale * jax.random.normal(key, shape, F32)


def setup_inputs(seed: int = 0) -> dict:
    key = jax.random.key(seed)
    ks = jax.random.split(key, 40)
    D = D_MODEL
    inp = {}
    inp['x'] = jax.random.normal(ks[0], (BATCH, SEQ, D), F32)
    inp['norm_mix_g'] = 1.0 + _normal(ks[1], (DEPTH, D), 0.01)
    inp['norm_ffn_g'] = 1.0 + _normal(ks[2], (DEPTH, D), 0.01)
    inp['norm_out_g'] = 1.0 + _normal(ks[3], (D,), 0.01)
    inp['mix_w_in'] = _normal(ks[4], (N_EVEN, D, MIX_IN), D ** -0.5)
    inp['mix_w_out'] = _normal(ks[5], (N_EVEN, MIX_OUT, D), MIX_OUT ** -0.5)
    inp['gmlp_norm_g'] = 1.0 + _normal(ks[6], (N_EVEN, GMLP_GROUPS, GMLP_DIM), 0.01)
    inp['gmlp_w_s'] = _normal(ks[7], (N_EVEN, GMLP_GROUPS, GMLP_CHUNK, GMLP_CHUNK), GMLP_CHUNK ** -0.5)
    inp['gmlp_b_s'] = 1.0 + _normal(ks[8], (N_EVEN, GMLP_GROUPS, GMLP_CHUNK), 0.01)
    inp['hgrn_lb_logits'] = _normal(ks[9], (N_EVEN + 1, B_KWIDTH), 0.5)
    inp['hgrn_onorm_g'] = 1.0 + _normal(ks[10], (N_EVEN, HGRN_DV), 0.01)
    inp['ffn_w_gate'] = _normal(ks[11], (N_EVEN, D, D_FF), D ** -0.5)
    inp['ffn_w_up'] = _normal(ks[12], (N_EVEN, D, D_FF), D ** -0.5)
    inp['ffn_w_down'] = _normal(ks[13], (N_EVEN, D_FF, D), D_FF ** -0.5)
    inp['rwkv_mix'] = jax.random.uniform(ks[14], (N_ODD, 6, D), F32)
    inp['rwkv_w_r'] = _normal(ks[15], (N_ODD, D, D), D ** -0.5)
    inp['rwkv_w_k'] = _normal(ks[16], (N_ODD, D, D), D ** -0.5)
    inp['rwkv_w_v'] = _normal(ks[17], (N_ODD, D, D), D ** -0.5)
    inp['rwkv_w_o'] = _normal(ks[18], (N_ODD, D, D), D ** -0.5)
    inp['rwkv_w0'] = -1.0 + _normal(ks[19], (N_ODD, D), 0.5)
    inp['rwkv_w1'] = _normal(ks[20], (N_ODD, D, RWKV_DECAY_LORA), D ** -0.5)
    inp['rwkv_w2'] = _normal(ks[21], (N_ODD, RWKV_DECAY_LORA, D), 0.1 * RWKV_DECAY_LORA ** -0.5)
    inp['rwkv_a0'] = _normal(ks[22], (N_ODD, D), 0.1)
    inp['rwkv_a1'] = _normal(ks[23], (N_ODD, D, RWKV_AAA_LORA), D ** -0.5)
    inp['rwkv_a2'] = _normal(ks[24], (N_ODD, RWKV_AAA_LORA, D), 0.1 * RWKV_AAA_LORA ** -0.5)
    inp['rwkv_g1'] = _normal(ks[25], (N_ODD, D, RWKV_GATE_LORA), D ** -0.5)
    inp['rwkv_g2'] = _normal(ks[26], (N_ODD, RWKV_GATE_LORA, D), RWKV_GATE_LORA ** -0.5)
    inp['rwkv_k_k'] = 0.85 + _normal(ks[27], (N_ODD, D), 0.05)
    inp['rwkv_k_a'] = 1.0 + _normal(ks[28], (N_ODD, D), 0.05)
    inp['rwkv_r_k'] = _normal(ks[29], (N_ODD, RWKV_HEADS, RWKV_HEAD), 0.1)
    inp['rwkv_ln_g'] = 1.0 + _normal(ks[30], (N_ODD, D), 0.01)
    inp['rwkv_ln_b'] = _normal(ks[31], (N_ODD, D), 0.01)
    inp['moe_router'] = _normal(ks[32], (N_ODD, D, N_EXPERTS), D ** -0.5)
    inp['moe_router_b'] = _normal(ks[33], (N_ODD, N_EXPERTS), 0.01)
    inp['moe_w_gate'] = _normal(ks[34], (N_ODD, N_EXPERTS, D, D_FF_EXPERT), D ** -0.5)
    inp['moe_w_up'] = _normal(ks[35], (N_ODD, N_EXPERTS, D, D_FF_EXPERT), D ** -0.5)
    inp['moe_w_down'] = _normal(ks[36], (N_ODD, N_EXPERTS, D_FF_EXPERT, D), D_FF_EXPERT ** -0.5)
    return inp


def reference(x, norm_mix_g, norm_ffn_g, norm_out_g,
              mix_w_in, mix_w_out, gmlp_norm_g, gmlp_w_s, gmlp_b_s, hgrn_lb_logits, hgrn_onorm_g,
              ffn_w_gate, ffn_w_up, ffn_w_down,
              rwkv_mix, rwkv_w_r, rwkv_w_k, rwkv_w_v, rwkv_w_o, rwkv_w0, rwkv_w1, rwkv_w2,
              rwkv_a0, rwkv_a1, rwkv_a2, rwkv_g1, rwkv_g2, rwkv_k_k, rwkv_k_a, rwkv_r_k,
              rwkv_ln_g, rwkv_ln_b,
              moe_router, moe_router_b, moe_w_gate, moe_w_up, moe_w_down):
    lower_bounds = jnp.cumsum(jax.nn.softmax(hgrn_lb_logits.astype(F32), axis=0), axis=0)
    h = x
    for layer in range(DEPTH):
        j = layer // 2
        if layer % 2 == 0:
            h = h + even_mixer(rms_norm(h, norm_mix_g[layer]), mix_w_in[j], mix_w_out[j],
                               gmlp_norm_g[j], gmlp_w_s[j], gmlp_b_s[j], lower_bounds[j], hgrn_onorm_g[j])
            h = h + swiglu(rms_norm(h, norm_ffn_g[layer]), ffn_w_gate[j], ffn_w_up[j], ffn_w_down[j])
        else:
            h = h + rwkv7_time_mix(rms_norm(h, norm_mix_g[layer]), rwkv_mix[j], rwkv_w_r[j], rwkv_w_k[j],
                                   rwkv_w_v[j], rwkv_w_o[j], rwkv_w0[j], rwkv_w1[j], rwkv_w2[j],
                                   rwkv_a0[j], rwkv_a1[j], rwkv_a2[j], rwkv_g1[j], rwkv_g2[j],
                                   rwkv_k_k[j], rwkv_k_a[j], rwkv_r_k[j], rwkv_ln_g[j], rwkv_ln_b[j])
            h = h + moe_swiglu(rms_norm(h, norm_ffn_g[layer]), moe_router[j], moe_router_b[j],
                               moe_w_gate[j], moe_w_up[j], moe_w_down[j])
    return rms_norm(h, norm_out_g)
```

```cpp
#include <hip/hip_runtime.h>
#include <cstdio>
#include <cstdint>
#ifndef MK_N_LAUNCHES
#define MK_N_LAUNCHES 20
#endif
#ifndef MK_PH_HI
#define MK_PH_HI 20
#endif
namespace pg8 {
#define PG8_LAS __attribute__((address_space(3)))
typedef unsigned short bf16_t;
typedef short bf16x8 __attribute__((ext_vector_type(8)));
typedef float f32x4 __attribute__((ext_vector_type(4)));
typedef float f32x2 __attribute__((ext_vector_type(2)));
typedef unsigned u32x4 __attribute__((ext_vector_type(4)));
constexpr int BM = 256, BK = 64, HALF = 128, HTB = HALF * BK * 2, STAGE_BYTES = 8 * HTB, NXCD = 8, WGM = 8;

__host__ __device__ __forceinline__ int lds_byte(int r, int c) { const int st = (r >> 4) * 2 + (c >> 5), rr = r & 15, cc = c & 31, ob = rr * 64 + cc * 2; return st * 1024 + (ob ^ (((ob >> 9) & 1) << 5)); }
__host__ __device__ __forceinline__ void stage_rc(int b, int& R, int& C) { const int st = b / 1024, sb = b % 1024, swz = sb ^ (((sb >> 9) & 1) << 5); R = (st >> 1) * 16 + swz / 64; C = (st & 1) * 32 + (swz % 64) / 2; }
__host__ __device__ __forceinline__ int perm32(int rho) { const int n = rho >> 4, i = rho & 15; return 8 * (i >> 2) + 4 * n + (i & 3); }

struct Unit { int pm, pn; const char* A; const char* B; };

struct DenseOrder {
    int nM, nN, nwg, G, c; const char* A; const char* Bt; size_t tstep;
    __device__ void init(const void* A_, const void* Bt_, int M, int N, int K, int G_, int c_) { nM = M / BM; nN = N / BM; nwg = nM * nN; G = G_; c = c_; A = (const char*)A_; Bt = (const char*)Bt_; tstep = (size_t)BM * K * 2; }
    __device__ bool next(int i, Unit& u) const {
        const long L = (long)i * G + c; if (L >= nwg) return false;
        int wgid = (int)L; { const int q = nwg / NXCD, r = nwg % NXCD, xcd = wgid % NXCD, off = wgid / NXCD; wgid = (xcd < r ? xcd * (q + 1) : r * (q + 1) + (xcd - r) * q) + off; }
        const int nig = WGM * nN, gid = wgid / nig, fm = gid * WGM, gsz = (nM - fm) < WGM ? (nM - fm) : WGM;
        u.pm = fm + ((wgid % nig) % gsz); u.pn = (wgid % nig) / gsz;
        u.A = A + (size_t)u.pm * tstep; u.B = Bt + (size_t)u.pn * tstep; return true;
    }
};
struct MoeOrder {
    int ntiles, nN, nwg, G, c; int toff[9]; const char* A; const char* Bt; size_t tstep, estride;
    __device__ bool next(int i, Unit& u) const {
        const long L = (long)i * G + c; if (L >= nwg) return false;
        const int rt = (int)(L % ntiles), pn = (int)(L / ntiles);
        int e = 0;
#pragma unroll
        for (int j = 1; j < 8; ++j) e += (rt >= toff[j]) ? 1 : 0;
        u.pm = rt; u.pn = pn; u.A = A + (size_t)rt * tstep; u.B = Bt + (size_t)e * estride + (size_t)pn * tstep; return true;
    }
};

typedef __bf16 bf16x2_t __attribute__((ext_vector_type(2)));
__device__ __forceinline__ unsigned cvt_pk_bf16(float lo, float hi) { f32x2 v = {lo, hi}; bf16x2_t b = __builtin_convertvector(v, bf16x2_t); return __builtin_bit_cast(unsigned, b); }

template <class Epi, class Sched>
__device__ __forceinline__ void gemm_phase(PG8_LAS unsigned char* lds, const int K, const Sched& S, const Epi& E) {
    const int tid = threadIdx.x, wid = __builtin_amdgcn_readfirstlane(tid >> 6), lane = tid & 63, wr = wid >> 2, wc = wid & 3, fr = lane & 15, fq = lane >> 4;
    const int nt = K / BK;
    unsigned voffA[2], voffB[2];
#pragma unroll
    for (int i = 0; i < 2; ++i) { int R, C; stage_rc(tid * 16 + i * 8192, R, C); const int Rb = Epi::PERM ? ((R & ~31) + perm32(R & 31)) : R;
        voffA[i] = (unsigned)(R * K + C) * 2u; voffB[i] = (unsigned)(Rb * K + C) * 2u; }
    const size_t kstep = (size_t)(BK * 2);
    const size_t hstep = (size_t)HALF * K * 2;
    const unsigned ldsw = (unsigned)wid * 1024u;
    const int aoff = lds_byte(wr * 64 + fr, fq * 8), boff = lds_byte(wc * 32 + fr, fq * 8);
#define PG8_SA(b, h) (((b) * 2 + (h)) * HTB)
#define PG8_SB(b, h) ((4 + (b) * 2 + (h)) * HTB)
#define PG8_STAGE(bufoff, gbase, voff) do { _Pragma("unroll") for (int _i = 0; _i < 2; ++_i) \
        __builtin_amdgcn_global_load_lds((const unsigned*)((const char*)(gbase) + (voff)[_i]), (PG8_LAS unsigned*)(lds + (bufoff) + ldsw + _i * 8192), 16, 0, 0); } while (0)
#define PG8_LDA(dst, b, h) do { _Pragma("unroll") for (int m = 0; m < 4; ++m) _Pragma("unroll") for (int k = 0; k < 2; ++k) dst[m][k] = *(const PG8_LAS bf16x8*)(lds + PG8_SA(b, h) + aoff + m * 2048 + k * 1024); } while (0)
#define PG8_LDB(dst, b, h) do { _Pragma("unroll") for (int n = 0; n < 2; ++n) _Pragma("unroll") for (int k = 0; k < 2; ++k) dst[n][k] = *(const PG8_LAS bf16x8*)(lds + PG8_SB(b, h) + boff + n * 2048 + k * 1024); } while (0)
#define PG8_MMA(ai, bj, At, Bt) do { __builtin_amdgcn_s_setprio(1); _Pragma("unroll") for (int m = 0; m < 4; ++m) _Pragma("unroll") for (int n = 0; n < 2; ++n) _Pragma("unroll") for (int k = 0; k < 2; ++k) \
        acc[ai][bj][m][n] = __builtin_amdgcn_mfma_f32_16x16x32_bf16(Bt[n][k], At[m][k], acc[ai][bj][m][n], 0, 0, 0); __builtin_amdgcn_s_setprio(0); } while (0)
#define PG8_WAIT_V(n) asm volatile("s_waitcnt vmcnt(" #n ")" ::: "memory")
#define PG8_WAIT_L(n) asm volatile("s_waitcnt lgkmcnt(" #n ")" ::: "memory")
#define PG8_BAR __builtin_amdgcn_s_barrier()
#define PG8_SCHED __builtin_amdgcn_sched_barrier(0)
    Unit cur, nxt; int ui = 0;
    if (!S.next(0, cur)) return;
    f32x4 acc[2][2][4][2];
#pragma unroll
    for (int a = 0; a < 2; ++a)
#pragma unroll
        for (int b = 0; b < 2; ++b)
#pragma unroll
            for (int m = 0; m < 4; ++m)
#pragma unroll
                for (int n = 0; n < 2; ++n) acc[a][b][m][n] = (f32x4){0.f, 0.f, 0.f, 0.f};
    bf16x8 At[4][2], B0[2][2], B1[2][2];
    const char* cA = cur.A; const char* cB = cur.B;
    PG8_STAGE(PG8_SB(0, 0), cB, voffB); PG8_STAGE(PG8_SB(0, 1), cB + hstep, voffB); PG8_STAGE(PG8_SA(0, 0), cA, voffA); PG8_STAGE(PG8_SA(0, 1), cA + hstep, voffA);
    if (wr == 1) PG8_BAR;
    PG8_WAIT_V(2); PG8_BAR;
    PG8_STAGE(PG8_SB(1, 0), cB + kstep, voffB); PG8_STAGE(PG8_SA(1, 0), cA + kstep, voffA); PG8_STAGE(PG8_SB(1, 1), cB + hstep + kstep, voffB);
    PG8_WAIT_V(6); PG8_BAR;
    for (;;) {
        const bool has_next = S.next(ui + 1, nxt);
        const char* nA = has_next ? nxt.A : cA; const char* nB = has_next ? nxt.B : cB;
        for (int t = 0; t < nt; t += 2) {
            const bool last = (t == nt - 2);
            const char* a1 = cA + (size_t)(t + 1) * kstep;
            const char* a2 = last ? nA : cA + (size_t)(t + 2) * kstep; const char* b2 = last ? nB : cB + (size_t)(t + 2) * kstep;
            const char* a3 = a2 + kstep; const char* b3 = b2 + kstep;
            PG8_LDB(B0, 0, 0); PG8_LDB(B1, 0, 1); PG8_SCHED; PG8_LDA(At, 0, 0); PG8_STAGE(PG8_SA(1, 1), a1 + hstep, voffA);
            PG8_WAIT_V(8); PG8_WAIT_L(0); PG8_BAR; PG8_MMA(0, 0, At, B0); PG8_MMA(0, 1, At, B1); PG8_BAR; PG8_SCHED;
            PG8_LDA(At, 0, 1); PG8_STAGE(PG8_SB(0, 0), b2, voffB); PG8_STAGE(PG8_SB(0, 1), b2 + hstep, voffB); PG8_STAGE(PG8_SA(0, 0), a2, voffA);
            PG8_WAIT_V(8); PG8_WAIT_L(0); PG8_BAR; PG8_MMA(1, 0, At, B0); PG8_MMA(1, 1, At, B1); PG8_BAR; PG8_SCHED;
            PG8_LDB(B0, 1, 0); PG8_LDB(B1, 1, 1); PG8_SCHED; PG8_LDA(At, 1, 0); PG8_STAGE(PG8_SA(0, 1), a2 + hstep, voffA);
            PG8_WAIT_V(8); PG8_WAIT_L(0); PG8_BAR; PG8_MMA(0, 0, At, B0); PG8_MMA(0, 1, At, B1); PG8_BAR; PG8_SCHED;
            PG8_LDA(At, 1, 1); PG8_STAGE(PG8_SB(1, 0), b3, voffB); PG8_STAGE(PG8_SB(1, 1), b3 + hstep, voffB); PG8_STAGE(PG8_SA(1, 0), a3, voffA);
            PG8_WAIT_V(8); PG8_WAIT_L(0); PG8_BAR; PG8_MMA(1, 0, At, B0); PG8_MMA(1, 1, At, B1); PG8_BAR; PG8_SCHED;
        }
        if (wr == 0) PG8_BAR;
        E(acc, cur, wr, wc, fr, fq);
        if (!has_next) break;
#pragma unroll
        for (int a = 0; a < 2; ++a)
#pragma unroll
            for (int b = 0; b < 2; ++b)
#pragma unroll
                for (int m = 0; m < 4; ++m)
#pragma unroll
                    for (int n = 0; n < 2; ++n) acc[a][b][m][n] = (f32x4){0.f, 0.f, 0.f, 0.f};
        cur = nxt; cA = nA; cB = nB; ++ui;
        if (wr == 1) PG8_BAR;
    }
    PG8_WAIT_V(0);
    PG8_BAR;
#undef PG8_SA
#undef PG8_SB
#undef PG8_STAGE
#undef PG8_LDA
#undef PG8_LDB
#undef PG8_MMA
#undef PG8_WAIT_V
#undef PG8_WAIT_L
#undef PG8_BAR
#undef PG8_SCHED
}
}
#define GAS __attribute__((address_space(1)))
#define LAS __attribute__((address_space(3)))
typedef unsigned short bf16;
typedef unsigned v4u __attribute__((ext_vector_type(4)));
typedef unsigned v2u __attribute__((ext_vector_type(2)));
typedef float f32x4 __attribute__((ext_vector_type(4)));
typedef float f32x2 __attribute__((ext_vector_type(2)));
typedef short bf16x8 __attribute__((ext_vector_type(8)));
typedef short bf16x4 __attribute__((ext_vector_type(4)));
typedef GAS unsigned gu32;
#define RLX_AGENT __ATOMIC_RELAXED, __HIP_MEMORY_SCOPE_AGENT
#define LDS_WAIT() asm volatile("s_waitcnt lgkmcnt(0)" ::: "memory")
#define VM_WAIT() asm volatile("s_waitcnt vmcnt(0)" ::: "memory")
__device__ __forceinline__ unsigned f2bf(float f) { return pg8::cvt_pk_bf16(f, 0.f) & 0xffffu; }
__device__ __forceinline__ unsigned pk2(float lo, float hi) { return pg8::cvt_pk_bf16(lo, hi); }
__device__ __forceinline__ float bf2f(unsigned h) { return __builtin_bit_cast(float, h << 16); }
__device__ __forceinline__ float bflo(unsigned w) { return __builtin_bit_cast(float, w << 16); }
__device__ __forceinline__ float bfhi(unsigned w) { return __builtin_bit_cast(float, w & 0xffff0000u); }
__device__ __forceinline__ float fexp(float x) { return __builtin_amdgcn_exp2f(x * 1.4426950408889634f); }
__device__ __forceinline__ float frcp(float x) { return __builtin_amdgcn_rcpf(x); }
__device__ __forceinline__ float fsigmoid(float x) { return frcp(1.f + fexp(-x)); }
__device__ __forceinline__ float fsilu(float x) { return x * fsigmoid(x); }
__device__ __forceinline__ float ftanh(float x) { const float e = fexp(2.f * x); return 1.f - 2.f * frcp(e + 1.f); }
__device__ __forceinline__ float fgelu_tanh(float x) { const float u = 0.7978845608028654f * (x + 0.044715f * x * x * x); return 0.5f * x * (1.f + ftanh(u)); }
__device__ __forceinline__ float wave_sum(float v) {
#pragma unroll
    for (int o = 1; o < 64; o <<= 1) v += __shfl_xor(v, o);
    return v;
}

#define XB_TMO      128
#define XB_XCNT(j)  (256  + 64 * (j))
#define XB_XSUB(j)  (1280 + 64 * (j))
#define XB_XGEN(j)  (2304 + 64 * (j))
#define XB_TOP      3328
#define XB_TOPGEN   3392
#define XCD_BAR_WORDS 3456
#define XB_SPIN_CAP (1u << 22)
__device__ __forceinline__ unsigned xb_ld(unsigned* p)              { return __hip_atomic_load(p, __ATOMIC_RELAXED, __HIP_MEMORY_SCOPE_AGENT); }
__device__ __forceinline__ unsigned xb_add(unsigned* p, unsigned v) { return __hip_atomic_fetch_add(p, v, __ATOMIC_RELAXED, __HIP_MEMORY_SCOPE_AGENT); }
__device__ __forceinline__ unsigned xb_xcc_id() { return (unsigned)__builtin_amdgcn_s_getreg((3 << 11) | 20) & 0xFu; }
#define XB_SPIN(cond, bar) do { unsigned _sp = 0; while (cond) { __builtin_amdgcn_s_sleep(1); \
    if ((++_sp & 255u) == 0u) { if (xb_ld(&(bar)[XB_TMO])) break; if (_sp > XB_SPIN_CAP) { atomicAdd(&(bar)[XB_TMO], 1u); break; } } } } while (0)
struct XcdBarrier { unsigned* bar; unsigned x; volatile LAS unsigned* st; };
__device__ __forceinline__ XcdBarrier xcd_barrier_post(unsigned* bar, volatile LAS unsigned* st) {
    XcdBarrier b; b.bar = bar; b.x = xb_xcc_id(); b.st = st;
    if (threadIdx.x == 0) (void)xb_add(&bar[XB_XCNT(b.x)], 1u);
    return b;
}
__device__ __forceinline__ void xcd_barrier_complete(unsigned* bar, unsigned x, unsigned& nloc, unsigned& nx) {
    const unsigned G = gridDim.x * gridDim.y * gridDim.z;
    unsigned sum, cnt, mine, sp = 0u;
    for (;;) {
        sum = 0u; cnt = 0u; mine = 0u;
#pragma unroll
        for (unsigned j = 0; j < 16; ++j) { const unsigned c = xb_ld(&bar[XB_XCNT(j)]); sum += c; cnt += (c > 0u) ? 1u : 0u; mine = (j == x) ? c : mine; }
        if (sum == G) break;
        __builtin_amdgcn_s_sleep(1);
        if ((++sp & 255u) == 0u) { if (xb_ld(&bar[XB_TMO])) break; if (sp > XB_SPIN_CAP) { atomicAdd(&bar[XB_TMO], 1u); break; } }
    }
    nloc = mine > 0u ? mine : 1u; nx = cnt > 0u ? cnt : 1u;
}
__device__ __forceinline__ void xcd_barrier(const XcdBarrier& b) {
    asm volatile("s_waitcnt vmcnt(0)" ::: "memory");
    __syncthreads();
    if (threadIdx.x == 0) {
        unsigned* bar = b.bar;
        __builtin_amdgcn_s_waitcnt(0);
        unsigned nloc = b.st[0], nx = b.st[1];
        if (nloc == 0u) { xcd_barrier_complete(bar, b.x, nloc, nx); b.st[0] = nloc; b.st[1] = nx; }
        const unsigned old = xb_add(&bar[XB_XSUB(b.x)], 1u);
        const unsigned gen = old / nloc;
        if (old + 1u == (gen + 1u) * nloc) {
            __builtin_amdgcn_fence(__ATOMIC_RELEASE, "agent");
            asm volatile("s_waitcnt vmcnt(0)" ::: "memory");
            const unsigned og = xb_add(&bar[XB_TOP], 1u);
            const unsigned tg = og / nx;
            if (og + 1u == (tg + 1u) * nx) xb_add(&bar[XB_TOPGEN], 1u);
            else XB_SPIN(xb_ld(&bar[XB_TOPGEN]) == tg, bar);
            __builtin_amdgcn_fence(__ATOMIC_ACQUIRE, "agent");
            xb_add(&bar[XB_XGEN(b.x)], 1u);
            asm volatile("s_waitcnt vmcnt(0)" ::: "memory");
        } else {
            XB_SPIN(xb_ld(&bar[XB_XGEN(b.x)]) == gen, bar);
            __builtin_amdgcn_fence(__ATOMIC_ACQUIRE, "agent");
            asm volatile("s_waitcnt vmcnt(0)" ::: "memory");
        }
    }
    __syncthreads();
}

template <int KSTEPS>
__device__ __forceinline__ f32x4 mm_tile(const LAS bf16* Am, int lda, const LAS bf16* Bn, int ldb, int m0, int n0, f32x4 acc, int fr, int fq) {
    const LAS bf16* ap = Am + (m0 + fr) * lda + fq * 8;
    const LAS bf16* bp = Bn + (n0 + fr) * ldb + fq * 8;
#pragma unroll
    for (int ks = 0; ks < KSTEPS; ++ks) {
        const bf16x8 a = *(const LAS bf16x8*)(ap + ks * 32);
        const bf16x8 b = *(const LAS bf16x8*)(bp + ks * 32);
        acc = __builtin_amdgcn_mfma_f32_16x16x32_bf16(b, a, acc, 0, 0, 0);
    }
    return acc;
}
__device__ __forceinline__ v2u pk4(f32x4 v) { v2u r; r.x = pk2(v[0], v[1]); r.y = pk2(v[2], v[3]); return r; }
constexpr int NWAVES = 8, NTHREADS = 512;
constexpr int BATCH = 2, T = 8192, D = 1024, M = BATCH * T;
constexpr int MIX_IN = 3072, DFF = 2816, NEXP = 8, DFE = 1408, NH = 16, HS = 64;
constexpr int NRW = 3328;
constexpr int XG_ROWS = 34816;
constexpr float RMS_EPS = 1e-6f, LN_EPS = 1e-5f, GN_EPS = 64e-5f;
constexpr size_t MiB = 1u << 20, KiB = 1024;
constexpr size_t WS_CTL = 0, CTL_ZERO_BYTES = 1 * MiB;
constexpr size_t WS_WSM = 1 * MiB;
constexpr size_t WS_LB = 1 * MiB + 128 * KiB;
constexpr size_t WS_WIN = 2 * MiB, WS_WOUT = 8 * MiB, WS_WGU = 10 * MiB, WS_WD = 21 * MiB, WS_WR = 26 * MiB + 512 * KiB, WS_WO = 39 * MiB + 512 * KiB, WS_W2T = 41 * MiB + 512 * KiB;
constexpr size_t WS_XN = 42 * MiB;
constexpr size_t WS_Z = 74 * MiB;
constexpr size_t WS_HGI = 170 * MiB, WS_HGS = 202 * MiB, WS_HGD = 234 * MiB;
constexpr size_t WS_HF = 74 * MiB;
constexpr size_t WS_A2 = 42 * MiB;
constexpr size_t WS_R = 106 * MiB, WS_K = 138 * MiB, WS_V = 170 * MiB, WS_LR = 202 * MiB, WS_RKS = 210 * MiB, WS_S0 = 211 * MiB;
constexpr size_t WS_OMT = 42 * MiB, WS_YL = 74 * MiB;
constexpr size_t WS_WEGU = 2 * MiB, WS_WED = 46 * MiB, WS_XG = 68 * MiB, WS_HE = 136 * MiB, WS_XN3 = 136 * MiB, WS_ROUTE = 240 * MiB;
constexpr size_t WS_END = 256 * MiB;
constexpr size_t RT_E = 0, RT_POS = 128 * KiB, RT_W = 256 * KiB, RT_SLOT = 384 * KiB, RT_SLOTW = 512 * KiB;
constexpr int CW_BAR = 4096;
constexpr int CW_CNT = 64;
constexpr int LDS_BYTES = 155648, MISC_OFF = 153600;
struct Frame {
    LAS unsigned char* lds;
    int tid, lane, wave, vcu, G;
    const float* in[37];
    float* out;
    unsigned char* ws;
};
template <class Tp> __device__ __forceinline__ Tp* wsp(const Frame& F, size_t off) { return (Tp*)(F.ws + off); }

enum { I_X = 0, I_NMG, I_NFG, I_NOG, I_WIN, I_WOUT, I_GNG, I_GWS, I_GBS, I_LBL, I_ONG, I_FG, I_FU, I_FD,
       I_RMIX, I_RWR, I_RWK, I_RWV, I_RWO, I_RW0, I_RW1, I_RW2, I_RA0, I_RA1, I_RA2, I_RG1, I_RG2, I_RKK, I_RKA, I_RRK, I_RLG, I_RLB,
       I_MR, I_MRB, I_MG, I_MU, I_MD };

struct Job { const float* src; int K, N; bf16* dst; int ldd, rowbase, kofs; const float* scale; int ilv; };
__device__ __forceinline__ int job_items(const Job& j) { return (j.K / 64) * (j.N / 32); }
__device__ __forceinline__ void conv_item(const Job& J, int item, LAS float* scr, int lane) {
    const int nblk = J.N / 32, kb = item / nblk, nb = item % nblk, k0 = 64 * kb, n0 = 32 * nb;
    const int drow0 = J.ilv ? ((n0 >> 7) * 256 + (J.ilv - 1) * 128 + (n0 & 127)) : (J.rowbase + n0);
#pragma unroll 8
    for (int i = 0; i < 32; ++i) { const int kk = 2 * i + (lane >> 5); float v = J.src[(size_t)(k0 + kk) * J.N + n0 + (lane & 31)]; if (J.scale) v *= J.scale[k0 + kk]; scr[kk * 33 + (lane & 31)] = v; }
    LDS_WAIT(); asm volatile("" ::: "memory");
    const int c = lane & 7;
#pragma unroll
    for (int j = 0; j < 4; ++j) { const int n = (lane >> 3) + 8 * j; const LAS float* s = scr + (8 * c) * 33 + n;
        v4u o; o.x = pk2(s[0 * 33], s[1 * 33]); o.y = pk2(s[2 * 33], s[3 * 33]); o.z = pk2(s[4 * 33], s[5 * 33]); o.w = pk2(s[6 * 33], s[7 * 33]);
        *(v4u*)(J.dst + (size_t)(drow0 + n) * J.ldd + J.kofs + k0 + 8 * c) = o; }
    LDS_WAIT(); asm volatile("" ::: "memory");
}
__device__ __forceinline__ Job p0_job(const Frame& F, int j) {
    Job J; J.scale = nullptr; J.ilv = 0; J.rowbase = 0; J.kofs = 0;
    const float* mix = F.in[I_RMIX];
    switch (j) {
    case 0: J.src = F.in[I_WIN]; J.K = 1024; J.N = 3072; J.dst = wsp<bf16>(F, WS_WIN); J.ldd = 1024; break;
    case 1: J.src = F.in[I_WOUT]; J.K = 1024; J.N = 1024; J.dst = wsp<bf16>(F, WS_WOUT); J.ldd = 1024; break;
    case 2: J.src = F.in[I_FG]; J.K = 1024; J.N = DFF; J.dst = wsp<bf16>(F, WS_WGU); J.ldd = 1024; J.ilv = 1; break;
    case 3: J.src = F.in[I_FU]; J.K = 1024; J.N = DFF; J.dst = wsp<bf16>(F, WS_WGU); J.ldd = 1024; J.ilv = 2; break;
    case 4: J.src = F.in[I_FD]; J.K = DFF; J.N = 1024; J.dst = wsp<bf16>(F, WS_WD); J.ldd = DFF; break;
    case 5: J.src = F.in[I_RWO]; J.K = 1024; J.N = 1024; J.dst = wsp<bf16>(F, WS_WO); J.ldd = 1024; break;
    case 6: J.src = F.in[I_RW2]; J.K = 64; J.N = 1024; J.dst = wsp<bf16>(F, WS_W2T); J.ldd = 64; break;
    case 7: J.src = F.in[I_RA2]; J.K = 64; J.N = 1024; J.dst = wsp<bf16>(F, WS_W2T) + 1024 * 64; J.ldd = 64; break;
    case 8: J.src = F.in[I_RG2]; J.K = 128; J.N = 1024; J.dst = wsp<bf16>(F, WS_W2T) + 2 * 1024 * 64; J.ldd = 128; break;
    default: {
        const int q = (j - 9) >> 1, sc = (j - 9) & 1;
        J.K = 1024; J.dst = wsp<bf16>(F, WS_WR); J.ldd = 2048; J.kofs = sc ? 1024 : 0;
        if (q == 0) { J.src = F.in[I_RWR]; J.N = 1024; J.rowbase = 0; if (sc) J.scale = mix + 0 * 1024; }
        else if (q == 1) { J.src = F.in[I_RWK]; J.N = 1024; J.rowbase = 1024; if (sc) J.scale = mix + 2 * 1024; }
        else if (q == 2) { J.src = F.in[I_RWV]; J.N = 1024; J.rowbase = 2048; if (sc) J.scale = mix + 3 * 1024; }
        else if (q == 3) { J.src = F.in[I_RW1]; J.N = 64; J.rowbase = 3072; if (sc) J.scale = mix + 1 * 1024; }
        else if (q == 4) { J.src = F.in[I_RA1]; J.N = 64; J.rowbase = 3136; if (sc) J.scale = mix + 4 * 1024; }
        else { J.src = F.in[I_RG1]; J.N = 128; J.rowbase = 3200; if (sc) J.scale = mix + 5 * 1024; }
    } }
    return J;
}
constexpr int P0_NJOBS = 21;
__device__ __forceinline__ Job moe_job(const Frame& F, int j) {
    Job J; J.scale = nullptr; J.rowbase = 0; J.kofs = 0; J.ilv = 0;
    const int e = j / 3, w = j % 3;
    if (w < 2) { J.src = F.in[w == 0 ? I_MG : I_MU] + (size_t)e * 1024 * DFE; J.K = 1024; J.N = DFE; J.dst = wsp<bf16>(F, WS_WEGU) + (size_t)e * 2 * DFE * 1024; J.ldd = 1024; J.ilv = w + 1; }
    else { J.src = F.in[I_MD] + (size_t)e * DFE * 1024; J.K = DFE; J.N = 1024; J.dst = wsp<bf16>(F, WS_WED) + (size_t)e * 1024 * DFE; J.ldd = DFE; }
    return J;
}
__device__ __forceinline__ void rms_row(const float* xrow, const float* g, int lane, f32x4 (&v)[4]) {
    const f32x4* xr = (const f32x4*)xrow + lane; float s = 0.f;
#pragma unroll
    for (int j = 0; j < 4; ++j) { v[j] = xr[64 * j]; s += (v[j].x * v[j].x + v[j].y * v[j].y) + (v[j].z * v[j].z + v[j].w * v[j].w); }
    const float rs = 1.f / sqrtf(wave_sum(s) * (1.f / D) + RMS_EPS);
    const f32x4* gr = (const f32x4*)g + lane;
#pragma unroll
    for (int j = 0; j < 4; ++j) v[j] = v[j] * rs * gr[64 * j];
}
__device__ __forceinline__ void store_row_bf16(bf16* orow, int lane, const f32x4 (&v)[4]) {
    v2u* o8 = (v2u*)orow + lane;
#pragma unroll
    for (int j = 0; j < 4; ++j) o8[64 * j] = pk4(v[j]);
}
__device__ __forceinline__ void run_jobs(const Frame& F, bool moe) {
    LAS float* scr = (LAS float*)(F.lds + F.wave * 16384);
    const int gw = F.vcu * NWAVES + F.wave, NGW = F.G * NWAVES;
    const int njobs = moe ? 24 : P0_NJOBS;
    int base = 0;
    for (int j = 0; j < njobs; ++j) {
        const Job J = moe ? moe_job(F, j) : p0_job(F, j);
        const int n = job_items(J);
        int it = (gw - base % NGW + NGW) % NGW;
        for (; it < n; it += NGW) conv_item(J, it, scr, F.lane);
        base += n;
    }
}
__device__ __forceinline__ void p0_prologue(const Frame& F) {
    run_jobs(F, false);
    const int gt = F.vcu * NTHREADS + F.tid, NGT = F.G * NTHREADS;
    { const float* ws = F.in[I_GWS]; bf16* o = wsp<bf16>(F, WS_WSM);
      for (int i = gt; i < 4 * 128 * 128; i += NGT) { const int t = (i >> 7) & 127, s = i & 127; o[i] = (bf16)f2bf(s <= t ? ws[i] : 0.f); } }
    { const float* l = F.in[I_LBL]; float* o = wsp<float>(F, WS_LB);
      for (int i = gt; i < 512; i += NGT) { const float a = l[i], b = l[512 + i], mx = fmaxf(a, b), ea = expf(a - mx), eb = expf(b - mx); o[i] = ea / (ea + eb); } }
    const int gw = F.vcu * NWAVES + F.wave, NGW = F.G * NWAVES;
    bf16* XN = wsp<bf16>(F, WS_XN);
    for (int m = gw; m < M; m += NGW) { f32x4 v[4]; rms_row(F.in[I_X] + (size_t)m * D, F.in[I_NMG], F.lane, v); store_row_bf16(XN + (size_t)m * D, F.lane, v); }
}
namespace epi {
using pg8::Unit; using pg8::HALF; using pg8::BM;
typedef float f32x4 __attribute__((ext_vector_type(4)));
struct MixIn {
    static constexpr bool PERM = true;
    bf16* Z; const float* lb;
    __device__ __forceinline__ void operator()(const f32x4 (&acc)[2][2][4][2], const Unit& u, int wr, int wc, int fr, int fq) const {
        const int seg = u.pn >> 1;
        const int row0 = u.pm * BM + wr * 64 + fr, col0 = u.pn * BM + wc * 32 + 8 * fq;
#pragma unroll
        for (int ai = 0; ai < 2; ++ai)
#pragma unroll
            for (int m = 0; m < 4; ++m) { bf16* rowp = Z + (size_t)(row0 + ai * HALF + m * 16) * MIX_IN + col0;
#pragma unroll
                for (int bj = 0; bj < 2; ++bj) { float v[8];
#pragma unroll
                    for (int i = 0; i < 4; ++i) { v[i] = acc[ai][bj][m][0][i]; v[4 + i] = acc[ai][bj][m][1][i]; }
                    if (seg < 2) {
#pragma unroll
                        for (int i = 0; i < 8; ++i) v[i] = fgelu_tanh(v[i]);
                    } else if (seg == 2 || seg == 5) {
#pragma unroll
                        for (int i = 0; i < 8; ++i) v[i] = fsilu(v[i]);
                    } else if (seg == 3) {
                        const float* lbp = lb + (col0 + bj * HALF - 1536);
#pragma unroll
                        for (int i = 0; i < 8; ++i) { const float l = lbp[i]; v[i] = __logf(l + (1.f - l) * fsigmoid(v[i])); }
                    }
                    v4u w; w.x = pk2(v[0], v[1]); w.y = pk2(v[2], v[3]); w.z = pk2(v[4], v[5]); w.w = pk2(v[6], v[7]);
                    *(v4u*)(rowp + bj * HALF) = w; } }
    }
};
struct Resid {
    static constexpr bool PERM = false;
    const float* base; float* out;
    __device__ __forceinline__ void operator()(const f32x4 (&acc)[2][2][4][2], const Unit& u, int wr, int wc, int fr, int fq) const {
        const int row0 = u.pm * BM + wr * 64 + fr, col0 = u.pn * BM + wc * 32 + 4 * fq;
#pragma unroll
        for (int ai = 0; ai < 2; ++ai)
#pragma unroll
            for (int m = 0; m < 4; ++m) { const size_t off = (size_t)(row0 + ai * HALF + m * 16) * D + col0;
#pragma unroll
                for (int bj = 0; bj < 2; ++bj)
#pragma unroll
                    for (int n = 0; n < 2; ++n) { const size_t p = off + bj * HALF + n * 16; const f32x4 b = *(const f32x4*)(base + p); *(f32x4*)(out + p) = b + acc[ai][bj][m][n]; } }
    }
};
struct SwiGlu {
    static constexpr bool PERM = true;
    bf16* H; int ld; const float* rowscale;
    __device__ __forceinline__ void operator()(const f32x4 (&acc)[2][2][4][2], const Unit& u, int wr, int wc, int fr, int fq) const {
        const int row0 = u.pm * BM + wr * 64 + fr, col0 = u.pn * HALF + wc * 32 + 8 * fq;
#pragma unroll
        for (int ai = 0; ai < 2; ++ai)
#pragma unroll
            for (int m = 0; m < 4; ++m) { const int row = row0 + ai * HALF + m * 16; const float sc = rowscale ? rowscale[row] : 1.f; float v[8];
#pragma unroll
                for (int i = 0; i < 4; ++i) { v[i] = fsilu(acc[ai][0][m][0][i]) * acc[ai][1][m][0][i] * sc; v[4 + i] = fsilu(acc[ai][0][m][1][i]) * acc[ai][1][m][1][i] * sc; }
                v4u w; w.x = pk2(v[0], v[1]); w.y = pk2(v[2], v[3]); w.z = pk2(v[4], v[5]); w.w = pk2(v[6], v[7]);
                *(v4u*)(H + (size_t)row * ld + col0) = w; }
    }
};
struct RwkvProj {
    static constexpr bool PERM = true;
    bf16* R; size_t split_stride; bf16* LR;
    __device__ __forceinline__ void operator()(const f32x4 (&acc)[2][2][4][2], const Unit& u, int wr, int wc, int fr, int fq) const {
        const int row0 = u.pm * BM + wr * 64 + fr;
        const bool lora = (u.pn == 12);
        bf16* base = lora ? LR : (R + (size_t)(u.pn >> 2) * split_stride);
        const int ld = lora ? 256 : D;
        const int col0 = (lora ? 0 : (u.pn & 3) * BM) + wc * 32 + 8 * fq;
#pragma unroll
        for (int ai = 0; ai < 2; ++ai)
#pragma unroll
            for (int m = 0; m < 4; ++m) { bf16* rowp = base + (size_t)(row0 + ai * HALF + m * 16) * ld + col0;
#pragma unroll
                for (int bj = 0; bj < 2; ++bj) { float v[8];
#pragma unroll
                    for (int i = 0; i < 4; ++i) { v[i] = acc[ai][bj][m][0][i]; v[4 + i] = acc[ai][bj][m][1][i]; }
                    if (lora) {
                        if (bj == 1) {
#pragma unroll
                            for (int i = 0; i < 8; ++i) v[i] = fsigmoid(v[i]);
                        } else if (wc < 2) {
#pragma unroll
                            for (int i = 0; i < 8; ++i) v[i] = ftanh(v[i]);
                        }
                    }
                    v4u w; w.x = pk2(v[0], v[1]); w.y = pk2(v[2], v[3]); w.z = pk2(v[4], v[5]); w.w = pk2(v[6], v[7]);
                    *(v4u*)(rowp + bj * HALF) = w; } }
    }
};
struct StoreBf16 {
    static constexpr bool PERM = true;
    bf16* O; int ld;
    __device__ __forceinline__ void operator()(const f32x4 (&acc)[2][2][4][2], const Unit& u, int wr, int wc, int fr, int fq) const {
        const int row0 = u.pm * BM + wr * 64 + fr, col0 = u.pn * BM + wc * 32 + 8 * fq;
#pragma unroll
        for (int ai = 0; ai < 2; ++ai)
#pragma unroll
            for (int m = 0; m < 4; ++m) { bf16* rowp = O + (size_t)(row0 + ai * HALF + m * 16) * ld + col0;
#pragma unroll
                for (int bj = 0; bj < 2; ++bj) { const f32x4 v0 = acc[ai][bj][m][0], v1 = acc[ai][bj][m][1];
                    v4u w; w.x = pk2(v0[0], v0[1]); w.y = pk2(v0[2], v0[3]); w.z = pk2(v1[0], v1[1]); w.w = pk2(v1[2], v1[3]);
                    *(v4u*)(rowp + bj * HALF) = w; } }
    }
};
}
constexpr int HG_L = 64, HG_NC = T / HG_L;
__device__ __forceinline__ void gmlp_unit(const Frame& F, int unit) {
    const int g = unit & 3, n = (unit >> 2) & 63, b = unit >> 8;
    const int m0 = b * T + n * 128;
    LAS bf16* WM = (LAS bf16*)F.lds; LAS bf16* VNT = (LAS bf16*)(F.lds + 34816);
    const bf16* Z = wsp<bf16>(F, WS_Z); bf16* Y = wsp<bf16>(F, WS_XN);
    const bf16* wsm = wsp<bf16>(F, WS_WSM) + g * 16384;
    const float* gng = F.in[I_GNG] + g * 128;
#pragma unroll
    for (int i = 0; i < 4; ++i) { const int id = F.tid + 512 * i, row = id >> 4, cc = id & 15;
        *(LAS v4u*)(WM + row * 136 + cc * 8) = *(const v4u*)(wsm + row * 128 + cc * 8); }
#pragma unroll
    for (int i = 0; i < 4; ++i) { const int id = F.tid + 512 * i, s = id >> 4, cc = id & 15;
        const v4u raw = *(const v4u*)(Z + (size_t)(m0 + s) * MIX_IN + 512 + g * 128 + cc * 8);
        float v[8]; v[0] = bflo(raw.x); v[1] = bfhi(raw.x); v[2] = bflo(raw.y); v[3] = bfhi(raw.y); v[4] = bflo(raw.z); v[5] = bfhi(raw.z); v[6] = bflo(raw.w); v[7] = bfhi(raw.w);
        float sm = 0.f;
#pragma unroll
        for (int j = 0; j < 8; ++j) sm += v[j];
        sm += __shfl_xor(sm, 1); sm += __shfl_xor(sm, 2); sm += __shfl_xor(sm, 4); sm += __shfl_xor(sm, 8);
        const float mu = sm * (1.f / 128.f); float sq = 0.f;
#pragma unroll
        for (int j = 0; j < 8; ++j) { v[j] -= mu; sq += v[j] * v[j]; }
        sq += __shfl_xor(sq, 1); sq += __shfl_xor(sq, 2); sq += __shfl_xor(sq, 4); sq += __shfl_xor(sq, 8);
        const float rstd = 1.f / sqrtf(sq * (1.f / 128.f) + LN_EPS);
#pragma unroll
        for (int j = 0; j < 8; ++j) VNT[(cc * 8 + j) * 136 + s] = (bf16)f2bf(v[j] * rstd * gng[cc * 8 + j]); }
    __syncthreads();
    const int fr = F.lane & 15, fq = F.lane >> 4, t0 = 16 * F.wave, nks = (F.wave >> 1) + 1;
    f32x4 acc[8];
#pragma unroll
    for (int j = 0; j < 8; ++j) acc[j] = (f32x4){0.f, 0.f, 0.f, 0.f};
    for (int ks = 0; ks < nks; ++ks) {
        const bf16x8 a = *(const LAS bf16x8*)(WM + (t0 + fr) * 136 + ks * 32 + fq * 8);
#pragma unroll
        for (int j = 0; j < 8; ++j) { const bf16x8 bb = *(const LAS bf16x8*)(VNT + (16 * j + fr) * 136 + ks * 32 + fq * 8);
            acc[j] = __builtin_amdgcn_mfma_f32_16x16x32_bf16(bb, a, acc[j], 0, 0, 0); }
    }
    const int t = t0 + fr; const float bs = F.in[I_GBS][g * 128 + t];
    const bf16* zr = Z + (size_t)(m0 + t) * MIX_IN + g * 128; bf16* yr = Y + (size_t)(m0 + t) * D + g * 128;
#pragma unroll
    for (int j = 0; j < 8; ++j) { const int c = 16 * j + 4 * fq; const v2u ur = *(const v2u*)(zr + c);
        f32x4 o; o[0] = bflo(ur.x) * (acc[j][0] + bs); o[1] = bfhi(ur.x) * (acc[j][1] + bs); o[2] = bflo(ur.y) * (acc[j][2] + bs); o[3] = bfhi(ur.y) * (acc[j][3] + bs);
        *(v2u*)(yr + c) = pk4(o); }
    __syncthreads();
}
__device__ __forceinline__ void hg_load_lf(const bf16* Z, int m0, int h, int k, int tq, float (&lf)[16]) {
#pragma unroll
    for (int i = 0; i < 16; ++i) lf[i] = bf2f(Z[(size_t)(m0 + 16 * tq + i) * MIX_IN + 1536 + h * 128 + k]);
}
__device__ __forceinline__ void hgrn_pre_unit(const Frame& F, int unit) {
    const int c = unit & 127, h = (unit >> 7) & 3, b = unit >> 9;
    const int m0 = b * T + c * HG_L;
    LAS bf16* KDT = (LAS bf16*)F.lds; LAS bf16* VT = (LAS bf16*)(F.lds + 18432); LAS float* PART = (LAS float*)(F.lds + 36864);
    const bf16* Z = wsp<bf16>(F, WS_Z);
    const int k = F.tid & 127, tq = F.tid >> 7;
    float lf[16]; hg_load_lf(Z, m0, h, k, tq, lf);
    float pre[16]; float run = 0.f;
#pragma unroll
    for (int i = 0; i < 16; ++i) { run += lf[i]; pre[i] = run; }
    PART[tq * 128 + k] = run;
    __syncthreads();
    float off = 0.f, bend = 0.f;
#pragma unroll
    for (int q = 0; q < 4; ++q) { const float p = PART[q * 128 + k]; bend += p; off += (q < tq) ? p : 0.f; }
    unsigned kd[8], vv[8];
#pragma unroll
    for (int i = 0; i < 8; ++i) {
        const float k0 = (1.f - fexp(lf[2 * i])) * fexp(bend - (off + pre[2 * i])), k1 = (1.f - fexp(lf[2 * i + 1])) * fexp(bend - (off + pre[2 * i + 1]));
        kd[i] = pk2(k0, k1);
        const unsigned v0 = Z[(size_t)(m0 + 16 * tq + 2 * i) * MIX_IN + 2048 + h * 128 + k], v1 = Z[(size_t)(m0 + 16 * tq + 2 * i + 1) * MIX_IN + 2048 + h * 128 + k];
        vv[i] = v0 | (v1 << 16);
    }
    *(LAS v4u*)(KDT + k * 72 + 16 * tq) = (v4u){kd[0], kd[1], kd[2], kd[3]}; *(LAS v4u*)(KDT + k * 72 + 16 * tq + 8) = (v4u){kd[4], kd[5], kd[6], kd[7]};
    *(LAS v4u*)(VT + k * 72 + 16 * tq) = (v4u){vv[0], vv[1], vv[2], vv[3]}; *(LAS v4u*)(VT + k * 72 + 16 * tq + 8) = (v4u){vv[4], vv[5], vv[6], vv[7]};
    if (tq == 0) wsp<float>(F, WS_HGD)[unit * 128 + k] = fexp(bend);
    __syncthreads();
    const int fr = F.lane & 15, fq = F.lane >> 4, v0 = 16 * F.wave;
    bf16* inc = wsp<bf16>(F, WS_HGI) + (size_t)unit * 16384;
#pragma unroll
    for (int j = 0; j < 8; ++j) { f32x4 acc = (f32x4){0.f, 0.f, 0.f, 0.f};
        acc = mm_tile<2>(VT, 72, KDT, 72, v0, 16 * j, acc, fr, fq);
        *(v2u*)(inc + (v0 + fr) * 128 + 16 * j + 4 * fq) = pk4(acc); }
    __syncthreads();
}
__device__ __forceinline__ void hgrn_scan(const Frame& F) {
    for (int gt = F.vcu * NTHREADS + F.tid; gt < 8 * 4096; gt += F.G * NTHREADS) {
    const int bh = gt >> 12, e = (gt & 4095) * 4, k = e & 127;
    const bf16* __restrict__ inc = wsp<bf16>(F, WS_HGI) + (size_t)bh * HG_NC * 16384 + e;
    bf16* __restrict__ st = wsp<bf16>(F, WS_HGS) + (size_t)bh * HG_NC * 16384 + e;
    const float* __restrict__ dd = wsp<float>(F, WS_HGD) + (size_t)bh * HG_NC * 128 + k;
    f32x4 S = (f32x4){0.f, 0.f, 0.f, 0.f};
#pragma unroll 4
    for (int c = 0; c < HG_NC; ++c) {
        const v2u iv = *(const v2u*)(inc + (size_t)c * 16384); const f32x4 d = *(const f32x4*)(dd + c * 128);
        *(v2u*)(st + (size_t)c * 16384) = pk4(S);
        S[0] = d[0] * S[0] + bflo(iv.x); S[1] = d[1] * S[1] + bfhi(iv.x); S[2] = d[2] * S[2] + bflo(iv.y); S[3] = d[3] * S[3] + bfhi(iv.y);
    }
    }
}
__device__ __forceinline__ void hgrn_post_unit(const Frame& F, int unit) {
    const int c = unit & 127, h = (unit >> 7) & 3, b = unit >> 9;
    const int m0 = b * T + c * HG_L;
    LAS bf16* QD = (LAS bf16*)F.lds; LAS bf16* QP = (LAS bf16*)(F.lds + 17408); LAS bf16* KP = (LAS bf16*)(F.lds + 34816);
    LAS bf16* VT = (LAS bf16*)(F.lds + 52224); LAS bf16* SC = (LAS bf16*)(F.lds + 70656);
    LAS float* PART = (LAS float*)(F.lds + 79872); LAS float* RS = (LAS float*)(F.lds + 81920);
    const bf16* Z = wsp<bf16>(F, WS_Z); bf16* Y = wsp<bf16>(F, WS_XN);
    const int k = F.tid & 127, tq = F.tid >> 7;
    float lf[16]; hg_load_lf(Z, m0, h, k, tq, lf);
    float pre[16]; float run = 0.f;
#pragma unroll
    for (int i = 0; i < 16; ++i) { run += lf[i]; pre[i] = run; }
    PART[tq * 128 + k] = run;
    __syncthreads();
    const float p0 = PART[k], p1 = PART[128 + k], p2 = PART[256 + k];
    const float off = (tq > 0 ? p0 : 0.f) + (tq > 1 ? p1 : 0.f) + (tq > 2 ? p2 : 0.f), bm = p0 + p1;
    unsigned vv[8];
#pragma unroll
    for (int i = 0; i < 16; ++i) {
        const int t = 16 * tq + i; const float bb = off + pre[i];
        const float q = bf2f(Z[(size_t)(m0 + t) * MIX_IN + 1024 + h * 128 + k]);
        const float kk = 1.f - fexp(lf[i]);
        const float dq = fminf(fmaxf(bb - bm, -80.f), 80.f);
        QD[t * 136 + k] = (bf16)f2bf(q * fexp(bb)); QP[t * 136 + k] = (bf16)f2bf(q * fexp(dq)); KP[t * 136 + k] = (bf16)f2bf(kk * fexp(-dq));
        const unsigned vr = Z[(size_t)(m0 + t) * MIX_IN + 2048 + h * 128 + k];
        if (i & 1) vv[i >> 1] |= vr << 16; else vv[i >> 1] = vr;
    }
    *(LAS v4u*)(VT + k * 72 + 16 * tq) = (v4u){vv[0], vv[1], vv[2], vv[3]}; *(LAS v4u*)(VT + k * 72 + 16 * tq + 8) = (v4u){vv[4], vv[5], vv[6], vv[7]};
    __syncthreads();
    const int fr = F.lane & 15, fq = F.lane >> 4, t0 = 16 * (F.wave >> 1);
#pragma unroll
    for (int j = 0; j < 2; ++j) { const int s0 = 16 * (2 * (F.wave & 1) + j); f32x4 acc = (f32x4){0.f, 0.f, 0.f, 0.f};
        if (s0 <= t0) acc = mm_tile<4>(QP, 136, KP, 136, t0, s0, acc, fr, fq);
        const int t = t0 + fr, s = s0 + 4 * fq;
#pragma unroll
        for (int i = 0; i < 4; ++i) acc[i] = (s + i <= t) ? acc[i] : 0.f;
        *(LAS v2u*)(SC + t * 72 + s) = pk4(acc); }
    __syncthreads();
    const bf16* ST = wsp<bf16>(F, WS_HGS) + (size_t)unit * 16384;
    f32x4 o[4]; float ss = 0.f;
#pragma unroll
    for (int j = 0; j < 4; ++j) { const int v0 = 16 * (4 * (F.wave & 1) + j); f32x4 acc = (f32x4){0.f, 0.f, 0.f, 0.f};
        acc = mm_tile<2>(SC, 72, VT, 72, t0, v0, acc, fr, fq);
#pragma unroll
        for (int ks = 0; ks < 4; ++ks) { const bf16x8 a = *(const LAS bf16x8*)(QD + (t0 + fr) * 136 + ks * 32 + fq * 8);
            const bf16x8 bb = *(const bf16x8*)(ST + (v0 + fr) * 128 + ks * 32 + fq * 8);
            acc = __builtin_amdgcn_mfma_f32_16x16x32_bf16(bb, a, acc, 0, 0, 0); }
        o[j] = acc; ss += (acc[0] * acc[0] + acc[1] * acc[1]) + (acc[2] * acc[2] + acc[3] * acc[3]); }
    ss += __shfl_xor(ss, 16); ss += __shfl_xor(ss, 32);
    if (fq == 0) RS[(t0 + fr) * 2 + (F.wave & 1)] = ss;
    __syncthreads();
    const int t = t0 + fr; const float rstd = 1.f / sqrtf((RS[t * 2] + RS[t * 2 + 1]) * (1.f / 128.f) + RMS_EPS);
    const float* ong = F.in[I_ONG];
#pragma unroll
    for (int j = 0; j < 4; ++j) { const int v = 16 * (4 * (F.wave & 1) + j) + 4 * fq;
        const v2u sg = *(const v2u*)(Z + (size_t)(m0 + t) * MIX_IN + 2560 + h * 128 + v); const f32x4 gg = *(const f32x4*)(ong + v);
        f32x4 r; r[0] = o[j][0] * rstd * gg[0] * bflo(sg.x); r[1] = o[j][1] * rstd * gg[1] * bfhi(sg.x); r[2] = o[j][2] * rstd * gg[2] * bflo(sg.y); r[3] = o[j][3] * rstd * gg[3] * bfhi(sg.y);
        *(v2u*)(Y + (size_t)(m0 + t) * D + 512 + h * 128 + v) = pk4(r); }
    __syncthreads();
}
constexpr int RW_L = 64, RW_NC = T / RW_L;
constexpr int SLOT = 9216;
constexpr int RW_MISC = 16 * SLOT;
#define RW_S(i) ((LAS bf16*)(F.lds + (i) * SLOT))
__device__ __forceinline__ float softplusf(float x) { return fmaxf(x, 0.f) + __logf(1.f + fexp(-fabsf(x))); }
__device__ __forceinline__ void rwkv_pre_unit(const Frame& F, int unit) {
    const int c = unit & 127, h = (unit >> 7) & 15, b = unit >> 11;
    const int m0 = b * T + c * RW_L, hc0 = h * 64;
    bf16* Rb = wsp<bf16>(F, WS_R); bf16* Kb = wsp<bf16>(F, WS_K); const bf16* Vb = wsp<bf16>(F, WS_V); const bf16* LR = wsp<bf16>(F, WS_LR);
    const bf16* w2t = wsp<bf16>(F, WS_W2T); const bf16* a2t = w2t + 1024 * 64;
    LAS float* LW = (LAS float*)(F.lds + 5 * SLOT); LAS float* AA = (LAS float*)(F.lds + 7 * SLOT);
    LAS float* PARTW = (LAS float*)(F.lds + RW_MISC); LAS float* WLs = PARTW + 512;
    const int tid = F.tid, lane = F.lane, wave = F.wave, fr = lane & 15, fq = lane >> 4;
    const int mt = wave >> 1, ntb = 2 * (wave & 1);
    { const int row = tid >> 3, cc = tid & 7; const size_t g = (size_t)(m0 + row) * D + hc0 + cc * 8;
      *(LAS v4u*)(RW_S(0) + row * 72 + cc * 8) = *(const v4u*)(Rb + g);
      *(LAS v4u*)(RW_S(1) + row * 72 + cc * 8) = *(const v4u*)(Kb + g);
      *(LAS v4u*)(RW_S(2) + row * 72 + cc * 8) = *(const v4u*)(Vb + g);
#pragma unroll
      for (int i = 0; i < 2; ++i) { const int id = tid + 512 * i, r2 = id >> 4, c2 = id & 15;
          *(LAS v4u*)(RW_S(3) + r2 * 136 + c2 * 8) = *(const v4u*)(LR + (size_t)(m0 + r2) * 256 + c2 * 8); } }
    __syncthreads();
    { LAS bf16* LRT = RW_S(3);
#pragma unroll
      for (int j = 0; j < 2; ++j) { const int n0 = 16 * (ntb + j); f32x4 aw = (f32x4){0.f, 0.f, 0.f, 0.f}, aa = aw;
#pragma unroll
          for (int ks = 0; ks < 2; ++ks) {
              const bf16x8 xw = *(const LAS bf16x8*)(LRT + (16 * mt + fr) * 136 + ks * 32 + fq * 8);
              const bf16x8 xa = *(const LAS bf16x8*)(LRT + (16 * mt + fr) * 136 + 64 + ks * 32 + fq * 8);
              const bf16x8 bw = *(const bf16x8*)(w2t + (size_t)(hc0 + n0 + fr) * 64 + ks * 32 + fq * 8);
              const bf16x8 ba = *(const bf16x8*)(a2t + (size_t)(hc0 + n0 + fr) * 64 + ks * 32 + fq * 8);
              aw = __builtin_amdgcn_mfma_f32_16x16x32_bf16(bw, xw, aw, 0, 0, 0);
              aa = __builtin_amdgcn_mfma_f32_16x16x32_bf16(ba, xa, aa, 0, 0, 0); }
          const int t = 16 * mt + fr, cl = n0 + 4 * fq;
          const f32x4 w0 = *(const f32x4*)(F.in[I_RW0] + hc0 + cl), a0 = *(const f32x4*)(F.in[I_RA0] + hc0 + cl);
#pragma unroll
          for (int i = 0; i < 4; ++i) { const float wl = -softplusf(-(w0[i] + aw[i])) - 0.5f; LW[t * 68 + cl + i] = -fexp(wl); AA[t * 68 + cl + i] = fsigmoid(a0[i] + aa[i]); } } }
    __syncthreads();
    { const int cl = lane, tq = wave, hc = hc0 + cl;
      float lw[8], pre[8]; float run = 0.f;
#pragma unroll
      for (int i = 0; i < 8; ++i) { lw[i] = LW[(8 * tq + i) * 68 + cl]; run += lw[i]; pre[i] = run; }
      PARTW[tq * 64 + cl] = run;
      __syncthreads();
      float off = 0.f, cL = 0.f;
#pragma unroll
      for (int q = 0; q < 8; ++q) { const float p = PARTW[q * 64 + cl]; cL += p; off += (q < tq) ? p : 0.f; }
      if (tq == 0) WLs[cl] = fexp(cL);
      const float kkw = F.in[I_RKK][hc], kaw = F.in[I_RKA][hc], rkw = F.in[I_RRK][hc];
      unsigned aht[4], btt[4], ktt[4], vt[4];
#pragma unroll
      for (int i = 0; i < 8; ++i) {
          const int t = 8 * tq + i;
          const float r = bf2f(RW_S(0)[t * 72 + cl]), k = bf2f(RW_S(1)[t * 72 + cl]); const unsigned vraw = RW_S(2)[t * 72 + cl];
          const float a = AA[t * 68 + cl];
          const float kkr = k * kkw; const float ss = wave_sum(kkr * kkr);
          const float kk = kkr / fmaxf(sqrtf(ss), 1e-12f);
          const float kp = k * (1.f + (a - 1.f) * kaw), bb = kk * a;
          const float rk = wave_sum(r * kp * rkw);
          if (lane == 0) wsp<float>(F, WS_RKS)[(size_t)(m0 + t) * 16 + h] = rk;
          const float cs = off + pre[i];
          const float ep = fexp(cs), em = fexp(-cs), epv = fexp(cs - lw[i]), eL = fexp(cL - cs);
          const unsigned ah = f2bf(epv * kk), bh = f2bf(bb * em), kh = f2bf(kp * em), rh = f2bf(r * ep), bt = f2bf(bb * eL), kt = f2bf(kp * eL);
          RW_S(3)[t * 72 + cl] = (bf16)ah; RW_S(4)[t * 72 + cl] = (bf16)bh; RW_S(9)[t * 72 + cl] = (bf16)kh; RW_S(10)[t * 72 + cl] = (bf16)rh;
          if (i & 1) { aht[i >> 1] |= ah << 16; btt[i >> 1] |= bt << 16; ktt[i >> 1] |= kt << 16; vt[i >> 1] |= vraw << 16; }
          else { aht[i >> 1] = ah; btt[i >> 1] = bt; ktt[i >> 1] = kt; vt[i >> 1] = vraw; }
      }
      *(LAS v4u*)(RW_S(11) + cl * 72 + 8 * tq) = (v4u){aht[0], aht[1], aht[2], aht[3]};
      *(LAS v4u*)(RW_S(12) + cl * 72 + 8 * tq) = (v4u){btt[0], btt[1], btt[2], btt[3]};
      *(LAS v4u*)(RW_S(13) + cl * 72 + 8 * tq) = (v4u){ktt[0], ktt[1], ktt[2], ktt[3]};
      *(LAS v4u*)(RW_S(14) + cl * 72 + 8 * tq) = (v4u){vt[0], vt[1], vt[2], vt[3]}; }
    __syncthreads();
#pragma unroll
    for (int j = 0; j < 2; ++j) { const int n0 = 16 * (ntb + j), t = 16 * mt + fr, jj = n0 + 4 * fq; const f32x4 z = (f32x4){0.f, 0.f, 0.f, 0.f};
        f32x4 gab = mm_tile<2>(RW_S(3), 72, RW_S(4), 72, 16 * mt, n0, z, fr, fq);
        f32x4 gkb = mm_tile<2>(RW_S(3), 72, RW_S(9), 72, 16 * mt, n0, z, fr, fq);
        f32x4 gbr = mm_tile<2>(RW_S(10), 72, RW_S(4), 72, 16 * mt, n0, z, fr, fq);
        f32x4 gkr = mm_tile<2>(RW_S(10), 72, RW_S(9), 72, 16 * mt, n0, z, fr, fq);
#pragma unroll
        for (int i = 0; i < 4; ++i) { const bool st = (jj + i < t), inc = (jj + i <= t);
            gab[i] = st ? gab[i] : 0.f; gkb[i] = st ? gkb[i] : 0.f; gbr[i] = inc ? gbr[i] : 0.f; gkr[i] = inc ? gkr[i] : 0.f;
            RW_S(1)[(jj + i) * 72 + t] = (bf16)f2bf(gab[i]);
            RW_S(7)[(jj + i) * 72 + t] = (bf16)f2bf((jj + i == t ? 1.f : 0.f) - gab[i]); }
        *(LAS v2u*)(RW_S(0) + t * 72 + jj) = pk4(gab); *(LAS v2u*)(RW_S(2) + t * 72 + jj) = pk4(gkb);
        *(LAS v2u*)(RW_S(5) + t * 72 + jj) = pk4(gbr); *(LAS v2u*)(RW_S(6) + t * 72 + jj) = pk4(gkr); }
    __syncthreads();
    {
        int sX = 1, sXT = 0, sP = 7, sY = 8, sYT = 15, sPn = 3;
        for (int it = 1; it <= 5; ++it) {
#pragma unroll
            for (int j = 0; j < 2; ++j) { const int n0 = 16 * (ntb + j), m = 16 * mt + fr, tt = n0 + 4 * fq;
                f32x4 y = mm_tile<2>(RW_S(sX), 72, RW_S(sXT), 72, 16 * mt, n0, (f32x4){0.f, 0.f, 0.f, 0.f}, fr, fq);
                *(LAS v2u*)(RW_S(sY) + m * 72 + tt) = pk4(y);
#pragma unroll
                for (int i = 0; i < 4; ++i) RW_S(sYT)[(tt + i) * 72 + m] = (bf16)f2bf(y[i]); }
            __syncthreads();
#pragma unroll
            for (int j = 0; j < 2; ++j) { const int n0 = 16 * (ntb + j), m = 16 * mt + fr, tt = n0 + 4 * fq;
                const v2u pr = *(const LAS v2u*)(RW_S(sP) + m * 72 + tt);
                f32x4 p = (f32x4){bflo(pr.x), bfhi(pr.x), bflo(pr.y), bfhi(pr.y)};
                p = mm_tile<2>(RW_S(sP), 72, RW_S(sYT), 72, 16 * mt, n0, p, fr, fq);
                if (it < 5) *(LAS v2u*)(RW_S(sPn) + m * 72 + tt) = pk4(p);
                else {
#pragma unroll
                    for (int i = 0; i < 4; ++i) RW_S(4)[(tt + i) * 72 + m] = (bf16)f2bf(p[i]); } }
            __syncthreads();
            int tmp = sX; sX = sY; sY = tmp; tmp = sXT; sXT = sYT; sYT = tmp; tmp = sP; sP = sPn; sPn = tmp;
        }
    }
#pragma unroll
    for (int j = 0; j < 2; ++j) { const int n0 = 16 * (ntb + j), m = 16 * mt + fr, tt = n0 + 4 * fq; const f32x4 z = (f32x4){0.f, 0.f, 0.f, 0.f};
        const f32x4 ap = mm_tile<2>(RW_S(11), 72, RW_S(4), 72, 16 * mt, n0, z, fr, fq);
        const f32x4 vm = mm_tile<2>(RW_S(14), 72, RW_S(2), 72, 16 * mt, n0, z, fr, fq);
        *(LAS v2u*)(RW_S(9) + m * 72 + tt) = pk4(ap); *(LAS v2u*)(RW_S(3) + m * 72 + tt) = pk4(vm); }
    __syncthreads();
#pragma unroll
    for (int j = 0; j < 2; ++j) { const int n0 = 16 * (ntb + j), m = 16 * mt + fr, tt = n0 + 4 * fq;
        const f32x4 vp = mm_tile<2>(RW_S(3), 72, RW_S(4), 72, 16 * mt, n0, (f32x4){0.f, 0.f, 0.f, 0.f}, fr, fq);
        *(LAS v2u*)(RW_S(7) + m * 72 + tt) = pk4(vp); }
    __syncthreads();
    bf16* OMT = wsp<bf16>(F, WS_OMT); bf16* YL = wsp<bf16>(F, WS_YL);
#pragma unroll
    for (int j = 0; j < 2; ++j) { const int nt = ntb + j, n0 = 16 * nt, m = 16 * mt + fr, nn = n0 + 4 * fq; const f32x4 z = (f32x4){0.f, 0.f, 0.f, 0.f};
        { f32x4 x = mm_tile<2>(RW_S(12), 72, RW_S(9), 72, 16 * mt, n0, z, fr, fq); const float wl = WLs[m];
#pragma unroll
          for (int i = 0; i < 4; ++i) x[i] = ((nn + i == m) ? wl : 0.f) - x[i];
          const int idx = (nt >> 1) * 32 + fq * 8 + (nt & 1) * 4;
          *(v2u*)(Rb + (size_t)(m0 + m) * D + hc0 + idx) = pk4(x); }
        { const f32x4 x1 = mm_tile<2>(RW_S(14), 72, RW_S(13), 72, 16 * mt, n0, z, fr, fq), x2 = mm_tile<2>(RW_S(7), 72, RW_S(12), 72, 16 * mt, n0, z, fr, fq);
          *(v2u*)(Kb + (size_t)(m0 + m) * D + hc0 + nn) = pk4(x1 - x2); }
        { const f32x4 x1 = mm_tile<2>(RW_S(6), 72, RW_S(14), 72, 16 * mt, n0, z, fr, fq), x2 = mm_tile<2>(RW_S(5), 72, RW_S(7), 72, 16 * mt, n0, z, fr, fq);
          *(v2u*)(YL + (size_t)(m0 + m) * D + hc0 + nn) = pk4(x1 - x2); }
        { const f32x4 x = mm_tile<2>(RW_S(5), 72, RW_S(9), 72, 16 * mt, n0, z, fr, fq);
          const v2u rr = *(const LAS v2u*)(RW_S(10) + m * 72 + nn);
          f32x4 o; o[0] = bflo(rr.x) - x[0]; o[1] = bfhi(rr.x) - x[1]; o[2] = bflo(rr.y) - x[2]; o[3] = bfhi(rr.y) - x[3];
          *(v2u*)(OMT + (size_t)(m0 + m) * D + hc0 + nn) = pk4(o); } }
    __syncthreads();
}
__device__ __forceinline__ void rwkv_scan(const Frame& F) {
    if (F.wave >= 4) return;
    for (int bh = F.vcu; bh < 32; bh += F.G) {
    const int b = bh >> 4, h = bh & 15, hc0 = h * 64, vg = F.wave, l15 = F.lane & 15, q = F.lane >> 4;
    const bf16* Rb = wsp<bf16>(F, WS_R); const bf16* Kb = wsp<bf16>(F, WS_K); bf16* S0 = wsp<bf16>(F, WS_S0);
    f32x4 acc[4];
#pragma unroll
    for (int i = 0; i < 4; ++i) acc[i] = (f32x4){0.f, 0.f, 0.f, 0.f};
    for (int c = 0; c < RW_NC; ++c) {
        const int m0 = b * T + c * RW_L;
        bf16x8 A[4][2]; v2u psi[4];
#pragma unroll
        for (int mt = 0; mt < 4; ++mt) {
#pragma unroll
            for (int s = 0; s < 2; ++s) A[mt][s] = *(const bf16x8*)(Rb + (size_t)(m0 + 16 * mt + l15) * D + hc0 + s * 32 + q * 8);
            psi[mt] = *(const v2u*)(Kb + (size_t)(m0 + 16 * vg + l15) * D + hc0 + 16 * mt + 4 * q); }
        v2u pk[4];
#pragma unroll
        for (int mt = 0; mt < 4; ++mt) { pk[mt] = pk4(acc[mt]); *(v2u*)(S0 + (size_t)(m0 + 16 * vg + l15) * D + hc0 + 16 * mt + 4 * q) = pk[mt]; }
        const v4u b0 = (v4u){pk[0].x, pk[0].y, pk[1].x, pk[1].y}, b1 = (v4u){pk[2].x, pk[2].y, pk[3].x, pk[3].y};
        const bf16x8 sB0 = __builtin_bit_cast(bf16x8, b0), sB1 = __builtin_bit_cast(bf16x8, b1);
#pragma unroll
        for (int mt = 0; mt < 4; ++mt) {
            f32x4 a = (f32x4){bflo(psi[mt].x), bfhi(psi[mt].x), bflo(psi[mt].y), bfhi(psi[mt].y)};
            a = __builtin_amdgcn_mfma_f32_16x16x32_bf16(A[mt][0], sB0, a, 0, 0, 0);
            a = __builtin_amdgcn_mfma_f32_16x16x32_bf16(A[mt][1], sB1, a, 0, 0, 0);
            acc[mt] = a; }
    }
    }
}
__device__ __forceinline__ void rwkv_post(const Frame& F) {
    const int gw = F.vcu * NWAVES + F.wave, NGW = F.G * NWAVES, fr = F.lane & 15, fq = F.lane >> 4;
    bf16* Rb = wsp<bf16>(F, WS_R); const bf16* Vb = wsp<bf16>(F, WS_V); const bf16* LR = wsp<bf16>(F, WS_LR);
    const bf16* OMT = wsp<bf16>(F, WS_OMT); const bf16* YL = wsp<bf16>(F, WS_YL); const bf16* S0 = wsp<bf16>(F, WS_S0);
    const bf16* g2t = wsp<bf16>(F, WS_W2T) + 2 * 1024 * 64; const float* RKS = wsp<float>(F, WS_RKS);
    for (int item = gw; item < 4096 * 4; item += NGW) {
        const int unit = item >> 2, mt = item & 3;
        const int c = unit & 127, h = (unit >> 7) & 15, b = unit >> 11;
        const int m0 = b * T + c * RW_L, hc0 = h * 64, t = 16 * mt + fr; const size_t rowt = (size_t)(m0 + t);
        f32x4 y[4], g[4];
        bf16x8 om[2], lg[4];
#pragma unroll
        for (int ks = 0; ks < 2; ++ks) om[ks] = *(const bf16x8*)(OMT + rowt * D + hc0 + ks * 32 + fq * 8);
#pragma unroll
        for (int ks = 0; ks < 4; ++ks) lg[ks] = *(const bf16x8*)(LR + rowt * 256 + 128 + ks * 32 + fq * 8);
#pragma unroll
        for (int nt = 0; nt < 4; ++nt) {
            const v2u yl = *(const v2u*)(YL + rowt * D + hc0 + 16 * nt + 4 * fq);
            f32x4 a = (f32x4){bflo(yl.x), bfhi(yl.x), bflo(yl.y), bfhi(yl.y)};
#pragma unroll
            for (int ks = 0; ks < 2; ++ks) { const bf16x8 sb = *(const bf16x8*)(S0 + (size_t)(m0 + 16 * nt + fr) * D + hc0 + ks * 32 + fq * 8);
                a = __builtin_amdgcn_mfma_f32_16x16x32_bf16(sb, om[ks], a, 0, 0, 0); }
            y[nt] = a;
            f32x4 gg = (f32x4){0.f, 0.f, 0.f, 0.f};
#pragma unroll
            for (int ks = 0; ks < 4; ++ks) { const bf16x8 gb = *(const bf16x8*)(g2t + (size_t)(hc0 + 16 * nt + fr) * 128 + ks * 32 + fq * 8);
                gg = __builtin_amdgcn_mfma_f32_16x16x32_bf16(gb, lg[ks], gg, 0, 0, 0); }
            g[nt] = gg; }
        float s = 0.f;
#pragma unroll
        for (int nt = 0; nt < 4; ++nt) s += (y[nt][0] + y[nt][1]) + (y[nt][2] + y[nt][3]);
        s += __shfl_xor(s, 16); s += __shfl_xor(s, 32);
        const float mu = s * (1.f / 64.f); float qv = 0.f;
#pragma unroll
        for (int nt = 0; nt < 4; ++nt) { y[nt] = y[nt] - mu; qv += (y[nt][0] * y[nt][0] + y[nt][1] * y[nt][1]) + (y[nt][2] * y[nt][2] + y[nt][3] * y[nt][3]); }
        qv += __shfl_xor(qv, 16); qv += __shfl_xor(qv, 32);
        const float rstd = 1.f / sqrtf(qv * (1.f / 64.f) + GN_EPS);
        const float rk = RKS[rowt * 16 + h];
#pragma unroll
        for (int nt = 0; nt < 4; ++nt) { const int v = hc0 + 16 * nt + 4 * fq;
            const f32x4 lgv = *(const f32x4*)(F.in[I_RLG] + v), lbv = *(const f32x4*)(F.in[I_RLB] + v);
            const v2u vr = *(const v2u*)(Vb + rowt * D + v);
            f32x4 o; o[0] = (y[nt][0] * rstd * lgv[0] + lbv[0] + rk * bflo(vr.x)) * g[nt][0]; o[1] = (y[nt][1] * rstd * lgv[1] + lbv[1] + rk * bfhi(vr.x)) * g[nt][1];
            o[2] = (y[nt][2] * rstd * lgv[2] + lbv[2] + rk * bflo(vr.y)) * g[nt][2]; o[3] = (y[nt][3] * rstd * lgv[3] + lbv[3] + rk * bfhi(vr.y)) * g[nt][3];
            *(v2u*)(Rb + rowt * D + v) = pk4(o); }
    }
}
__device__ __forceinline__ void norm_phase(const Frame& F, const float* g, bf16* XN) {
    const int gw = F.vcu * NWAVES + F.wave, NGW = F.G * NWAVES;
    for (int m = gw; m < M; m += NGW) { f32x4 v[4]; rms_row(F.out + (size_t)m * D, g, F.lane, v); store_row_bf16(XN + (size_t)m * D, F.lane, v); }
}
__device__ __forceinline__ void a2_phase(const Frame& F) {
    const int gw = F.vcu * NWAVES + F.wave, NGW = F.G * NWAVES; const float* g = F.in[I_NMG] + D; bf16* A2 = wsp<bf16>(F, WS_A2);
    for (int blk = gw; blk < M / 8; blk += NGW) {
        const int r0 = 8 * blk; f32x4 prev[4];
        if ((r0 & (T - 1)) == 0) {
#pragma unroll
            for (int j = 0; j < 4; ++j) prev[j] = (f32x4){0.f, 0.f, 0.f, 0.f};
        } else rms_row(F.out + (size_t)(r0 - 1) * D, g, F.lane, prev);
        for (int i = 0; i < 8; ++i) { f32x4 cur[4]; rms_row(F.out + (size_t)(r0 + i) * D, g, F.lane, cur);
            store_row_bf16(A2 + (size_t)(r0 + i) * 2048, F.lane, cur);
            f32x4 dx[4];
#pragma unroll
            for (int j = 0; j < 4; ++j) { dx[j] = prev[j] - cur[j]; prev[j] = cur[j]; }
            store_row_bf16(A2 + (size_t)(r0 + i) * 2048 + D, F.lane, dx); }
    }
}
__device__ __forceinline__ void router_phase(const Frame& F) {
    LAS int* wgc = (LAS int*)(F.lds + 131072); LAS int* wbase = wgc + 8; LAS int* TE = wgc + 16; LAS int* TL = TE + 128; LAS float* TW = (LAS float*)(TL + 128);
    const float* g = F.in[I_NFG] + D; const float* rw = F.in[I_MR]; const float* rb = F.in[I_MRB]; bf16* XN3 = wsp<bf16>(F, WS_XN3);
    for (int blk = F.vcu; blk < M / 64; blk += F.G) {
    if (F.tid < 8) wgc[F.tid] = 0;
    __syncthreads();
    for (int i = 0; i < 8; ++i) {
        const int tl = 8 * F.wave + i, m = 64 * blk + tl;
        if (m < M) {
            f32x4 v[4]; rms_row(F.out + (size_t)m * D, g, F.lane, v); store_row_bf16(XN3 + (size_t)m * D, F.lane, v);
            float lg[8];
#pragma unroll
            for (int e = 0; e < 8; ++e) lg[e] = 0.f;
#pragma unroll
            for (int j = 0; j < 4; ++j)
#pragma unroll
                for (int x = 0; x < 4; ++x) { const int k = 4 * F.lane + 256 * j + x; const f32x4 r0 = *(const f32x4*)(rw + k * 8), r1 = *(const f32x4*)(rw + k * 8 + 4); const float xv = v[j][x];
                    lg[0] += xv * r0[0]; lg[1] += xv * r0[1]; lg[2] += xv * r0[2]; lg[3] += xv * r0[3]; lg[4] += xv * r1[0]; lg[5] += xv * r1[1]; lg[6] += xv * r1[2]; lg[7] += xv * r1[3]; }
#pragma unroll
            for (int e = 0; e < 8; ++e) lg[e] = wave_sum(lg[e]) + rb[e];
            int e1 = 0; float l1 = lg[0];
#pragma unroll
            for (int e = 1; e < 8; ++e) if (lg[e] > l1) { l1 = lg[e]; e1 = e; }
            int e2 = (e1 + 1) & 7; float l2 = -3.0e38f;
#pragma unroll
            for (int e = 0; e < 8; ++e) if (e != e1 && lg[e] > l2) { l2 = lg[e]; e2 = e; }
            const float w1 = 1.f / (1.f + expf(l2 - l1)), w2 = 1.f - w1;
            if (F.lane == 0) { const int a = atomicAdd((int*)&wgc[e1], 1), bb = atomicAdd((int*)&wgc[e2], 1);
                TE[2 * tl] = e1; TE[2 * tl + 1] = e2; TL[2 * tl] = a; TL[2 * tl + 1] = bb; TW[2 * tl] = w1; TW[2 * tl + 1] = w2; }
        }
    }
    __syncthreads();
    if (F.tid < 8) wbase[F.tid] = (int)__hip_atomic_fetch_add((unsigned*)(F.ws + WS_CTL) + CW_CNT + F.tid, (unsigned)wgc[F.tid], RLX_AGENT);
    __syncthreads();
    if (F.tid < 128) { const int tl = F.tid >> 1, m = 64 * blk + tl;
        if (m < M) { unsigned char* rt = F.ws + WS_ROUTE; const int e = TE[F.tid];
            ((int*)(rt + RT_E))[2 * m + (F.tid & 1)] = e; ((int*)(rt + RT_POS))[2 * m + (F.tid & 1)] = wbase[e] + TL[F.tid]; ((float*)(rt + RT_W))[2 * m + (F.tid & 1)] = TW[F.tid]; } }
    __syncthreads();
    }
    run_jobs(F, true);
}
__device__ __forceinline__ void moe_offsets(const Frame& F, int (&toff)[9]) {
    const unsigned* cnt = (const unsigned*)(F.ws + WS_CTL) + CW_CNT; int acc = 0;
#pragma unroll
    for (int e = 0; e < 8; ++e) { toff[e] = acc; acc += ((int)__hip_atomic_load(cnt + e, RLX_AGENT) + 255) >> 8; }
    toff[8] = acc;
}
__device__ __forceinline__ void gather_phase(const Frame& F) {
    int toff[9]; moe_offsets(F, toff);
    const int gw = F.vcu * NWAVES + F.wave, NGW = F.G * NWAVES; unsigned char* rt = F.ws + WS_ROUTE;
    const bf16* XN3 = wsp<bf16>(F, WS_XN3); bf16* XG = wsp<bf16>(F, WS_XG);
    for (int p = gw; p < 2 * M; p += NGW) {
        const int m = p >> 1; const int e = ((const int*)(rt + RT_E))[p], pos = ((const int*)(rt + RT_POS))[p]; const float w = ((const float*)(rt + RT_W))[p];
        int off = 0;
#pragma unroll
        for (int j = 0; j < 8; ++j) off = (e == j) ? toff[j] : off;
        int slot = off * 256 + pos; if ((unsigned)e >= 8u || (unsigned)slot >= (unsigned)XG_ROWS) slot = XG_ROWS - 1;
        const v4u* src = (const v4u*)(XN3 + (size_t)m * D); v4u* dst = (v4u*)(XG + (size_t)slot * D);
        dst[F.lane] = src[F.lane]; dst[64 + F.lane] = src[64 + F.lane];
        if (F.lane == 0) { ((int*)(rt + RT_SLOT))[p] = slot; ((float*)(rt + RT_SLOTW))[slot] = w; }
    }
}
__device__ __forceinline__ void final_phase(const Frame& F) {
    const int gw = F.vcu * NWAVES + F.wave, NGW = F.G * NWAVES; unsigned char* rt = F.ws + WS_ROUTE; const bf16* YE = wsp<bf16>(F, WS_XG);
    const float* g = F.in[I_NOG];
    for (int m = gw; m < M; m += NGW) {
        int s0 = ((const int*)(rt + RT_SLOT))[2 * m], s1 = ((const int*)(rt + RT_SLOT))[2 * m + 1];
        if ((unsigned)s0 >= (unsigned)XG_ROWS) s0 = XG_ROWS - 1; if ((unsigned)s1 >= (unsigned)XG_ROWS) s1 = XG_ROWS - 1;
        const f32x4* xr = (const f32x4*)(F.out + (size_t)m * D) + F.lane; const v2u* y0 = (const v2u*)(YE + (size_t)s0 * D) + F.lane; const v2u* y1 = (const v2u*)(YE + (size_t)s1 * D) + F.lane;
        f32x4 v[4]; float s = 0.f;
#pragma unroll
        for (int j = 0; j < 4; ++j) { const v2u a = y0[64 * j], bq = y1[64 * j]; v[j] = xr[64 * j];
            v[j][0] += bflo(a.x) + bflo(bq.x); v[j][1] += bfhi(a.x) + bfhi(bq.x); v[j][2] += bflo(a.y) + bflo(bq.y); v[j][3] += bfhi(a.y) + bfhi(bq.y);
            s += (v[j][0] * v[j][0] + v[j][1] * v[j][1]) + (v[j][2] * v[j][2] + v[j][3] * v[j][3]); }
        const float rs = 1.f / sqrtf(wave_sum(s) * (1.f / D) + RMS_EPS);
        f32x4* o = (f32x4*)(F.out + (size_t)m * D) + F.lane; const f32x4* gr = (const f32x4*)g + F.lane;
#pragma unroll
        for (int j = 0; j < 4; ++j) o[64 * j] = v[j] * rs * gr[64 * j];
    }
}
constexpr int N_PHASES = 20;
struct Args { const float* in[37]; float* out; unsigned char* ws; int ph_lo, ph_hi; };
__global__ void __launch_bounds__(NTHREADS, 2) fwd_kernel(Args args) {
    extern __shared__ __attribute__((aligned(16))) unsigned char lds_raw[];
    Frame F;
    F.lds = (LAS unsigned char*)lds_raw;
    F.tid = threadIdx.x; F.lane = F.tid & 63; F.wave = __builtin_amdgcn_readfirstlane(F.tid >> 6);
    F.G = gridDim.x; { const int bx = blockIdx.x; F.vcu = (F.G % 8 == 0) ? (bx % 8) * (F.G / 8) + bx / 8 : bx; }
#pragma unroll
    for (int i = 0; i < 37; ++i) F.in[i] = args.in[i];
    F.out = args.out; F.ws = args.ws;
    volatile LAS unsigned* MISC = (volatile LAS unsigned*)(F.lds + MISC_OFF);
    if (F.tid < 64) MISC[F.tid] = 0u;
    __syncthreads();
    const int lo = args.ph_lo, hi = args.ph_hi;
    const bool multi = (hi - lo) > 1;
    XcdBarrier bar; bar.bar = (unsigned*)(F.ws + WS_CTL) + CW_BAR; bar.x = 0; bar.st = nullptr;
    if (multi) bar = xcd_barrier_post((unsigned*)(F.ws + WS_CTL) + CW_BAR, MISC + 8);
#define IN(k) (lo <= (k) && (k) < hi)
#define SEAM(k) do { if (IN(k) && IN((k) + 1)) xcd_barrier(bar); } while (0)
    LAS unsigned char* lds = F.lds;
    const int cu = (int)blockIdx.x;

    if (IN(0)) { p0_prologue(F); } SEAM(0);
    if (IN(1)) { pg8::DenseOrder S; S.init(wsp<bf16>(F, WS_XN), wsp<bf16>(F, WS_WIN), M, MIX_IN, 1024, F.G, cu);
        epi::MixIn E{wsp<bf16>(F, WS_Z), wsp<float>(F, WS_LB)};
        pg8::gemm_phase(lds, 1024, S, E); } SEAM(1);
    if (IN(2)) { for (int u = F.vcu; u < 512; u += F.G) gmlp_unit(F, u);
        for (int u = F.vcu; u < 1024; u += F.G) hgrn_pre_unit(F, u); } SEAM(2);
    if (IN(3)) { hgrn_scan(F); } SEAM(3);
    if (IN(4)) { for (int u = F.vcu; u < 1024; u += F.G) hgrn_post_unit(F, u); } SEAM(4);
    if (IN(5)) { pg8::DenseOrder S; S.init(wsp<bf16>(F, WS_XN), wsp<bf16>(F, WS_WOUT), M, D, 1024, F.G, cu);
        epi::Resid E{F.in[I_X], F.out};
        pg8::gemm_phase(lds, 1024, S, E); } SEAM(5);
    if (IN(6)) { norm_phase(F, F.in[I_NFG], wsp<bf16>(F, WS_XN)); } SEAM(6);
    if (IN(7)) { pg8::DenseOrder S; S.init(wsp<bf16>(F, WS_XN), wsp<bf16>(F, WS_WGU), M, 2 * DFF, 1024, F.G, cu);
        epi::SwiGlu E{wsp<bf16>(F, WS_HF), DFF, nullptr};
        pg8::gemm_phase(lds, 1024, S, E); } SEAM(7);
    if (IN(8)) { pg8::DenseOrder S; S.init(wsp<bf16>(F, WS_HF), wsp<bf16>(F, WS_WD), M, D, DFF, F.G, cu);
        epi::Resid E{F.out, F.out};
        pg8::gemm_phase(lds, DFF, S, E); } SEAM(8);
    if (IN(9)) { a2_phase(F); } SEAM(9);
    if (IN(10)) { pg8::DenseOrder S; S.init(wsp<bf16>(F, WS_A2), wsp<bf16>(F, WS_WR), M, NRW, 2048, F.G, cu);
        epi::RwkvProj E{wsp<bf16>(F, WS_R), (size_t)(WS_K - WS_R) / 2, wsp<bf16>(F, WS_LR)};
        pg8::gemm_phase(lds, 2048, S, E); } SEAM(10);
    if (IN(11)) { for (int u = F.vcu; u < 4096; u += F.G) rwkv_pre_unit(F, u); } SEAM(11);
    if (IN(12)) { rwkv_scan(F); } SEAM(12);
    if (IN(13)) { rwkv_post(F); } SEAM(13);
    if (IN(14)) { pg8::DenseOrder S; S.init(wsp<bf16>(F, WS_R), wsp<bf16>(F, WS_WO), M, D, 1024, F.G, cu);
        epi::Resid E{F.out, F.out};
        pg8::gemm_phase(lds, 1024, S, E); } SEAM(14);
    if (IN(15)) { router_phase(F); } SEAM(15);
    if (IN(16)) { gather_phase(F); } SEAM(16);
    if (IN(17)) { pg8::MoeOrder S; moe_offsets(F, S.toff); S.ntiles = S.toff[8]; S.nN = 2 * DFE / 256; S.nwg = S.ntiles * S.nN; S.G = F.G; S.c = cu;
        S.A = (const char*)wsp<bf16>(F, WS_XG); S.Bt = (const char*)wsp<bf16>(F, WS_WEGU); S.tstep = (size_t)256 * 1024 * 2; S.estride = (size_t)2 * DFE * 1024 * 2;
        epi::SwiGlu E{wsp<bf16>(F, WS_HE), DFE, (const float*)(F.ws + WS_ROUTE + RT_SLOTW)};
        pg8::gemm_phase(lds, 1024, S, E); } SEAM(17);
    if (IN(18)) { pg8::MoeOrder S; moe_offsets(F, S.toff); S.ntiles = S.toff[8]; S.nN = D / 256; S.nwg = S.ntiles * S.nN; S.G = F.G; S.c = cu;
        S.A = (const char*)wsp<bf16>(F, WS_HE); S.Bt = (const char*)wsp<bf16>(F, WS_WED); S.tstep = (size_t)256 * DFE * 2; S.estride = (size_t)1024 * DFE * 2;
        epi::StoreBf16 E{wsp<bf16>(F, WS_XG), D};
        pg8::gemm_phase(lds, DFE, S, E); } SEAM(18);
    if (IN(19)) { final_phase(F); }
#undef IN
#undef SEAM
}


struct DiagReg { size_t off; int rows, stride, col0, ncols, isf32; float lo, hi; };
struct DiagArgs { DiagReg r[12]; int n; int pad; };
__global__ void diag_count(unsigned char* ws, unsigned* cnt, DiagArgs da) {
    for (int ri = 0; ri < da.n; ++ri) { const DiagReg R = da.r[ri]; const long tot = (long)R.rows * R.ncols; float worst = 0.f;
        for (long i = (long)blockIdx.x * blockDim.x + threadIdx.x; i < tot; i += (long)gridDim.x * blockDim.x) { const long row = i / R.ncols; const int col = (int)(i % R.ncols);
            float v;
            if (R.isf32) v = ((const float*)(ws + R.off))[row * R.stride + R.col0 + col];
            else v = __builtin_bit_cast(float, (unsigned)((const unsigned short*)(ws + R.off))[row * R.stride + R.col0 + col] << 16);
            if (!(v <= R.hi && v >= R.lo)) { float a = fabsf(v); if (!(a < 1e30f)) a = 1e30f; if (a < 1e-30f) a = 1e-30f; worst = fmaxf(worst, a); } }
        if (worst > 0.f) atomicMax(cnt + ri, __float_as_uint(worst)); }
}
__global__ void diag_mark(float* out, unsigned* cnt, DiagArgs da, int total) {
    for (int i = blockIdx.x * blockDim.x + threadIdx.x; i < total; i += gridDim.x * blockDim.x) out[i] = 0.f;
    if (threadIdx.x == 0 && blockIdx.x == 0) { int first = -1; for (int i = da.n - 1; i >= 0; --i) if (cnt[i]) first = i;
        if (first >= 0) { const float w = __uint_as_float(cnt[first]), bound = fmaxf(fabsf(da.r[first].lo), fabsf(da.r[first].hi));
            float m = 1.f + log10f(fmaxf(w / bound, 1.f)) * 0.25f; if (m > 9.5f) m = 9.5f;
            out[0] = sqrtf(1.678e7f * m * powf(10.f, 2.f + first)); } }
}
extern "C" void kernel_launch(void* const* d_in, const int* in_sizes, int n_in, void* d_out, int out_size, void* d_ws, size_t ws_size, hipStream_t stream) {
    static int grid = 0;
    if (grid == 0) {
        if (n_in != 37 || out_size != M * D || ws_size < WS_END) { fprintf(stderr, "kernel_launch: unexpected shapes (n_in %d out %d ws %zu)\n", n_in, out_size, ws_size); grid = -1; return; }
        int dev = 0, cus = 0, per_cu = 0;
        hipGetDevice(&dev); hipDeviceGetAttribute(&cus, hipDeviceAttributeMultiprocessorCount, dev);
        hipFuncSetAttribute((const void*)fwd_kernel, hipFuncAttributeMaxDynamicSharedMemorySize, LDS_BYTES);
        hipOccupancyMaxActiveBlocksPerMultiprocessor(&per_cu, (const void*)fwd_kernel, NTHREADS, LDS_BYTES);
        (void)hipGetLastError();
        grid = cus;
        if (per_cu < 1) fprintf(stderr, "kernel_launch: occupancy query says %d blocks per CU\n", per_cu);
    }
    if (grid < 0) return;
    hipMemsetAsync((char*)d_ws + WS_CTL, 0, CTL_ZERO_BYTES, stream);
    Args a{};
    for (int i = 0; i < 37; ++i) a.in[i] = (const float*)d_in[i];
    a.out = (float*)d_out; a.ws = (unsigned char*)d_ws;
#if MK_N_LAUNCHES == 1
    a.ph_lo = 0; a.ph_hi = N_PHASES;
    hipLaunchKernelGGL(fwd_kernel, dim3(grid), dim3(NTHREADS), LDS_BYTES, stream, a);
#else
    for (int p = 0; p < MK_PH_HI; ++p) { a.ph_lo = p; a.ph_hi = p + 1; hipLaunchKernelGGL(fwd_kernel, dim3(grid), dim3(NTHREADS), LDS_BYTES, stream, a); }
#endif
}
```

```cpp
#include <hip/hip_runtime.h>
#include <cstdio>
#include <cstdint>
#ifndef MK_N_LAUNCHES
#define MK_N_LAUNCHES 1
#endif
#ifndef MK_PH_HI
#define MK_PH_HI 20
#endif
namespace pg8 {
#define PG8_LAS __attribute__((address_space(3)))
typedef unsigned short bf16_t;
typedef short bf16x8 __attribute__((ext_vector_type(8)));
typedef float f32x4 __attribute__((ext_vector_type(4)));
typedef float f32x2 __attribute__((ext_vector_type(2)));
typedef unsigned u32x4 __attribute__((ext_vector_type(4)));
constexpr int BM = 256, BK = 64, HALF = 128, HTB = HALF * BK * 2, STAGE_BYTES = 8 * HTB, NXCD = 8, WGM = 8;

__host__ __device__ __forceinline__ int lds_byte(int r, int c) { const int st = (r >> 4) * 2 + (c >> 5), rr = r & 15, cc = c & 31, ob = rr * 64 + cc * 2; return st * 1024 + (ob ^ (((ob >> 9) & 1) << 5)); }
__host__ __device__ __forceinline__ void stage_rc(int b, int& R, int& C) { const int st = b / 1024, sb = b % 1024, swz = sb ^ (((sb >> 9) & 1) << 5); R = (st >> 1) * 16 + swz / 64; C = (st & 1) * 32 + (swz % 64) / 2; }
__host__ __device__ __forceinline__ int perm32(int rho) { const int n = rho >> 4, i = rho & 15; return 8 * (i >> 2) + 4 * n + (i & 3); }

struct Unit { int pm, pn; const char* A; const char* B; };

struct DenseOrder {
    int nM, nN, nwg, G, c; const char* A; const char* Bt; size_t tstep;
    __device__ void init(const void* A_, const void* Bt_, int M, int N, int K, int G_, int c_) { nM = M / BM; nN = N / BM; nwg = nM * nN; G = G_; c = c_; A = (const char*)A_; Bt = (const char*)Bt_; tstep = (size_t)BM * K * 2; }
    __device__ bool next(int i, Unit& u) const {
        const long L = (long)i * G + c; if (L >= nwg) return false;
        int wgid = (int)L; { const int q = nwg / NXCD, r = nwg % NXCD, xcd = wgid % NXCD, off = wgid / NXCD; wgid = (xcd < r ? xcd * (q + 1) : r * (q + 1) + (xcd - r) * q) + off; }
        const int nig = WGM * nN, gid = wgid / nig, fm = gid * WGM, gsz = (nM - fm) < WGM ? (nM - fm) : WGM;
        u.pm = fm + ((wgid % nig) % gsz); u.pn = (wgid % nig) / gsz;
        u.A = A + (size_t)u.pm * tstep; u.B = Bt + (size_t)u.pn * tstep; return true;
    }
};
struct MoeOrder {
    int ntiles, nN, nwg, G, c; int toff[9]; const char* A; const char* Bt; size_t tstep, estride;
    __device__ bool next(int i, Unit& u) const {
        const long L = (long)i * G + c; if (L >= nwg) return false;
        const int rt = (int)(L % ntiles), pn = (int)(L / ntiles);
        int e = 0;
#pragma unroll
        for (int j = 1; j < 8; ++j) e += (rt >= toff[j]) ? 1 : 0;
        u.pm = rt; u.pn = pn; u.A = A + (size_t)rt * tstep; u.B = Bt + (size_t)e * estride + (size_t)pn * tstep; return true;
    }
};

typedef __bf16 bf16x2_t __attribute__((ext_vector_type(2)));
__device__ __forceinline__ unsigned cvt_pk_bf16(float lo, float hi) { f32x2 v = {lo, hi}; bf16x2_t b = __builtin_convertvector(v, bf16x2_t); return __builtin_bit_cast(unsigned, b); }

template <class Epi, class Sched>
__device__ __forceinline__ void gemm_phase(PG8_LAS unsigned char* lds, const int K, const Sched& S, const Epi& E) {
    const int tid = threadIdx.x, wid = __builtin_amdgcn_readfirstlane(tid >> 6), lane = tid & 63, wr = wid >> 2, wc = wid & 3, fr = lane & 15, fq = lane >> 4;
    const int nt = K / BK;
    unsigned voffA[2], voffB[2];
#pragma unroll
    for (int i = 0; i < 2; ++i) { int R, C; stage_rc(tid * 16 + i * 8192, R, C); const int Rb = Epi::PERM ? ((R & ~31) + perm32(R & 31)) : R;
        voffA[i] = (unsigned)(R * K + C) * 2u; voffB[i] = (unsigned)(Rb * K + C) * 2u; }
    const size_t kstep = (size_t)(BK * 2);
    const size_t hstep = (size_t)HALF * K * 2;
    const unsigned ldsw = (unsigned)wid * 1024u;
    const int aoff = lds_byte(wr * 64 + fr, fq * 8), boff = lds_byte(wc * 32 + fr, fq * 8);
#define PG8_SA(b, h) (((b) * 2 + (h)) * HTB)
#define PG8_SB(b, h) ((4 + (b) * 2 + (h)) * HTB)
#define PG8_STAGE(bufoff, gbase, voff) do { _Pragma("unroll") for (int _i = 0; _i < 2; ++_i) \
        __builtin_amdgcn_global_load_lds((const unsigned*)((const char*)(gbase) + (voff)[_i]), (PG8_LAS unsigned*)(lds + (bufoff) + ldsw + _i * 8192), 16, 0, 0); } while (0)
#define PG8_LDA(dst, b, h) do { _Pragma("unroll") for (int m = 0; m < 4; ++m) _Pragma("unroll") for (int k = 0; k < 2; ++k) dst[m][k] = *(const PG8_LAS bf16x8*)(lds + PG8_SA(b, h) + aoff + m * 2048 + k * 1024); } while (0)
#define PG8_LDB(dst, b, h) do { _Pragma("unroll") for (int n = 0; n < 2; ++n) _Pragma("unroll") for (int k = 0; k < 2; ++k) dst[n][k] = *(const PG8_LAS bf16x8*)(lds + PG8_SB(b, h) + boff + n * 2048 + k * 1024); } while (0)
#define PG8_MMA(ai, bj, At, Bt) do { __builtin_amdgcn_s_setprio(1); _Pragma("unroll") for (int m = 0; m < 4; ++m) _Pragma("unroll") for (int n = 0; n < 2; ++n) _Pragma("unroll") for (int k = 0; k < 2; ++k) \
        acc[ai][bj][m][n] = __builtin_amdgcn_mfma_f32_16x16x32_bf16(Bt[n][k], At[m][k], acc[ai][bj][m][n], 0, 0, 0); __builtin_amdgcn_s_setprio(0); } while (0)
#define PG8_WAIT_V(n) asm volatile("s_waitcnt vmcnt(" #n ")" ::: "memory")
#define PG8_WAIT_L(n) asm volatile("s_waitcnt lgkmcnt(" #n ")" ::: "memory")
#define PG8_BAR __builtin_amdgcn_s_barrier()
#define PG8_SCHED __builtin_amdgcn_sched_barrier(0)
    Unit cur, nxt; int ui = 0;
    if (!S.next(0, cur)) return;
    f32x4 acc[2][2][4][2];
#pragma unroll
    for (int a = 0; a < 2; ++a)
#pragma unroll
        for (int b = 0; b < 2; ++b)
#pragma unroll
            for (int m = 0; m < 4; ++m)
#pragma unroll
                for (int n = 0; n < 2; ++n) acc[a][b][m][n] = (f32x4){0.f, 0.f, 0.f, 0.f};
    bf16x8 At[4][2], B0[2][2], B1[2][2];
    const char* cA = cur.A; const char* cB = cur.B;
    PG8_STAGE(PG8_SB(0, 0), cB, voffB); PG8_STAGE(PG8_SB(0, 1), cB + hstep, voffB); PG8_STAGE(PG8_SA(0, 0), cA, voffA); PG8_STAGE(PG8_SA(0, 1), cA + hstep, voffA);
    if (wr == 1) PG8_BAR;
    PG8_WAIT_V(2); PG8_BAR;
    PG8_STAGE(PG8_SB(1, 0), cB + kstep, voffB); PG8_STAGE(PG8_SA(1, 0), cA + kstep, voffA); PG8_STAGE(PG8_SB(1, 1), cB + hstep + kstep, voffB);
    PG8_WAIT_V(6); PG8_BAR;
    for (;;) {
        const bool has_next = S.next(ui + 1, nxt);
        const char* nA = has_next ? nxt.A : cA; const char* nB = has_next ? nxt.B : cB;
        for (int t = 0; t < nt; t += 2) {
            const bool last = (t == nt - 2);
            const char* a1 = cA + (size_t)(t + 1) * kstep;
            const char* a2 = last ? nA : cA + (size_t)(t + 2) * kstep; const char* b2 = last ? nB : cB + (size_t)(t + 2) * kstep;
            const char* a3 = a2 + kstep; const char* b3 = b2 + kstep;
            PG8_LDB(B0, 0, 0); PG8_LDB(B1, 0, 1); PG8_SCHED; PG8_LDA(At, 0, 0); PG8_STAGE(PG8_SA(1, 1), a1 + hstep, voffA);
            PG8_WAIT_V(8); PG8_WAIT_L(0); PG8_BAR; PG8_MMA(0, 0, At, B0); PG8_MMA(0, 1, At, B1); PG8_BAR; PG8_SCHED;
            PG8_LDA(At, 0, 1); PG8_STAGE(PG8_SB(0, 0), b2, voffB); PG8_STAGE(PG8_SB(0, 1), b2 + hstep, voffB); PG8_STAGE(PG8_SA(0, 0), a2, voffA);
            PG8_WAIT_V(8); PG8_WAIT_L(0); PG8_BAR; PG8_MMA(1, 0, At, B0); PG8_MMA(1, 1, At, B1); PG8_BAR; PG8_SCHED;
            PG8_LDB(B0, 1, 0); PG8_LDB(B1, 1, 1); PG8_SCHED; PG8_LDA(At, 1, 0); PG8_STAGE(PG8_SA(0, 1), a2 + hstep, voffA);
            PG8_WAIT_V(8); PG8_WAIT_L(0); PG8_BAR; PG8_MMA(0, 0, At, B0); PG8_MMA(0, 1, At, B1); PG8_BAR; PG8_SCHED;
            PG8_LDA(At, 1, 1); PG8_STAGE(PG8_SB(1, 0), b3, voffB); PG8_STAGE(PG8_SB(1, 1), b3 + hstep, voffB); PG8_STAGE(PG8_SA(1, 0), a3, voffA);
            PG8_WAIT_V(8); PG8_WAIT_L(0); PG8_BAR; PG8_MMA(1, 0, At, B0); PG8_MMA(1, 1, At, B1); PG8_BAR; PG8_SCHED;
        }
        if (wr == 0) PG8_BAR;
        E(acc, cur, wr, wc, fr, fq);
        if (!has_next) break;
#pragma unroll
        for (int a = 0; a < 2; ++a)
#pragma unroll
            for (int b = 0; b < 2; ++b)
#pragma unroll
                for (int m = 0; m < 4; ++m)
#pragma unroll
                    for (int n = 0; n < 2; ++n) acc[a][b][m][n] = (f32x4){0.f, 0.f, 0.f, 0.f};
        cur = nxt; cA = nA; cB = nB; ++ui;
        if (wr == 1) PG8_BAR;
    }
    PG8_WAIT_V(0);
    PG8_BAR;
#undef PG8_SA
#undef PG8_SB
#undef PG8_STAGE
#undef PG8_LDA
#undef PG8_LDB
#undef PG8_MMA
#undef PG8_WAIT_V
#undef PG8_WAIT_L
#undef PG8_BAR
#undef PG8_SCHED
}
}
#define GAS __attribute__((address_space(1)))
#define LAS __attribute__((address_space(3)))
typedef unsigned short bf16;
typedef unsigned v4u __attribute__((ext_vector_type(4)));
typedef unsigned v2u __attribute__((ext_vector_type(2)));
typedef float f32x4 __attribute__((ext_vector_type(4)));
typedef float f32x2 __attribute__((ext_vector_type(2)));
typedef short bf16x8 __attribute__((ext_vector_type(8)));
typedef short bf16x4 __attribute__((ext_vector_type(4)));
typedef GAS unsigned gu32;
#define RLX_AGENT __ATOMIC_RELAXED, __HIP_MEMORY_SCOPE_AGENT
#define LDS_WAIT() asm volatile("s_waitcnt lgkmcnt(0)" ::: "memory")
#define VM_WAIT() asm volatile("s_waitcnt vmcnt(0)" ::: "memory")
__device__ __forceinline__ unsigned f2bf(float f) { return pg8::cvt_pk_bf16(f, 0.f) & 0xffffu; }
__device__ __forceinline__ unsigned pk2(float lo, float hi) { return pg8::cvt_pk_bf16(lo, hi); }
__device__ __forceinline__ float bf2f(unsigned h) { return __builtin_bit_cast(float, h << 16); }
__device__ __forceinline__ float bflo(unsigned w) { return __builtin_bit_cast(float, w << 16); }
__device__ __forceinline__ float bfhi(unsigned w) { return __builtin_bit_cast(float, w & 0xffff0000u); }
__device__ __forceinline__ float fexp(float x) { return __builtin_amdgcn_exp2f(x * 1.4426950408889634f); }
__device__ __forceinline__ float frcp(float x) { return __builtin_amdgcn_rcpf(x); }
__device__ __forceinline__ float fsigmoid(float x) { return frcp(1.f + fexp(-x)); }
__device__ __forceinline__ float fsilu(float x) { return x * fsigmoid(x); }
__device__ __forceinline__ float ftanh(float x) { const float e = fexp(2.f * x); return 1.f - 2.f * frcp(e + 1.f); }
__device__ __forceinline__ float fgelu_tanh(float x) { const float u = 0.7978845608028654f * (x + 0.044715f * x * x * x); return 0.5f * x * (1.f + ftanh(u)); }
__device__ __forceinline__ float wave_sum(float v) {
#pragma unroll
    for (int o = 1; o < 64; o <<= 1) v += __shfl_xor(v, o);
    return v;
}

#define XB_TMO      128
#define XB_XCNT(j)  (256  + 64 * (j))
#define XB_XSUB(j)  (1280 + 64 * (j))
#define XB_XGEN(j)  (2304 + 64 * (j))
#define XB_TOP      3328
#define XB_TOPGEN   3392
#define XCD_BAR_WORDS 3456
#define XB_SPIN_CAP (1u << 22)
__device__ __forceinline__ unsigned xb_ld(unsigned* p)              { return __hip_atomic_load(p, __ATOMIC_RELAXED, __HIP_MEMORY_SCOPE_AGENT); }
__device__ __forceinline__ unsigned xb_add(unsigned* p, unsigned v) { return __hip_atomic_fetch_add(p, v, __ATOMIC_RELAXED, __HIP_MEMORY_SCOPE_AGENT); }
__device__ __forceinline__ unsigned xb_xcc_id() { return (unsigned)__builtin_amdgcn_s_getreg((3 << 11) | 20) & 0xFu; }
#define XB_SPIN(cond, bar) do { unsigned _sp = 0; while (cond) { __builtin_amdgcn_s_sleep(1); \
    if ((++_sp & 255u) == 0u) { if (xb_ld(&(bar)[XB_TMO])) break; if (_sp > XB_SPIN_CAP) { atomicAdd(&(bar)[XB_TMO], 1u); break; } } } } while (0)
struct XcdBarrier { unsigned* bar; unsigned x; volatile LAS unsigned* st; };
__device__ __forceinline__ XcdBarrier xcd_barrier_post(unsigned* bar, volatile LAS unsigned* st) {
    XcdBarrier b; b.bar = bar; b.x = xb_xcc_id(); b.st = st;
    if (threadIdx.x == 0) (void)xb_add(&bar[XB_XCNT(b.x)], 1u);
    return b;
}
__device__ __forceinline__ void xcd_barrier_complete(unsigned* bar, unsigned x, unsigned& nloc, unsigned& nx) {
    const unsigned G = gridDim.x * gridDim.y * gridDim.z;
    unsigned sum, cnt, mine, sp = 0u;
    for (;;) {
        sum = 0u; cnt = 0u; mine = 0u;
#pragma unroll
        for (unsigned j = 0; j < 16; ++j) { const unsigned c = xb_ld(&bar[XB_XCNT(j)]); sum += c; cnt += (c > 0u) ? 1u : 0u; mine = (j == x) ? c : mine; }
        if (sum == G) break;
        __builtin_amdgcn_s_sleep(1);
        if ((++sp & 255u) == 0u) { if (xb_ld(&bar[XB_TMO])) break; if (sp > XB_SPIN_CAP) { atomicAdd(&bar[XB_TMO], 1u); break; } }
    }
    nloc = mine > 0u ? mine : 1u; nx = cnt > 0u ? cnt : 1u;
}
__device__ __forceinline__ void xcd_barrier(const XcdBarrier& b) {
    asm volatile("s_waitcnt vmcnt(0)" ::: "memory");
    __syncthreads();
    if (threadIdx.x == 0) {
        unsigned* bar = b.bar;
        __builtin_amdgcn_s_waitcnt(0);
        unsigned nloc = b.st[0], nx = b.st[1];
        if (nloc == 0u) { xcd_barrier_complete(bar, b.x, nloc, nx); b.st[0] = nloc; b.st[1] = nx; }
        const unsigned old = xb_add(&bar[XB_XSUB(b.x)], 1u);
        const unsigned gen = old / nloc;
        if (old + 1u == (gen + 1u) * nloc) {
            __builtin_amdgcn_fence(__ATOMIC_RELEASE, "agent");
            asm volatile("s_waitcnt vmcnt(0)" ::: "memory");
            const unsigned og = xb_add(&bar[XB_TOP], 1u);
            const unsigned tg = og / nx;
            if (og + 1u == (tg + 1u) * nx) xb_add(&bar[XB_TOPGEN], 1u);
            else XB_SPIN(xb_ld(&bar[XB_TOPGEN]) == tg, bar);
            __builtin_amdgcn_fence(__ATOMIC_ACQUIRE, "agent");
            xb_add(&bar[XB_XGEN(b.x)], 1u);
            asm volatile("s_waitcnt vmcnt(0)" ::: "memory");
        } else {
            XB_SPIN(xb_ld(&bar[XB_XGEN(b.x)]) == gen, bar);
            __builtin_amdgcn_fence(__ATOMIC_ACQUIRE, "agent");
            asm volatile("s_waitcnt vmcnt(0)" ::: "memory");
        }
    }
    __syncthreads();
}

template <int KSTEPS>
__device__ __forceinline__ f32x4 mm_tile(const LAS bf16* Am, int lda, const LAS bf16* Bn, int ldb, int m0, int n0, f32x4 acc, int fr, int fq) {
    const LAS bf16* ap = Am + (m0 + fr) * lda + fq * 8;
    const LAS bf16* bp = Bn + (n0 + fr) * ldb + fq * 8;
#pragma unroll
    for (int ks = 0; ks < KSTEPS; ++ks) {
        const bf16x8 a = *(const LAS bf16x8*)(ap + ks * 32);
        const bf16x8 b = *(const LAS bf16x8*)(bp + ks * 32);
        acc = __builtin_amdgcn_mfma_f32_16x16x32_bf16(b, a, acc, 0, 0, 0);
    }
    return acc;
}
__device__ __forceinline__ v2u pk4(f32x4 v) { v2u r; r.x = pk2(v[0], v[1]); r.y = pk2(v[2], v[3]); return r; }
constexpr int NWAVES = 8, NTHREADS = 512;
constexpr int BATCH = 2, T = 8192, D = 1024, M = BATCH * T;
constexpr int MIX_IN = 3072, DFF = 2816, NEXP = 8, DFE = 1408, NH = 16, HS = 64;
constexpr int NRW = 3328;
constexpr int XG_ROWS = 34816;
constexpr float RMS_EPS = 1e-6f, LN_EPS = 1e-5f, GN_EPS = 64e-5f;
constexpr size_t MiB = 1u << 20, KiB = 1024;
constexpr size_t WS_CTL = 0, CTL_ZERO_BYTES = 1 * MiB;
constexpr size_t WS_WSM = 1 * MiB;
constexpr size_t WS_LB = 1 * MiB + 128 * KiB;
constexpr size_t WS_WIN = 2 * MiB, WS_WOUT = 8 * MiB, WS_WGU = 10 * MiB, WS_WD = 21 * MiB, WS_WR = 26 * MiB + 512 * KiB, WS_WO = 39 * MiB + 512 * KiB, WS_W2T = 41 * MiB + 512 * KiB;
constexpr size_t WS_XN = 42 * MiB;
constexpr size_t WS_Z = 74 * MiB;
constexpr size_t WS_HGI = 170 * MiB, WS_HGS = 202 * MiB, WS_HGD = 234 * MiB;
constexpr size_t WS_HF = 74 * MiB;
constexpr size_t WS_A2 = 42 * MiB;
constexpr size_t WS_R = 106 * MiB, WS_K = 138 * MiB, WS_V = 170 * MiB, WS_LR = 202 * MiB, WS_RKS = 210 * MiB, WS_S0 = 211 * MiB;
constexpr size_t WS_OMT = 42 * MiB, WS_YL = 74 * MiB;
constexpr size_t WS_WEGU = 2 * MiB, WS_WED = 46 * MiB, WS_XG = 68 * MiB, WS_HE = 136 * MiB, WS_XN3 = 136 * MiB, WS_ROUTE = 240 * MiB;
constexpr size_t WS_END = 256 * MiB;
constexpr size_t RT_E = 0, RT_POS = 128 * KiB, RT_W = 256 * KiB, RT_SLOT = 384 * KiB, RT_SLOTW = 512 * KiB;
constexpr int CW_BAR = 4096;
constexpr int CW_CNT = 64;
constexpr int LDS_BYTES = 155648, MISC_OFF = 153600;
struct Frame {
    LAS unsigned char* lds;
    int tid, lane, wave, vcu, G;
    const float* in[37];
    float* out;
    unsigned char* ws;
};
template <class Tp> __device__ __forceinline__ Tp* wsp(const Frame& F, size_t off) { return (Tp*)(F.ws + off); }

enum { I_X = 0, I_NMG, I_NFG, I_NOG, I_WIN, I_WOUT, I_GNG, I_GWS, I_GBS, I_LBL, I_ONG, I_FG, I_FU, I_FD,
       I_RMIX, I_RWR, I_RWK, I_RWV, I_RWO, I_RW0, I_RW1, I_RW2, I_RA0, I_RA1, I_RA2, I_RG1, I_RG2, I_RKK, I_RKA, I_RRK, I_RLG, I_RLB,
       I_MR, I_MRB, I_MG, I_MU, I_MD };

struct Job { const float* src; int K, N; bf16* dst; int ldd, rowbase, kofs; const float* scale; int ilv; };
__device__ __forceinline__ int job_items(const Job& j) { return (j.K / 64) * (j.N / 32); }
__device__ __forceinline__ void conv_item(const Job& J, int item, LAS float* scr, int lane) {
    const int nblk = J.N / 32, kb = item / nblk, nb = item % nblk, k0 = 64 * kb, n0 = 32 * nb;
    const int drow0 = J.ilv ? ((n0 >> 7) * 256 + (J.ilv - 1) * 128 + (n0 & 127)) : (J.rowbase + n0);
#pragma unroll 8
    for (int i = 0; i < 32; ++i) { const int kk = 2 * i + (lane >> 5); float v = J.src[(size_t)(k0 + kk) * J.N + n0 + (lane & 31)]; if (J.scale) v *= J.scale[k0 + kk]; scr[kk * 33 + (lane & 31)] = v; }
    LDS_WAIT(); asm volatile("" ::: "memory");
    const int c = lane & 7;
#pragma unroll
    for (int j = 0; j < 4; ++j) { const int n = (lane >> 3) + 8 * j; const LAS float* s = scr + (8 * c) * 33 + n;
        v4u o; o.x = pk2(s[0 * 33], s[1 * 33]); o.y = pk2(s[2 * 33], s[3 * 33]); o.z = pk2(s[4 * 33], s[5 * 33]); o.w = pk2(s[6 * 33], s[7 * 33]);
        *(v4u*)(J.dst + (size_t)(drow0 + n) * J.ldd + J.kofs + k0 + 8 * c) = o; }
    LDS_WAIT(); asm volatile("" ::: "memory");
}
__device__ __forceinline__ Job p0_job(const Frame& F, int j) {
    Job J; J.scale = nullptr; J.ilv = 0; J.rowbase = 0; J.kofs = 0;
    const float* mix = F.in[I_RMIX];
    switch (j) {
    case 0: J.src = F.in[I_WIN]; J.K = 1024; J.N = 3072; J.dst = wsp<bf16>(F, WS_WIN); J.ldd = 1024; break;
    case 1: J.src = F.in[I_WOUT]; J.K = 1024; J.N = 1024; J.dst = wsp<bf16>(F, WS_WOUT); J.ldd = 1024; break;
    case 2: J.src = F.in[I_FG]; J.K = 1024; J.N = DFF; J.dst = wsp<bf16>(F, WS_WGU); J.ldd = 1024; J.ilv = 1; break;
    case 3: J.src = F.in[I_FU]; J.K = 1024; J.N = DFF; J.dst = wsp<bf16>(F, WS_WGU); J.ldd = 1024; J.ilv = 2; break;
    case 4: J.src = F.in[I_FD]; J.K = DFF; J.N = 1024; J.dst = wsp<bf16>(F, WS_WD); J.ldd = DFF; break;
    case 5: J.src = F.in[I_RWO]; J.K = 1024; J.N = 1024; J.dst = wsp<bf16>(F, WS_WO); J.ldd = 1024; break;
    case 6: J.src = F.in[I_RW2]; J.K = 64; J.N = 1024; J.dst = wsp<bf16>(F, WS_W2T); J.ldd = 64; break;
    case 7: J.src = F.in[I_RA2]; J.K = 64; J.N = 1024; J.dst = wsp<bf16>(F, WS_W2T) + 1024 * 64; J.ldd = 64; break;
    case 8: J.src = F.in[I_RG2]; J.K = 128; J.N = 1024; J.dst = wsp<bf16>(F, WS_W2T) + 2 * 1024 * 64; J.ldd = 128; break;
    default: {
        const int q = (j - 9) >> 1, sc = (j - 9) & 1;
        J.K = 1024; J.dst = wsp<bf16>(F, WS_WR); J.ldd = 2048; J.kofs = sc ? 1024 : 0;
        if (q == 0) { J.src = F.in[I_RWR]; J.N = 1024; J.rowbase = 0; if (sc) J.scale = mix + 0 * 1024; }
        else if (q == 1) { J.src = F.in[I_RWK]; J.N = 1024; J.rowbase = 1024; if (sc) J.scale = mix + 2 * 1024; }
        else if (q == 2) { J.src = F.in[I_RWV]; J.N = 1024; J.rowbase = 2048; if (sc) J.scale = mix + 3 * 1024; }
        else if (q == 3) { J.src = F.in[I_RW1]; J.N = 64; J.rowbase = 3072; if (sc) J.scale = mix + 1 * 1024; }
        else if (q == 4) { J.src = F.in[I_RA1]; J.N = 64; J.rowbase = 3136; if (sc) J.scale = mix + 4 * 1024; }
        else { J.src = F.in[I_RG1]; J.N = 128; J.rowbase = 3200; if (sc) J.scale = mix + 5 * 1024; }
    } }
    return J;
}
constexpr int P0_NJOBS = 21;
__device__ __forceinline__ Job moe_job(const Frame& F, int j) {
    Job J; J.scale = nullptr; J.rowbase = 0; J.kofs = 0; J.ilv = 0;
    const int e = j / 3, w = j % 3;
    if (w < 2) { J.src = F.in[w == 0 ? I_MG : I_MU] + (size_t)e * 1024 * DFE; J.K = 1024; J.N = DFE; J.dst = wsp<bf16>(F, WS_WEGU) + (size_t)e * 2 * DFE * 1024; J.ldd = 1024; J.ilv = w + 1; }
    else { J.src = F.in[I_MD] + (size_t)e * DFE * 1024; J.K = DFE; J.N = 1024; J.dst = wsp<bf16>(F, WS_WED) + (size_t)e * 1024 * DFE; J.ldd = DFE; }
    return J;
}
__device__ __forceinline__ void rms_row(const float* xrow, const float* g, int lane, f32x4 (&v)[4]) {
    const f32x4* xr = (const f32x4*)xrow + lane; float s = 0.f;
#pragma unroll
    for (int j = 0; j < 4; ++j) { v[j] = xr[64 * j]; s += (v[j].x * v[j].x + v[j].y * v[j].y) + (v[j].z * v[j].z + v[j].w * v[j].w); }
    const float rs = 1.f / sqrtf(wave_sum(s) * (1.f / D) + RMS_EPS);
    const f32x4* gr = (const f32x4*)g + lane;
#pragma unroll
    for (int j = 0; j < 4; ++j) v[j] = v[j] * rs * gr[64 * j];
}
__device__ __forceinline__ void store_row_bf16(bf16* orow, int lane, const f32x4 (&v)[4]) {
    v2u* o8 = (v2u*)orow + lane;
#pragma unroll
    for (int j = 0; j < 4; ++j) o8[64 * j] = pk4(v[j]);
}
__device__ __forceinline__ void run_jobs(const Frame& F, bool moe) {
    LAS float* scr = (LAS float*)(F.lds + F.wave * 16384);
    const int gw = F.vcu * NWAVES + F.wave, NGW = F.G * NWAVES;
    const int njobs = moe ? 24 : P0_NJOBS;
    int base = 0;
    for (int j = 0; j < njobs; ++j) {
        const Job J = moe ? moe_job(F, j) : p0_job(F, j);
        const int n = job_items(J);
        int it = (gw - base % NGW + NGW) % NGW;
        for (; it < n; it += NGW) conv_item(J, it, scr, F.lane);
        base += n;
    }
}
__device__ __forceinline__ void p0_prologue(const Frame& F) {
    run_jobs(F, false);
    const int gt = F.vcu * NTHREADS + F.tid, NGT = F.G * NTHREADS;
    { const float* ws = F.in[I_GWS]; bf16* o = wsp<bf16>(F, WS_WSM);
      for (int i = gt; i < 4 * 128 * 128; i += NGT) { const int t = (i >> 7) & 127, s = i & 127; o[i] = (bf16)f2bf(s <= t ? ws[i] : 0.f); } }
    { const float* l = F.in[I_LBL]; float* o = wsp<float>(F, WS_LB);
      for (int i = gt; i < 512; i += NGT) { const float a = l[i], b = l[512 + i], mx = fmaxf(a, b), ea = expf(a - mx), eb = expf(b - mx); o[i] = ea / (ea + eb); } }
    const int gw = F.vcu * NWAVES + F.wave, NGW = F.G * NWAVES;
    bf16* XN = wsp<bf16>(F, WS_XN);
    for (int m = gw; m < M; m += NGW) { f32x4 v[4]; rms_row(F.in[I_X] + (size_t)m * D, F.in[I_NMG], F.lane, v); store_row_bf16(XN + (size_t)m * D, F.lane, v); }
}
namespace epi {
using pg8::Unit; using pg8::HALF; using pg8::BM;
typedef float f32x4 __attribute__((ext_vector_type(4)));
struct MixIn {
    static constexpr bool PERM = true;
    bf16* Z; const float* lb;
    __device__ __forceinline__ void operator()(const f32x4 (&acc)[2][2][4][2], const Unit& u, int wr, int wc, int fr, int fq) const {
        const int seg = u.pn >> 1;
        const int row0 = u.pm * BM + wr * 64 + fr, col0 = u.pn * BM + wc * 32 + 8 * fq;
#pragma unroll
        for (int ai = 0; ai < 2; ++ai)
#pragma unroll
            for (int m = 0; m < 4; ++m) { bf16* rowp = Z + (size_t)(row0 + ai * HALF + m * 16) * MIX_IN + col0;
#pragma unroll
                for (int bj = 0; bj < 2; ++bj) { float v[8];
#pragma unroll
                    for (int i = 0; i < 4; ++i) { v[i] = acc[ai][bj][m][0][i]; v[4 + i] = acc[ai][bj][m][1][i]; }
                    if (seg < 2) {
#pragma unroll
                        for (int i = 0; i < 8; ++i) v[i] = fgelu_tanh(v[i]);
                    } else if (seg == 2 || seg == 5) {
#pragma unroll
                        for (int i = 0; i < 8; ++i) v[i] = fsilu(v[i]);
                    } else if (seg == 3) {
                        const float* lbp = lb + (col0 + bj * HALF - 1536);
#pragma unroll
                        for (int i = 0; i < 8; ++i) { const float l = lbp[i]; v[i] = __logf(l + (1.f - l) * fsigmoid(v[i])); }
                    }
                    v4u w; w.x = pk2(v[0], v[1]); w.y = pk2(v[2], v[3]); w.z = pk2(v[4], v[5]); w.w = pk2(v[6], v[7]);
                    *(v4u*)(rowp + bj * HALF) = w; } }
    }
};
struct Resid {
    static constexpr bool PERM = false;
    const float* base; float* out;
    __device__ __forceinline__ void operator()(const f32x4 (&acc)[2][2][4][2], const Unit& u, int wr, int wc, int fr, int fq) const {
        const int row0 = u.pm * BM + wr * 64 + fr, col0 = u.pn * BM + wc * 32 + 4 * fq;
#pragma unroll
        for (int ai = 0; ai < 2; ++ai)
#pragma unroll
            for (int m = 0; m < 4; ++m) { const size_t off = (size_t)(row0 + ai * HALF + m * 16) * D + col0;
#pragma unroll
                for (int bj = 0; bj < 2; ++bj)
#pragma unroll
                    for (int n = 0; n < 2; ++n) { const size_t p = off + bj * HALF + n * 16; const f32x4 b = *(const f32x4*)(base + p); *(f32x4*)(out + p) = b + acc[ai][bj][m][n]; } }
    }
};
struct SwiGlu {
    static constexpr bool PERM = true;
    bf16* H; int ld; const float* rowscale;
    __device__ __forceinline__ void operator()(const f32x4 (&acc)[2][2][4][2], const Unit& u, int wr, int wc, int fr, int fq) const {
        const int row0 = u.pm * BM + wr * 64 + fr, col0 = u.pn * HALF + wc * 32 + 8 * fq;
#pragma unroll
        for (int ai = 0; ai < 2; ++ai)
#pragma unroll
            for (int m = 0; m < 4; ++m) { const int row = row0 + ai * HALF + m * 16; const float sc = rowscale ? rowscale[row] : 1.f; float v[8];
#pragma unroll
                for (int i = 0; i < 4; ++i) { v[i] = fsilu(acc[ai][0][m][0][i]) * acc[ai][1][m][0][i] * sc; v[4 + i] = fsilu(acc[ai][0][m][1][i]) * acc[ai][1][m][1][i] * sc; }
                v4u w; w.x = pk2(v[0], v[1]); w.y = pk2(v[2], v[3]); w.z = pk2(v[4], v[5]); w.w = pk2(v[6], v[7]);
                *(v4u*)(H + (size_t)row * ld + col0) = w; }
    }
};
struct RwkvProj {
    static constexpr bool PERM = true;
    bf16* R; size_t split_stride; bf16* LR;
    __device__ __forceinline__ void operator()(const f32x4 (&acc)[2][2][4][2], const Unit& u, int wr, int wc, int fr, int fq) const {
        const int row0 = u.pm * BM + wr * 64 + fr;
        const bool lora = (u.pn == 12);
        bf16* base = lora ? LR : (R + (size_t)(u.pn >> 2) * split_stride);
        const int ld = lora ? 256 : D;
        const int col0 = (lora ? 0 : (u.pn & 3) * BM) + wc * 32 + 8 * fq;
#pragma unroll
        for (int ai = 0; ai < 2; ++ai)
#pragma unroll
            for (int m = 0; m < 4; ++m) { bf16* rowp = base + (size_t)(row0 + ai * HALF + m * 16) * ld + col0;
#pragma unroll
                for (int bj = 0; bj < 2; ++bj) { float v[8];
#pragma unroll
                    for (int i = 0; i < 4; ++i) { v[i] = acc[ai][bj][m][0][i]; v[4 + i] = acc[ai][bj][m][1][i]; }
                    if (lora) {
                        if (bj == 1) {
#pragma unroll
                            for (int i = 0; i < 8; ++i) v[i] = fsigmoid(v[i]);
                        } else if (wc < 2) {
#pragma unroll
                            for (int i = 0; i < 8; ++i) v[i] = ftanh(v[i]);
                        }
                    }
                    v4u w; w.x = pk2(v[0], v[1]); w.y = pk2(v[2], v[3]); w.z = pk2(v[4], v[5]); w.w = pk2(v[6], v[7]);
                    *(v4u*)(rowp + bj * HALF) = w; } }
    }
};
struct StoreBf16 {
    static constexpr bool PERM = true;
    bf16* O; int ld;
    __device__ __forceinline__ void operator()(const f32x4 (&acc)[2][2][4][2], const Unit& u, int wr, int wc, int fr, int fq) const {
        const int row0 = u.pm * BM + wr * 64 + fr, col0 = u.pn * BM + wc * 32 + 8 * fq;
#pragma unroll
        for (int ai = 0; ai < 2; ++ai)
#pragma unroll
            for (int m = 0; m < 4; ++m) { bf16* rowp = O + (size_t)(row0 + ai * HALF + m * 16) * ld + col0;
#pragma unroll
                for (int bj = 0; bj < 2; ++bj) { const f32x4 v0 = acc[ai][bj][m][0], v1 = acc[ai][bj][m][1];
                    v4u w; w.x = pk2(v0[0], v0[1]); w.y = pk2(v0[2], v0[3]); w.z = pk2(v1[0], v1[1]); w.w = pk2(v1[2], v1[3]);
                    *(v4u*)(rowp + bj * HALF) = w; } }
    }
};
}
constexpr int HG_L = 64, HG_NC = T / HG_L;
__device__ __forceinline__ void gmlp_unit(const Frame& F, int unit) {
    const int g = unit & 3, n = (unit >> 2) & 63, b = unit >> 8;
    const int m0 = b * T + n * 128;
    LAS bf16* WM = (LAS bf16*)F.lds; LAS bf16* VNT = (LAS bf16*)(F.lds + 34816);
    const bf16* Z = wsp<bf16>(F, WS_Z); bf16* Y = wsp<bf16>(F, WS_XN);
    const bf16* wsm = wsp<bf16>(F, WS_WSM) + g * 16384;
    const float* gng = F.in[I_GNG] + g * 128;
#pragma unroll
    for (int i = 0; i < 4; ++i) { const int id = F.tid + 512 * i, row = id >> 4, cc = id & 15;
        *(LAS v4u*)(WM + row * 136 + cc * 8) = *(const v4u*)(wsm + row * 128 + cc * 8); }
#pragma unroll
    for (int i = 0; i < 4; ++i) { const int id = F.tid + 512 * i, s = id >> 4, cc = id & 15;
        const v4u raw = *(const v4u*)(Z + (size_t)(m0 + s) * MIX_IN + 512 + g * 128 + cc * 8);
        float v[8]; v[0] = bflo(raw.x); v[1] = bfhi(raw.x); v[2] = bflo(raw.y); v[3] = bfhi(raw.y); v[4] = bflo(raw.z); v[5] = bfhi(raw.z); v[6] = bflo(raw.w); v[7] = bfhi(raw.w);
        float sm = 0.f;
#pragma unroll
        for (int j = 0; j < 8; ++j) sm += v[j];
        sm += __shfl_xor(sm, 1); sm += __shfl_xor(sm, 2); sm += __shfl_xor(sm, 4); sm += __shfl_xor(sm, 8);
        const float mu = sm * (1.f / 128.f); float sq = 0.f;
#pragma unroll
        for (int j = 0; j < 8; ++j) { v[j] -= mu; sq += v[j] * v[j]; }
        sq += __shfl_xor(sq, 1); sq += __shfl_xor(sq, 2); sq += __shfl_xor(sq, 4); sq += __shfl_xor(sq, 8);
        const float rstd = 1.f / sqrtf(sq * (1.f / 128.f) + LN_EPS);
#pragma unroll
        for (int j = 0; j < 8; ++j) VNT[(cc * 8 + j) * 136 + s] = (bf16)f2bf(v[j] * rstd * gng[cc * 8 + j]); }
    __syncthreads();
    const int fr = F.lane & 15, fq = F.lane >> 4, t0 = 16 * F.wave, nks = (F.wave >> 1) + 1;
    f32x4 acc[8];
#pragma unroll
    for (int j = 0; j < 8; ++j) acc[j] = (f32x4){0.f, 0.f, 0.f, 0.f};
    for (int ks = 0; ks < nks; ++ks) {
        const bf16x8 a = *(const LAS bf16x8*)(WM + (t0 + fr) * 136 + ks * 32 + fq * 8);
#pragma unroll
        for (int j = 0; j < 8; ++j) { const bf16x8 bb = *(const LAS bf16x8*)(VNT + (16 * j + fr) * 136 + ks * 32 + fq * 8);
            acc[j] = __builtin_amdgcn_mfma_f32_16x16x32_bf16(bb, a, acc[j], 0, 0, 0); }
    }
    const int t = t0 + fr; const float bs = F.in[I_GBS][g * 128 + t];
    const bf16* zr = Z + (size_t)(m0 + t) * MIX_IN + g * 128; bf16* yr = Y + (size_t)(m0 + t) * D + g * 128;
#pragma unroll
    for (int j = 0; j < 8; ++j) { const int c = 16 * j + 4 * fq; const v2u ur = *(const v2u*)(zr + c);
        f32x4 o; o[0] = bflo(ur.x) * (acc[j][0] + bs); o[1] = bfhi(ur.x) * (acc[j][1] + bs); o[2] = bflo(ur.y) * (acc[j][2] + bs); o[3] = bfhi(ur.y) * (acc[j][3] + bs);
        *(v2u*)(yr + c) = pk4(o); }
    __syncthreads();
}
__device__ __forceinline__ void hg_load_lf(const bf16* Z, int m0, int h, int k, int tq, float (&lf)[16]) {
#pragma unroll
    for (int i = 0; i < 16; ++i) lf[i] = bf2f(Z[(size_t)(m0 + 16 * tq + i) * MIX_IN + 1536 + h * 128 + k]);
}
__device__ __forceinline__ void hgrn_pre_unit(const Frame& F, int unit) {
    const int c = unit & 127, h = (unit >> 7) & 3, b = unit >> 9;
    const int m0 = b * T + c * HG_L;
    LAS bf16* KDT = (LAS bf16*)F.lds; LAS bf16* VT = (LAS bf16*)(F.lds + 18432); LAS float* PART = (LAS float*)(F.lds + 36864);
    const bf16* Z = wsp<bf16>(F, WS_Z);
    const int k = F.tid & 127, tq = F.tid >> 7;
    float lf[16]; hg_load_lf(Z, m0, h, k, tq, lf);
    float pre[16]; float run = 0.f;
#pragma unroll
    for (int i = 0; i < 16; ++i) { run += lf[i]; pre[i] = run; }
    PART[tq * 128 + k] = run;
    __syncthreads();
    float off = 0.f, bend = 0.f;
#pragma unroll
    for (int q = 0; q < 4; ++q) { const float p = PART[q * 128 + k]; bend += p; off += (q < tq) ? p : 0.f; }
    unsigned kd[8], vv[8];
#pragma unroll
    for (int i = 0; i < 8; ++i) {
        const float k0 = (1.f - fexp(lf[2 * i])) * fexp(bend - (off + pre[2 * i])), k1 = (1.f - fexp(lf[2 * i + 1])) * fexp(bend - (off + pre[2 * i + 1]));
        kd[i] = pk2(k0, k1);
        const unsigned v0 = Z[(size_t)(m0 + 16 * tq + 2 * i) * MIX_IN + 2048 + h * 128 + k], v1 = Z[(size_t)(m0 + 16 * tq + 2 * i + 1) * MIX_IN + 2048 + h * 128 + k];
        vv[i] = v0 | (v1 << 16);
    }
    *(LAS v4u*)(KDT + k * 72 + 16 * tq) = (v4u){kd[0], kd[1], kd[2], kd[3]}; *(LAS v4u*)(KDT + k * 72 + 16 * tq + 8) = (v4u){kd[4], kd[5], kd[6], kd[7]};
    *(LAS v4u*)(VT + k * 72 + 16 * tq) = (v4u){vv[0], vv[1], vv[2], vv[3]}; *(LAS v4u*)(VT + k * 72 + 16 * tq + 8) = (v4u){vv[4], vv[5], vv[6], vv[7]};
    if (tq == 0) wsp<float>(F, WS_HGD)[unit * 128 + k] = fexp(bend);
    __syncthreads();
    const int fr = F.lane & 15, fq = F.lane >> 4, v0 = 16 * F.wave;
    bf16* inc = wsp<bf16>(F, WS_HGI) + (size_t)unit * 16384;
#pragma unroll
    for (int j = 0; j < 8; ++j) { f32x4 acc = (f32x4){0.f, 0.f, 0.f, 0.f};
        acc = mm_tile<2>(VT, 72, KDT, 72, v0, 16 * j, acc, fr, fq);
        *(v2u*)(inc + (v0 + fr) * 128 + 16 * j + 4 * fq) = pk4(acc); }
    __syncthreads();
}
__device__ __forceinline__ void hgrn_scan(const Frame& F) {
    for (int gt = F.vcu * NTHREADS + F.tid; gt < 8 * 4096; gt += F.G * NTHREADS) {
    const int bh = gt >> 12, e = (gt & 4095) * 4, k = e & 127;
    const bf16* __restrict__ inc = wsp<bf16>(F, WS_HGI) + (size_t)bh * HG_NC * 16384 + e;
    bf16* __restrict__ st = wsp<bf16>(F, WS_HGS) + (size_t)bh * HG_NC * 16384 + e;
    const float* __restrict__ dd = wsp<float>(F, WS_HGD) + (size_t)bh * HG_NC * 128 + k;
    f32x4 S = (f32x4){0.f, 0.f, 0.f, 0.f};
#pragma unroll 4
    for (int c = 0; c < HG_NC; ++c) {
        const v2u iv = *(const v2u*)(inc + (size_t)c * 16384); const f32x4 d = *(const f32x4*)(dd + c * 128);
        *(v2u*)(st + (size_t)c * 16384) = pk4(S);
        S[0] = d[0] * S[0] + bflo(iv.x); S[1] = d[1] * S[1] + bfhi(iv.x); S[2] = d[2] * S[2] + bflo(iv.y); S[3] = d[3] * S[3] + bfhi(iv.y);
    }
    }
}
__device__ __forceinline__ void hgrn_post_unit(const Frame& F, int unit) {
    const int c = unit & 127, h = (unit >> 7) & 3, b = unit >> 9;
    const int m0 = b * T + c * HG_L;
    LAS bf16* QD = (LAS bf16*)F.lds; LAS bf16* QP = (LAS bf16*)(F.lds + 17408); LAS bf16* KP = (LAS bf16*)(F.lds + 34816);
    LAS bf16* VT = (LAS bf16*)(F.lds + 52224); LAS bf16* SC = (LAS bf16*)(F.lds + 70656);
    LAS float* PART = (LAS float*)(F.lds + 79872); LAS float* RS = (LAS float*)(F.lds + 81920);
    const bf16* Z = wsp<bf16>(F, WS_Z); bf16* Y = wsp<bf16>(F, WS_XN);
    const int k = F.tid & 127, tq = F.tid >> 7;
    float lf[16]; hg_load_lf(Z, m0, h, k, tq, lf);
    float pre[16]; float run = 0.f;
#pragma unroll
    for (int i = 0; i < 16; ++i) { run += lf[i]; pre[i] = run; }
    PART[tq * 128 + k] = run;
    __syncthreads();
    const float p0 = PART[k], p1 = PART[128 + k], p2 = PART[256 + k];
    const float off = (tq > 0 ? p0 : 0.f) + (tq > 1 ? p1 : 0.f) + (tq > 2 ? p2 : 0.f), bm = p0 + p1;
    unsigned vv[8];
#pragma unroll
    for (int i = 0; i < 16; ++i) {
        const int t = 16 * tq + i; const float bb = off + pre[i];
        const float q = bf2f(Z[(size_t)(m0 + t) * MIX_IN + 1024 + h * 128 + k]);
        const float kk = 1.f - fexp(lf[i]);
        const float dq = fminf(fmaxf(bb - bm, -80.f), 80.f);
        QD[t * 136 + k] = (bf16)f2bf(q * fexp(bb)); QP[t * 136 + k] = (bf16)f2bf(q * fexp(dq)); KP[t * 136 + k] = (bf16)f2bf(kk * fexp(-dq));
        const unsigned vr = Z[(size_t)(m0 + t) * MIX_IN + 2048 + h * 128 + k];
        if (i & 1) vv[i >> 1] |= vr << 16; else vv[i >> 1] = vr;
    }
    *(LAS v4u*)(VT + k * 72 + 16 * tq) = (v4u){vv[0], vv[1], vv[2], vv[3]}; *(LAS v4u*)(VT + k * 72 + 16 * tq + 8) = (v4u){vv[4], vv[5], vv[6], vv[7]};
    __syncthreads();
    const int fr = F.lane & 15, fq = F.lane >> 4, t0 = 16 * (F.wave >> 1);
#pragma unroll
    for (int j = 0; j < 2; ++j) { const int s0 = 16 * (2 * (F.wave & 1) + j); f32x4 acc = (f32x4){0.f, 0.f, 0.f, 0.f};
        if (s0 <= t0) acc = mm_tile<4>(QP, 136, KP, 136, t0, s0, acc, fr, fq);
        const int t = t0 + fr, s = s0 + 4 * fq;
#pragma unroll
        for (int i = 0; i < 4; ++i) acc[i] = (s + i <= t) ? acc[i] : 0.f;
        *(LAS v2u*)(SC + t * 72 + s) = pk4(acc); }
    __syncthreads();
    const bf16* ST = wsp<bf16>(F, WS_HGS) + (size_t)unit * 16384;
    f32x4 o[4]; float ss = 0.f;
#pragma unroll
    for (int j = 0; j < 4; ++j) { const int v0 = 16 * (4 * (F.wave & 1) + j); f32x4 acc = (f32x4){0.f, 0.f, 0.f, 0.f};
        acc = mm_tile<2>(SC, 72, VT, 72, t0, v0, acc, fr, fq);
#pragma unroll
        for (int ks = 0; ks < 4; ++ks) { const bf16x8 a = *(const LAS bf16x8*)(QD + (t0 + fr) * 136 + ks * 32 + fq * 8);
            const bf16x8 bb = *(const bf16x8*)(ST + (v0 + fr) * 128 + ks * 32 + fq * 8);
            acc = __builtin_amdgcn_mfma_f32_16x16x32_bf16(bb, a, acc, 0, 0, 0); }
        o[j] = acc; ss += (acc[0] * acc[0] + acc[1] * acc[1]) + (acc[2] * acc[2] + acc[3] * acc[3]); }
    ss += __shfl_xor(ss, 16); ss += __shfl_xor(ss, 32);
    if (fq == 0) RS[(t0 + fr) * 2 + (F.wave & 1)] = ss;
    __syncthreads();
    const int t = t0 + fr; const float rstd = 1.f / sqrtf((RS[t * 2] + RS[t * 2 + 1]) * (1.f / 128.f) + RMS_EPS);
    const float* ong = F.in[I_ONG];
#pragma unroll
    for (int j = 0; j < 4; ++j) { const int v = 16 * (4 * (F.wave & 1) + j) + 4 * fq;
        const v2u sg = *(const v2u*)(Z + (size_t)(m0 + t) * MIX_IN + 2560 + h * 128 + v); const f32x4 gg = *(const f32x4*)(ong + v);
        f32x4 r; r[0] = o[j][0] * rstd * gg[0] * bflo(sg.x); r[1] = o[j][1] * rstd * gg[1] * bfhi(sg.x); r[2] = o[j][2] * rstd * gg[2] * bflo(sg.y); r[3] = o[j][3] * rstd * gg[3] * bfhi(sg.y);
        *(v2u*)(Y + (size_t)(m0 + t) * D + 512 + h * 128 + v) = pk4(r); }
    __syncthreads();
}
constexpr int RW_L = 64, RW_NC = T / RW_L;
constexpr int SLOT = 9216;
constexpr int RW_MISC = 16 * SLOT;
#define RW_S(i) ((LAS bf16*)(F.lds + (i) * SLOT))
__device__ __forceinline__ float softplusf(float x) { return fmaxf(x, 0.f) + __logf(1.f + fexp(-fabsf(x))); }
__device__ __forceinline__ void rwkv_pre_unit(const Frame& F, int unit) {
    const int c = unit & 127, h = (unit >> 7) & 15, b = unit >> 11;
    const int m0 = b * T + c * RW_L, hc0 = h * 64;
    bf16* Rb = wsp<bf16>(F, WS_R); bf16* Kb = wsp<bf16>(F, WS_K); const bf16* Vb = wsp<bf16>(F, WS_V); const bf16* LR = wsp<bf16>(F, WS_LR);
    const bf16* w2t = wsp<bf16>(F, WS_W2T); const bf16* a2t = w2t + 1024 * 64;
    LAS float* LW = (LAS float*)(F.lds + 5 * SLOT); LAS float* AA = (LAS float*)(F.lds + 7 * SLOT);
    LAS float* PARTW = (LAS float*)(F.lds + RW_MISC); LAS float* WLs = PARTW + 512;
    const int tid = F.tid, lane = F.lane, wave = F.wave, fr = lane & 15, fq = lane >> 4;
    const int mt = wave >> 1, ntb = 2 * (wave & 1);
    { const int row = tid >> 3, cc = tid & 7; const size_t g = (size_t)(m0 + row) * D + hc0 + cc * 8;
      *(LAS v4u*)(RW_S(0) + row * 72 + cc * 8) = *(const v4u*)(Rb + g);
      *(LAS v4u*)(RW_S(1) + row * 72 + cc * 8) = *(const v4u*)(Kb + g);
      *(LAS v4u*)(RW_S(2) + row * 72 + cc * 8) = *(const v4u*)(Vb + g);
#pragma unroll
      for (int i = 0; i < 2; ++i) { const int id = tid + 512 * i, r2 = id >> 4, c2 = id & 15;
          *(LAS v4u*)(RW_S(3) + r2 * 136 + c2 * 8) = *(const v4u*)(LR + (size_t)(m0 + r2) * 256 + c2 * 8); } }
    __syncthreads();
    { LAS bf16* LRT = RW_S(3);
#pragma unroll
      for (int j = 0; j < 2; ++j) { const int n0 = 16 * (ntb + j); f32x4 aw = (f32x4){0.f, 0.f, 0.f, 0.f}, aa = aw;
#pragma unroll
          for (int ks = 0; ks < 2; ++ks) {
              const bf16x8 xw = *(const LAS bf16x8*)(LRT + (16 * mt + fr) * 136 + ks * 32 + fq * 8);
              const bf16x8 xa = *(const LAS bf16x8*)(LRT + (16 * mt + fr) * 136 + 64 + ks * 32 + fq * 8);
              const bf16x8 bw = *(const bf16x8*)(w2t + (size_t)(hc0 + n0 + fr) * 64 + ks * 32 + fq * 8);
              const bf16x8 ba = *(const bf16x8*)(a2t + (size_t)(hc0 + n0 + fr) * 64 + ks * 32 + fq * 8);
              aw = __builtin_amdgcn_mfma_f32_16x16x32_bf16(bw, xw, aw, 0, 0, 0);
              aa = __builtin_amdgcn_mfma_f32_16x16x32_bf16(ba, xa, aa, 0, 0, 0); }
          const int t = 16 * mt + fr, cl = n0 + 4 * fq;
          const f32x4 w0 = *(const f32x4*)(F.in[I_RW0] + hc0 + cl), a0 = *(const f32x4*)(F.in[I_RA0] + hc0 + cl);
#pragma unroll
          for (int i = 0; i < 4; ++i) { const float wl = -softplusf(-(w0[i] + aw[i])) - 0.5f; LW[t * 68 + cl + i] = -fexp(wl); AA[t * 68 + cl + i] = fsigmoid(a0[i] + aa[i]); } } }
    __syncthreads();
    { const int cl = lane, tq = wave, hc = hc0 + cl;
      float lw[8], pre[8]; float run = 0.f;
#pragma unroll
      for (int i = 0; i < 8; ++i) { lw[i] = LW[(8 * tq + i) * 68 + cl]; run += lw[i]; pre[i] = run; }
      PARTW[tq * 64 + cl] = run;
      __syncthreads();
      float off = 0.f, cL = 0.f;
#pragma unroll
      for (int q = 0; q < 8; ++q) { const float p = PARTW[q * 64 + cl]; cL += p; off += (q < tq) ? p : 0.f; }
      if (tq == 0) WLs[cl] = fexp(cL);
      const float kkw = F.in[I_RKK][hc], kaw = F.in[I_RKA][hc], rkw = F.in[I_RRK][hc];
      unsigned aht[4], btt[4], ktt[4], vt[4];
#pragma unroll
      for (int i = 0; i < 8; ++i) {
          const int t = 8 * tq + i;
          const float r = bf2f(RW_S(0)[t * 72 + cl]), k = bf2f(RW_S(1)[t * 72 + cl]); const unsigned vraw = RW_S(2)[t * 72 + cl];
          const float a = AA[t * 68 + cl];
          const float kkr = k * kkw; const float ss = wave_sum(kkr * kkr);
          const float kk = kkr / fmaxf(sqrtf(ss), 1e-12f);
          const float kp = k * (1.f + (a - 1.f) * kaw), bb = kk * a;
          const float rk = wave_sum(r * kp * rkw);
          if (lane == 0) wsp<float>(F, WS_RKS)[(size_t)(m0 + t) * 16 + h] = rk;
          const float cs = off + pre[i];
          const float ep = fexp(cs), em = fexp(-cs), epv = fexp(cs - lw[i]), eL = fexp(cL - cs);
          const unsigned ah = f2bf(epv * kk), bh = f2bf(bb * em), kh = f2bf(kp * em), rh = f2bf(r * ep), bt = f2bf(bb * eL), kt = f2bf(kp * eL);
          RW_S(3)[t * 72 + cl] = (bf16)ah; RW_S(4)[t * 72 + cl] = (bf16)bh; RW_S(9)[t * 72 + cl] = (bf16)kh; RW_S(10)[t * 72 + cl] = (bf16)rh;
          if (i & 1) { aht[i >> 1] |= ah << 16; btt[i >> 1] |= bt << 16; ktt[i >> 1] |= kt << 16; vt[i >> 1] |= vraw << 16; }
          else { aht[i >> 1] = ah; btt[i >> 1] = bt; ktt[i >> 1] = kt; vt[i >> 1] = vraw; }
      }
      *(LAS v4u*)(RW_S(11) + cl * 72 + 8 * tq) = (v4u){aht[0], aht[1], aht[2], aht[3]};
      *(LAS v4u*)(RW_S(12) + cl * 72 + 8 * tq) = (v4u){btt[0], btt[1], btt[2], btt[3]};
      *(LAS v4u*)(RW_S(13) + cl * 72 + 8 * tq) = (v4u){ktt[0], ktt[1], ktt[2], ktt[3]};
      *(LAS v4u*)(RW_S(14) + cl * 72 + 8 * tq) = (v4u){vt[0], vt[1], vt[2], vt[3]}; }
    __syncthreads();
#pragma unroll
    for (int j = 0; j < 2; ++j) { const int n0 = 16 * (ntb + j), t = 16 * mt + fr, jj = n0 + 4 * fq; const f32x4 z = (f32x4){0.f, 0.f, 0.f, 0.f};
        f32x4 gab = mm_tile<2>(RW_S(3), 72, RW_S(4), 72, 16 * mt, n0, z, fr, fq);
        f32x4 gkb = mm_tile<2>(RW_S(3), 72, RW_S(9), 72, 16 * mt, n0, z, fr, fq);
        f32x4 gbr = mm_tile<2>(RW_S(10), 72, RW_S(4), 72, 16 * mt, n0, z, fr, fq);
        f32x4 gkr = mm_tile<2>(RW_S(10), 72, RW_S(9), 72, 16 * mt, n0, z, fr, fq);
#pragma unroll
        for (int i = 0; i < 4; ++i) { const bool st = (jj + i < t), inc = (jj + i <= t);
            gab[i] = st ? gab[i] : 0.f; gkb[i] = st ? gkb[i] : 0.f; gbr[i] = inc ? gbr[i] : 0.f; gkr[i] = inc ? gkr[i] : 0.f;
            RW_S(1)[(jj + i) * 72 + t] = (bf16)f2bf(gab[i]);
            RW_S(7)[(jj + i) * 72 + t] = (bf16)f2bf((jj + i == t ? 1.f : 0.f) - gab[i]); }
        *(LAS v2u*)(RW_S(0) + t * 72 + jj) = pk4(gab); *(LAS v2u*)(RW_S(2) + t * 72 + jj) = pk4(gkb);
        *(LAS v2u*)(RW_S(5) + t * 72 + jj) = pk4(gbr); *(LAS v2u*)(RW_S(6) + t * 72 + jj) = pk4(gkr); }
    __syncthreads();
    {
        int sX = 1, sXT = 0, sP = 7, sY = 8, sYT = 15, sPn = 3;
        for (int it = 1; it <= 5; ++it) {
#pragma unroll
            for (int j = 0; j < 2; ++j) { const int n0 = 16 * (ntb + j), m = 16 * mt + fr, tt = n0 + 4 * fq;
                f32x4 y = mm_tile<2>(RW_S(sX), 72, RW_S(sXT), 72, 16 * mt, n0, (f32x4){0.f, 0.f, 0.f, 0.f}, fr, fq);
                *(LAS v2u*)(RW_S(sY) + m * 72 + tt) = pk4(y);
#pragma unroll
                for (int i = 0; i < 4; ++i) RW_S(sYT)[(tt + i) * 72 + m] = (bf16)f2bf(y[i]); }
            __syncthreads();
#pragma unroll
            for (int j = 0; j < 2; ++j) { const int n0 = 16 * (ntb + j), m = 16 * mt + fr, tt = n0 + 4 * fq;
                const v2u pr = *(const LAS v2u*)(RW_S(sP) + m * 72 + tt);
                f32x4 p = (f32x4){bflo(pr.x), bfhi(pr.x), bflo(pr.y), bfhi(pr.y)};
                p = mm_tile<2>(RW_S(sP), 72, RW_S(sYT), 72, 16 * mt, n0, p, fr, fq);
                if (it < 5) *(LAS v2u*)(RW_S(sPn) + m * 72 + tt) = pk4(p);
                else {
#pragma unroll
                    for (int i = 0; i < 4; ++i) RW_S(4)[(tt + i) * 72 + m] = (bf16)f2bf(p[i]); } }
            __syncthreads();
            int tmp = sX; sX = sY; sY = tmp; tmp = sXT; sXT = sYT; sYT = tmp; tmp = sP; sP = sPn; sPn = tmp;
        }
    }
#pragma unroll
    for (int j = 0; j < 2; ++j) { const int n0 = 16 * (ntb + j), m = 16 * mt + fr, tt = n0 + 4 * fq; const f32x4 z = (f32x4){0.f, 0.f, 0.f, 0.f};
        const f32x4 ap = mm_tile<2>(RW_S(11), 72, RW_S(4), 72, 16 * mt, n0, z, fr, fq);
        const f32x4 vm = mm_tile<2>(RW_S(14), 72, RW_S(2), 72, 16 * mt, n0, z, fr, fq);
        *(LAS v2u*)(RW_S(9) + m * 72 + tt) = pk4(ap); *(LAS v2u*)(RW_S(3) + m * 72 + tt) = pk4(vm); }
    __syncthreads();
#pragma unroll
    for (int j = 0; j < 2; ++j) { const int n0 = 16 * (ntb + j), m = 16 * mt + fr, tt = n0 + 4 * fq;
        const f32x4 vp = mm_tile<2>(RW_S(3), 72, RW_S(4), 72, 16 * mt, n0, (f32x4){0.f, 0.f, 0.f, 0.f}, fr, fq);
        *(LAS v2u*)(RW_S(7) + m * 72 + tt) = pk4(vp); }
    __syncthreads();
    bf16* OMT = wsp<bf16>(F, WS_OMT); bf16* YL = wsp<bf16>(F, WS_YL);
#pragma unroll
    for (int j = 0; j < 2; ++j) { const int nt = ntb + j, n0 = 16 * nt, m = 16 * mt + fr, nn = n0 + 4 * fq; const f32x4 z = (f32x4){0.f, 0.f, 0.f, 0.f};
        { f32x4 x = mm_tile<2>(RW_S(12), 72, RW_S(9), 72, 16 * mt, n0, z, fr, fq); const float wl = WLs[m];
#pragma unroll
          for (int i = 0; i < 4; ++i) x[i] = ((nn + i == m) ? wl : 0.f) - x[i];
          const int idx = (nt >> 1) * 32 + fq * 8 + (nt & 1) * 4;
          *(v2u*)(Rb + (size_t)(m0 + m) * D + hc0 + idx) = pk4(x); }
        { const f32x4 x1 = mm_tile<2>(RW_S(14), 72, RW_S(13), 72, 16 * mt, n0, z, fr, fq), x2 = mm_tile<2>(RW_S(7), 72, RW_S(12), 72, 16 * mt, n0, z, fr, fq);
          *(v2u*)(Kb + (size_t)(m0 + m) * D + hc0 + nn) = pk4(x1 - x2); }
        { const f32x4 x1 = mm_tile<2>(RW_S(6), 72, RW_S(14), 72, 16 * mt, n0, z, fr, fq), x2 = mm_tile<2>(RW_S(5), 72, RW_S(7), 72, 16 * mt, n0, z, fr, fq);
          *(v2u*)(YL + (size_t)(m0 + m) * D + hc0 + nn) = pk4(x1 - x2); }
        { const f32x4 x = mm_tile<2>(RW_S(5), 72, RW_S(9), 72, 16 * mt, n0, z, fr, fq);
          const v2u rr = *(const LAS v2u*)(RW_S(10) + m * 72 + nn);
          f32x4 o; o[0] = bflo(rr.x) - x[0]; o[1] = bfhi(rr.x) - x[1]; o[2] = bflo(rr.y) - x[2]; o[3] = bfhi(rr.y) - x[3];
          *(v2u*)(OMT + (size_t)(m0 + m) * D + hc0 + nn) = pk4(o); } }
    __syncthreads();
}
__device__ __forceinline__ void rwkv_scan(const Frame& F) {
    if (F.wave >= 4) return;
    for (int bh = F.vcu; bh < 32; bh += F.G) {
    const int b = bh >> 4, h = bh & 15, hc0 = h * 64, vg = F.wave, l15 = F.lane & 15, q = F.lane >> 4;
    const bf16* Rb = wsp<bf16>(F, WS_R); const bf16* Kb = wsp<bf16>(F, WS_K); bf16* S0 = wsp<bf16>(F, WS_S0);
    f32x4 acc[4];
#pragma unroll
    for (int i = 0; i < 4; ++i) acc[i] = (f32x4){0.f, 0.f, 0.f, 0.f};
    for (int c = 0; c < RW_NC; ++c) {
        const int m0 = b * T + c * RW_L;
        bf16x8 A[4][2]; v2u psi[4];
#pragma unroll
        for (int mt = 0; mt < 4; ++mt) {
#pragma unroll
            for (int s = 0; s < 2; ++s) A[mt][s] = *(const bf16x8*)(Rb + (size_t)(m0 + 16 * mt + l15) * D + hc0 + s * 32 + q * 8);
            psi[mt] = *(const v2u*)(Kb + (size_t)(m0 + 16 * vg + l15) * D + hc0 + 16 * mt + 4 * q); }
        v2u pk[4];
#pragma unroll
        for (int mt = 0; mt < 4; ++mt) { pk[mt] = pk4(acc[mt]); *(v2u*)(S0 + (size_t)(m0 + 16 * vg + l15) * D + hc0 + 16 * mt + 4 * q) = pk[mt]; }
        const v4u b0 = (v4u){pk[0].x, pk[0].y, pk[1].x, pk[1].y}, b1 = (v4u){pk[2].x, pk[2].y, pk[3].x, pk[3].y};
        const bf16x8 sB0 = __builtin_bit_cast(bf16x8, b0), sB1 = __builtin_bit_cast(bf16x8, b1);
#pragma unroll
        for (int mt = 0; mt < 4; ++mt) {
            f32x4 a = (f32x4){bflo(psi[mt].x), bfhi(psi[mt].x), bflo(psi[mt].y), bfhi(psi[mt].y)};
            a = __builtin_amdgcn_mfma_f32_16x16x32_bf16(A[mt][0], sB0, a, 0, 0, 0);
            a = __builtin_amdgcn_mfma_f32_16x16x32_bf16(A[mt][1], sB1, a, 0, 0, 0);
            acc[mt] = a; }
    }
    }
}
__device__ __forceinline__ void rwkv_post(const Frame& F) {
    const int gw = F.vcu * NWAVES + F.wave, NGW = F.G * NWAVES, fr = F.lane & 15, fq = F.lane >> 4;
    bf16* Rb = wsp<bf16>(F, WS_R); const bf16* Vb = wsp<bf16>(F, WS_V); const bf16* LR = wsp<bf16>(F, WS_LR);
    const bf16* OMT = wsp<bf16>(F, WS_OMT); const bf16* YL = wsp<bf16>(F, WS_YL); const bf16* S0 = wsp<bf16>(F, WS_S0);
    const bf16* g2t = wsp<bf16>(F, WS_W2T) + 2 * 1024 * 64; const float* RKS = wsp<float>(F, WS_RKS);
    for (int item = gw; item < 4096 * 4; item += NGW) {
        const int unit = item >> 2, mt = item & 3;
        const int c = unit & 127, h = (unit >> 7) & 15, b = unit >> 11;
        const int m0 = b * T + c * RW_L, hc0 = h * 64, t = 16 * mt + fr; const size_t rowt = (size_t)(m0 + t);
        f32x4 y[4], g[4];
        bf16x8 om[2], lg[4];
#pragma unroll
        for (int ks = 0; ks < 2; ++ks) om[ks] = *(const bf16x8*)(OMT + rowt * D + hc0 + ks * 32 + fq * 8);
#pragma unroll
        for (int ks = 0; ks < 4; ++ks) lg[ks] = *(const bf16x8*)(LR + rowt * 256 + 128 + ks * 32 + fq * 8);
#pragma unroll
        for (int nt = 0; nt < 4; ++nt) {
            const v2u yl = *(const v2u*)(YL + rowt * D + hc0 + 16 * nt + 4 * fq);
            f32x4 a = (f32x4){bflo(yl.x), bfhi(yl.x), bflo(yl.y), bfhi(yl.y)};
#pragma unroll
            for (int ks = 0; ks < 2; ++ks) { const bf16x8 sb = *(const bf16x8*)(S0 + (size_t)(m0 + 16 * nt + fr) * D + hc0 + ks * 32 + fq * 8);
                a = __builtin_amdgcn_mfma_f32_16x16x32_bf16(sb, om[ks], a, 0, 0, 0); }
            y[nt] = a;
            f32x4 gg = (f32x4){0.f, 0.f, 0.f, 0.f};
#pragma unroll
            for (int ks = 0; ks < 4; ++ks) { const bf16x8 gb = *(const bf16x8*)(g2t + (size_t)(hc0 + 16 * nt + fr) * 128 + ks * 32 + fq * 8);
                gg = __builtin_amdgcn_mfma_f32_16x16x32_bf16(gb, lg[ks], gg, 0, 0, 0); }
            g[nt] = gg; }
        float s = 0.f;
#pragma unroll
        for (int nt = 0; nt < 4; ++nt) s += (y[nt][0] + y[nt][1]) + (y[nt][2] + y[nt][3]);
        s += __shfl_xor(s, 16); s += __shfl_xor(s, 32);
        const float mu = s * (1.f / 64.f); float qv = 0.f;
#pragma unroll
        for (int nt = 0; nt < 4; ++nt) { y[nt] = y[nt] - mu; qv += (y[nt][0] * y[nt][0] + y[nt][1] * y[nt][1]) + (y[nt][2] * y[nt][2] + y[nt][3] * y[nt][3]); }
        qv += __shfl_xor(qv, 16); qv += __shfl_xor(qv, 32);
        const float rstd = 1.f / sqrtf(qv * (1.f / 64.f) + GN_EPS);
        const float rk = RKS[rowt * 16 + h];
#pragma unroll
        for (int nt = 0; nt < 4; ++nt) { const int v = hc0 + 16 * nt + 4 * fq;
            const f32x4 lgv = *(const f32x4*)(F.in[I_RLG] + v), lbv = *(const f32x4*)(F.in[I_RLB] + v);
            const v2u vr = *(const v2u*)(Vb + rowt * D + v);
            f32x4 o; o[0] = (y[nt][0] * rstd * lgv[0] + lbv[0] + rk * bflo(vr.x)) * g[nt][0]; o[1] = (y[nt][1] * rstd * lgv[1] + lbv[1] + rk * bfhi(vr.x)) * g[nt][1];
            o[2] = (y[nt][2] * rstd * lgv[2] + lbv[2] + rk * bflo(vr.y)) * g[nt][2]; o[3] = (y[nt][3] * rstd * lgv[3] + lbv[3] + rk * bfhi(vr.y)) * g[nt][3];
            *(v2u*)(Rb + rowt * D + v) = pk4(o); }
    }
}
__device__ __forceinline__ void norm_phase(const Frame& F, const float* g, bf16* XN) {
    const int gw = F.vcu * NWAVES + F.wave, NGW = F.G * NWAVES;
    for (int m = gw; m < M; m += NGW) { f32x4 v[4]; rms_row(F.out + (size_t)m * D, g, F.lane, v); store_row_bf16(XN + (size_t)m * D, F.lane, v); }
}
__device__ __forceinline__ void a2_phase(const Frame& F) {
    const int gw = F.vcu * NWAVES + F.wave, NGW = F.G * NWAVES; const float* g = F.in[I_NMG] + D; bf16* A2 = wsp<bf16>(F, WS_A2);
    for (int blk = gw; blk < M / 8; blk += NGW) {
        const int r0 = 8 * blk; f32x4 prev[4];
        if ((r0 & (T - 1)) == 0) {
#pragma unroll
            for (int j = 0; j < 4; ++j) prev[j] = (f32x4){0.f, 0.f, 0.f, 0.f};
        } else rms_row(F.out + (size_t)(r0 - 1) * D, g, F.lane, prev);
        for (int i = 0; i < 8; ++i) { f32x4 cur[4]; rms_row(F.out + (size_t)(r0 + i) * D, g, F.lane, cur);
            store_row_bf16(A2 + (size_t)(r0 + i) * 2048, F.lane, cur);
            f32x4 dx[4];
#pragma unroll
            for (int j = 0; j < 4; ++j) { dx[j] = prev[j] - cur[j]; prev[j] = cur[j]; }
            store_row_bf16(A2 + (size_t)(r0 + i) * 2048 + D, F.lane, dx); }
    }
}
__device__ __forceinline__ void router_phase(const Frame& F) {
    LAS int* wgc = (LAS int*)(F.lds + 131072); LAS int* wbase = wgc + 8; LAS int* TE = wgc + 16; LAS int* TL = TE + 128; LAS float* TW = (LAS float*)(TL + 128);
    const float* g = F.in[I_NFG] + D; const float* rw = F.in[I_MR]; const float* rb = F.in[I_MRB]; bf16* XN3 = wsp<bf16>(F, WS_XN3);
    for (int blk = F.vcu; blk < M / 64; blk += F.G) {
    if (F.tid < 8) wgc[F.tid] = 0;
    __syncthreads();
    for (int i = 0; i < 8; ++i) {
        const int tl = 8 * F.wave + i, m = 64 * blk + tl;
        if (m < M) {
            f32x4 v[4]; rms_row(F.out + (size_t)m * D, g, F.lane, v); store_row_bf16(XN3 + (size_t)m * D, F.lane, v);
            float lg[8];
#pragma unroll
            for (int e = 0; e < 8; ++e) lg[e] = 0.f;
#pragma unroll
            for (int j = 0; j < 4; ++j)
#pragma unroll
                for (int x = 0; x < 4; ++x) { const int k = 4 * F.lane + 256 * j + x; const f32x4 r0 = *(const f32x4*)(rw + k * 8), r1 = *(const f32x4*)(rw + k * 8 + 4); const float xv = v[j][x];
                    lg[0] += xv * r0[0]; lg[1] += xv * r0[1]; lg[2] += xv * r0[2]; lg[3] += xv * r0[3]; lg[4] += xv * r1[0]; lg[5] += xv * r1[1]; lg[6] += xv * r1[2]; lg[7] += xv * r1[3]; }
#pragma unroll
            for (int e = 0; e < 8; ++e) lg[e] = wave_sum(lg[e]) + rb[e];
            int e1 = 0; float l1 = lg[0];
#pragma unroll
            for (int e = 1; e < 8; ++e) if (lg[e] > l1) { l1 = lg[e]; e1 = e; }
            int e2 = (e1 + 1) & 7; float l2 = -3.0e38f;
#pragma unroll
            for (int e = 0; e < 8; ++e) if (e != e1 && lg[e] > l2) { l2 = lg[e]; e2 = e; }
            const float w1 = 1.f / (1.f + expf(l2 - l1)), w2 = 1.f - w1;
            if (F.lane == 0) { const int a = atomicAdd((int*)&wgc[e1], 1), bb = atomicAdd((int*)&wgc[e2], 1);
                TE[2 * tl] = e1; TE[2 * tl + 1] = e2; TL[2 * tl] = a; TL[2 * tl + 1] = bb; TW[2 * tl] = w1; TW[2 * tl + 1] = w2; }
        }
    }
    __syncthreads();
    if (F.tid < 8) wbase[F.tid] = (int)__hip_atomic_fetch_add((unsigned*)(F.ws + WS_CTL) + CW_CNT + F.tid, (unsigned)wgc[F.tid], RLX_AGENT);
    __syncthreads();
    if (F.tid < 128) { const int tl = F.tid >> 1, m = 64 * blk + tl;
        if (m < M) { unsigned char* rt = F.ws + WS_ROUTE; const int e = TE[F.tid];
            ((int*)(rt + RT_E))[2 * m + (F.tid & 1)] = e; ((int*)(rt + RT_POS))[2 * m + (F.tid & 1)] = wbase[e] + TL[F.tid]; ((float*)(rt + RT_W))[2 * m + (F.tid & 1)] = TW[F.tid]; } }
    __syncthreads();
    }
    run_jobs(F, true);
}
__device__ __forceinline__ void moe_offsets(const Frame& F, int (&toff)[9]) {
    const unsigned* cnt = (const unsigned*)(F.ws + WS_CTL) + CW_CNT; int acc = 0;
#pragma unroll
    for (int e = 0; e < 8; ++e) { toff[e] = acc; acc += ((int)__hip_atomic_load(cnt + e, RLX_AGENT) + 255) >> 8; }
    toff[8] = acc;
}
__device__ __forceinline__ void gather_phase(const Frame& F) {
    int toff[9]; moe_offsets(F, toff);
    const int gw = F.vcu * NWAVES + F.wave, NGW = F.G * NWAVES; unsigned char* rt = F.ws + WS_ROUTE;
    const bf16* XN3 = wsp<bf16>(F, WS_XN3); bf16* XG = wsp<bf16>(F, WS_XG);
    for (int p = gw; p < 2 * M; p += NGW) {
        const int m = p >> 1; const int e = ((const int*)(rt + RT_E))[p], pos = ((const int*)(rt + RT_POS))[p]; const float w = ((const float*)(rt + RT_W))[p];
        int off = 0;
#pragma unroll
        for (int j = 0; j < 8; ++j) off = (e == j) ? toff[j] : off;
        int slot = off * 256 + pos; if ((unsigned)e >= 8u || (unsigned)slot >= (unsigned)XG_ROWS) slot = XG_ROWS - 1;
        const v4u* src = (const v4u*)(XN3 + (size_t)m * D); v4u* dst = (v4u*)(XG + (size_t)slot * D);
        dst[F.lane] = src[F.lane]; dst[64 + F.lane] = src[64 + F.lane];
        if (F.lane == 0) { ((int*)(rt + RT_SLOT))[p] = slot; ((float*)(rt + RT_SLOTW))[slot] = w; }
    }
}
__device__ __forceinline__ void final_phase(const Frame& F) {
    const int gw = F.vcu * NWAVES + F.wave, NGW = F.G * NWAVES; unsigned char* rt = F.ws + WS_ROUTE; const bf16* YE = wsp<bf16>(F, WS_XG);
    const float* g = F.in[I_NOG];
    for (int m = gw; m < M; m += NGW) {
        int s0 = ((const int*)(rt + RT_SLOT))[2 * m], s1 = ((const int*)(rt + RT_SLOT))[2 * m + 1];
        if ((unsigned)s0 >= (unsigned)XG_ROWS) s0 = XG_ROWS - 1; if ((unsigned)s1 >= (unsigned)XG_ROWS) s1 = XG_ROWS - 1;
        const f32x4* xr = (const f32x4*)(F.out + (size_t)m * D) + F.lane; const v2u* y0 = (const v2u*)(YE + (size_t)s0 * D) + F.lane; const v2u* y1 = (const v2u*)(YE + (size_t)s1 * D) + F.lane;
        f32x4 v[4]; float s = 0.f;
#pragma unroll
        for (int j = 0; j < 4; ++j) { const v2u a = y0[64 * j], bq = y1[64 * j]; v[j] = xr[64 * j];
            v[j][0] += bflo(a.x) + bflo(bq.x); v[j][1] += bfhi(a.x) + bfhi(bq.x); v[j][2] += bflo(a.y) + bflo(bq.y); v[j][3] += bfhi(a.y) + bfhi(bq.y);
            s += (v[j][0] * v[j][0] + v[j][1] * v[j][1]) + (v[j][2] * v[j][2] + v[j][3] * v[j][3]); }
        const float rs = 1.f / sqrtf(wave_sum(s) * (1.f / D) + RMS_EPS);
        f32x4* o = (f32x4*)(F.out + (size_t)m * D) + F.lane; const f32x4* gr = (const f32x4*)g + F.lane;
#pragma unroll
        for (int j = 0; j < 4; ++j) o[64 * j] = v[j] * rs * gr[64 * j];
    }
}
constexpr int N_PHASES = 20;
struct Args { const float* in[37]; float* out; unsigned char* ws; int ph_lo, ph_hi; };
__global__ void __launch_bounds__(NTHREADS, 2) fwd_kernel(Args args) {
    extern __shared__ __attribute__((aligned(16))) unsigned char lds_raw[];
    Frame F;
    F.lds = (LAS unsigned char*)lds_raw;
    F.tid = threadIdx.x; F.lane = F.tid & 63; F.wave = __builtin_amdgcn_readfirstlane(F.tid >> 6);
    F.G = gridDim.x; { const int bx = blockIdx.x; F.vcu = (F.G % 8 == 0) ? (bx % 8) * (F.G / 8) + bx / 8 : bx; }
#pragma unroll
    for (int i = 0; i < 37; ++i) F.in[i] = args.in[i];
    F.out = args.out; F.ws = args.ws;
    volatile LAS unsigned* MISC = (volatile LAS unsigned*)(F.lds + MISC_OFF);
    if (F.tid < 64) MISC[F.tid] = 0u;
    __syncthreads();
    const int lo = args.ph_lo, hi = args.ph_hi;
    const bool multi = (hi - lo) > 1;
    XcdBarrier bar; bar.bar = (unsigned*)(F.ws + WS_CTL) + CW_BAR; bar.x = 0; bar.st = nullptr;
    if (multi) bar = xcd_barrier_post((unsigned*)(F.ws + WS_CTL) + CW_BAR, MISC + 8);
#define IN(k) (lo <= (k) && (k) < hi)
#define SEAM(k) do { if (IN(k) && IN((k) + 1)) xcd_barrier(bar); } while (0)
    LAS unsigned char* lds = F.lds;
    const int cu = (int)blockIdx.x;

    if (IN(0)) { p0_prologue(F); } SEAM(0);
    if (IN(1)) { pg8::DenseOrder S; S.init(wsp<bf16>(F, WS_XN), wsp<bf16>(F, WS_WIN), M, MIX_IN, 1024, F.G, cu);
        epi::MixIn E{wsp<bf16>(F, WS_Z), wsp<float>(F, WS_LB)};
        pg8::gemm_phase(lds, 1024, S, E); } SEAM(1);
    if (IN(2)) { for (int u = F.vcu; u < 512; u += F.G) gmlp_unit(F, u);
        for (int u = F.vcu; u < 1024; u += F.G) hgrn_pre_unit(F, u); } SEAM(2);
    if (IN(3)) { hgrn_scan(F); } SEAM(3);
    if (IN(4)) { for (int u = F.vcu; u < 1024; u += F.G) hgrn_post_unit(F, u); } SEAM(4);
    if (IN(5)) { pg8::DenseOrder S; S.init(wsp<bf16>(F, WS_XN), wsp<bf16>(F, WS_WOUT), M, D, 1024, F.G, cu);
        epi::Resid E{F.in[I_X], F.out};
        pg8::gemm_phase(lds, 1024, S, E); } SEAM(5);
    if (IN(6)) { norm_phase(F, F.in[I_NFG], wsp<bf16>(F, WS_XN)); } SEAM(6);
    if (IN(7)) { pg8::DenseOrder S; S.init(wsp<bf16>(F, WS_XN), wsp<bf16>(F, WS_WGU), M, 2 * DFF, 1024, F.G, cu);
        epi::SwiGlu E{wsp<bf16>(F, WS_HF), DFF, nullptr};
        pg8::gemm_phase(lds, 1024, S, E); } SEAM(7);
    if (IN(8)) { pg8::DenseOrder S; S.init(wsp<bf16>(F, WS_HF), wsp<bf16>(F, WS_WD), M, D, DFF, F.G, cu);
        epi::Resid E{F.out, F.out};
        pg8::gemm_phase(lds, DFF, S, E); } SEAM(8);
    if (IN(9)) { a2_phase(F); } SEAM(9);
    if (IN(10)) { pg8::DenseOrder S; S.init(wsp<bf16>(F, WS_A2), wsp<bf16>(F, WS_WR), M, NRW, 2048, F.G, cu);
        epi::RwkvProj E{wsp<bf16>(F, WS_R), (size_t)(WS_K - WS_R) / 2, wsp<bf16>(F, WS_LR)};
        pg8::gemm_phase(lds, 2048, S, E); } SEAM(10);
    if (IN(11)) { for (int u = F.vcu; u < 4096; u += F.G) rwkv_pre_unit(F, u); } SEAM(11);
    if (IN(12)) { rwkv_scan(F); } SEAM(12);
    if (IN(13)) { rwkv_post(F); } SEAM(13);
    if (IN(14)) { pg8::DenseOrder S; S.init(wsp<bf16>(F, WS_R), wsp<bf16>(F, WS_WO), M, D, 1024, F.G, cu);
        epi::Resid E{F.out, F.out};
        pg8::gemm_phase(lds, 1024, S, E); } SEAM(14);
    if (IN(15)) { router_phase(F); } SEAM(15);
    if (IN(16)) { gather_phase(F); } SEAM(16);
    if (IN(17)) { pg8::MoeOrder S; moe_offsets(F, S.toff); S.ntiles = S.toff[8]; S.nN = 2 * DFE / 256; S.nwg = S.ntiles * S.nN; S.G = F.G; S.c = cu;
        S.A = (const char*)wsp<bf16>(F, WS_XG); S.Bt = (const char*)wsp<bf16>(F, WS_WEGU); S.tstep = (size_t)256 * 1024 * 2; S.estride = (size_t)2 * DFE * 1024 * 2;
        epi::SwiGlu E{wsp<bf16>(F, WS_HE), DFE, (const float*)(F.ws + WS_ROUTE + RT_SLOTW)};
        pg8::gemm_phase(lds, 1024, S, E); } SEAM(17);
    if (IN(18)) { pg8::MoeOrder S; moe_offsets(F, S.toff); S.ntiles = S.toff[8]; S.nN = D / 256; S.nwg = S.ntiles * S.nN; S.G = F.G; S.c = cu;
        S.A = (const char*)wsp<bf16>(F, WS_HE); S.Bt = (const char*)wsp<bf16>(F, WS_WED); S.tstep = (size_t)256 * DFE * 2; S.estride = (size_t)1024 * DFE * 2;
        epi::StoreBf16 E{wsp<bf16>(F, WS_XG), D};
        pg8::gemm_phase(lds, DFE, S, E); } SEAM(18);
    if (IN(19)) { final_phase(F); }
#undef IN
#undef SEAM
}


struct DiagReg { size_t off; int rows, stride, col0, ncols, isf32; float lo, hi; };
struct DiagArgs { DiagReg r[12]; int n; int pad; };
__global__ void diag_count(unsigned char* ws, unsigned* cnt, DiagArgs da) {
    for (int ri = 0; ri < da.n; ++ri) { const DiagReg R = da.r[ri]; const long tot = (long)R.rows * R.ncols; float worst = 0.f;
        for (long i = (long)blockIdx.x * blockDim.x + threadIdx.x; i < tot; i += (long)gridDim.x * blockDim.x) { const long row = i / R.ncols; const int col = (int)(i % R.ncols);
            float v;
            if (R.isf32) v = ((const float*)(ws + R.off))[row * R.stride + R.col0 + col];
            else v = __builtin_bit_cast(float, (unsigned)((const unsigned short*)(ws + R.off))[row * R.stride + R.col0 + col] << 16);
            if (!(v <= R.hi && v >= R.lo)) { float a = fabsf(v); if (!(a < 1e30f)) a = 1e30f; if (a < 1e-30f) a = 1e-30f; worst = fmaxf(worst, a); } }
        if (worst > 0.f) atomicMax(cnt + ri, __float_as_uint(worst)); }
}
__global__ void diag_mark(float* out, unsigned* cnt, DiagArgs da, int total) {
    for (int i = blockIdx.x * blockDim.x + threadIdx.x; i < total; i += gridDim.x * blockDim.x) out[i] = 0.f;
    if (threadIdx.x == 0 && blockIdx.x == 0) { int first = -1; for (int i = da.n - 1; i >= 0; --i) if (cnt[i]) first = i;
        if (first >= 0) { const float w = __uint_as_float(cnt[first]), bound = fmaxf(fabsf(da.r[first].lo), fabsf(da.r[first].hi));
            float m = 1.f + log10f(fmaxf(w / bound, 1.f)) * 0.25f; if (m > 9.5f) m = 9.5f;
            out[0] = sqrtf(1.678e7f * m * powf(10.f, 2.f + first)); } }
}
extern "C" void kernel_launch(void* const* d_in, const int* in_sizes, int n_in, void* d_out, int out_size, void* d_ws, size_t ws_size, hipStream_t stream) {
    static int grid = 0;
    if (grid == 0) {
        if (n_in != 37 || out_size != M * D || ws_size < WS_END) { fprintf(stderr, "kernel_launch: unexpected shapes (n_in %d out %d ws %zu)\n", n_in, out_size, ws_size); grid = -1; return; }
        int dev = 0, cus = 0, per_cu = 0;
        hipGetDevice(&dev); hipDeviceGetAttribute(&cus, hipDeviceAttributeMultiprocessorCount, dev);
        hipFuncSetAttribute((const void*)fwd_kernel, hipFuncAttributeMaxDynamicSharedMemorySize, LDS_BYTES);
        hipOccupancyMaxActiveBlocksPerMultiprocessor(&per_cu, (const void*)fwd_kernel, NTHREADS, LDS_BYTES);
        (void)hipGetLastError();
        grid = cus;
        if (per_cu < 1) fprintf(stderr, "kernel_launch: occupancy query says %d blocks per CU\n", per_cu);
    }
    if (grid < 0) return;
    hipMemsetAsync((char*)d_ws + WS_CTL, 0, CTL_ZERO_BYTES, stream);
    Args a{};
    for (int i = 0; i < 37; ++i) a.in[i] = (const float*)d_in[i];
    a.out = (float*)d_out; a.ws = (unsigned char*)d_ws;
#if MK_N_LAUNCHES == 1
    a.ph_lo = 0; a.ph_hi = N_PHASES;
    hipLaunchKernelGGL(fwd_kernel, dim3(grid), dim3(NTHREADS), LDS_BYTES, stream, a);
#else
    for (int p = 0; p < MK_PH_HI; ++p) { a.ph_lo = p; a.ph_hi = p + 1; hipLaunchKernelGGL(fwd_kernel, dim3(grid), dim3(NTHREADS), LDS_BYTES, stream, a); }
#endif
}
```

```cpp
#include <hip/hip_runtime.h>
#include <cstdio>
#include <cstdint>
#ifndef MK_N_LAUNCHES
#define MK_N_LAUNCHES 1
#endif
#ifndef MK_PH_HI
#define MK_PH_HI 20
#endif
namespace pg8 {
#define PG8_LAS __attribute__((address_space(3)))
typedef unsigned short bf16_t;
typedef short bf16x8 __attribute__((ext_vector_type(8)));
typedef float f32x4 __attribute__((ext_vector_type(4)));
typedef float f32x2 __attribute__((ext_vector_type(2)));
typedef unsigned u32x4 __attribute__((ext_vector_type(4)));
constexpr int BM = 256, BK = 64, HALF = 128, HTB = HALF * BK * 2, STAGE_BYTES = 8 * HTB, NXCD = 8, WGM = 8;

__host__ __device__ __forceinline__ int lds_byte(int r, int c) { const int st = (r >> 4) * 2 + (c >> 5), rr = r & 15, cc = c & 31, ob = rr * 64 + cc * 2; return st * 1024 + (ob ^ (((ob >> 9) & 1) << 5)); }
__host__ __device__ __forceinline__ void stage_rc(int b, int& R, int& C) { const int st = b / 1024, sb = b % 1024, swz = sb ^ (((sb >> 9) & 1) << 5); R = (st >> 1) * 16 + swz / 64; C = (st & 1) * 32 + (swz % 64) / 2; }
__host__ __device__ __forceinline__ int perm32(int rho) { const int n = rho >> 4, i = rho & 15; return 8 * (i >> 2) + 4 * n + (i & 3); }

struct Unit { int pm, pn; const char* A; const char* B; };

struct DenseOrder {
    int nM, nN, nwg, G, c; const char* A; const char* Bt; size_t tstep;
    __device__ void init(const void* A_, const void* Bt_, int M, int N, int K, int G_, int c_) { nM = M / BM; nN = N / BM; nwg = nM * nN; G = G_; c = c_; A = (const char*)A_; Bt = (const char*)Bt_; tstep = (size_t)BM * K * 2; }
    __device__ bool next(int i, Unit& u) const {
        const long L = (long)i * G + c; if (L >= nwg) return false;
        int wgid = (int)L; { const int q = nwg / NXCD, r = nwg % NXCD, xcd = wgid % NXCD, off = wgid / NXCD; wgid = (xcd < r ? xcd * (q + 1) : r * (q + 1) + (xcd - r) * q) + off; }
        const int nig = WGM * nN, gid = wgid / nig, fm = gid * WGM, gsz = (nM - fm) < WGM ? (nM - fm) : WGM;
        u.pm = fm + ((wgid % nig) % gsz); u.pn = (wgid % nig) / gsz;
        u.A = A + (size_t)u.pm * tstep; u.B = Bt + (size_t)u.pn * tstep; return true;
    }
};
struct MoeOrder {
    int ntiles, nN, nwg, G, c; int toff[9]; const char* A; const char* Bt; size_t tstep, estride;
    __device__ bool next(int i, Unit& u) const {
        const long L = (long)i * G + c; if (L >= nwg) return false;
        const int rt = (int)(L % ntiles), pn = (int)(L / ntiles);
        int e = 0;
#pragma unroll
        for (int j = 1; j < 8; ++j) e += (rt >= toff[j]) ? 1 : 0;
        u.pm = rt; u.pn = pn; u.A = A + (size_t)rt * tstep; u.B = Bt + (size_t)e * estride + (size_t)pn * tstep; return true;
    }
};

typedef __bf16 bf16x2_t __attribute__((ext_vector_type(2)));
__device__ __forceinline__ unsigned cvt_pk_bf16(float lo, float hi) { f32x2 v = {lo, hi}; bf16x2_t b = __builtin_convertvector(v, bf16x2_t); return __builtin_bit_cast(unsigned, b); }

template <class Epi, class Sched>
__device__ __forceinline__ void gemm_phase(PG8_LAS unsigned char* lds, const int K, const Sched& S, const Epi& E) {
    const int tid = threadIdx.x, wid = __builtin_amdgcn_readfirstlane(tid >> 6), lane = tid & 63, wr = wid >> 2, wc = wid & 3, fr = lane & 15, fq = lane >> 4;
    const int nt = K / BK;
    unsigned voffA[2], voffB[2];
#pragma unroll
    for (int i = 0; i < 2; ++i) { int R, C; stage_rc(tid * 16 + i * 8192, R, C); const int Rb = Epi::PERM ? ((R & ~31) + perm32(R & 31)) : R;
        voffA[i] = (unsigned)(R * K + C) * 2u; voffB[i] = (unsigned)(Rb * K + C) * 2u; }
    const size_t kstep = (size_t)(BK * 2);
    const size_t hstep = (size_t)HALF * K * 2;
    const unsigned ldsw = (unsigned)wid * 1024u;
    const int aoff = lds_byte(wr * 64 + fr, fq * 8), boff = lds_byte(wc * 32 + fr, fq * 8);
#define PG8_SA(b, h) (((b) * 2 + (h)) * HTB)
#define PG8_SB(b, h) ((4 + (b) * 2 + (h)) * HTB)
#define PG8_STAGE(bufoff, gbase, voff) do { _Pragma("unroll") for (int _i = 0; _i < 2; ++_i) \
        __builtin_amdgcn_global_load_lds((const unsigned*)((const char*)(gbase) + (voff)[_i]), (PG8_LAS unsigned*)(lds + (bufoff) + ldsw + _i * 8192), 16, 0, 0); } while (0)
#define PG8_LDA(dst, b, h) do { _Pragma("unroll") for (int m = 0; m < 4; ++m) _Pragma("unroll") for (int k = 0; k < 2; ++k) dst[m][k] = *(const PG8_LAS bf16x8*)(lds + PG8_SA(b, h) + aoff + m * 2048 + k * 1024); } while (0)
#define PG8_LDB(dst, b, h) do { _Pragma("unroll") for (int n = 0; n < 2; ++n) _Pragma("unroll") for (int k = 0; k < 2; ++k) dst[n][k] = *(const PG8_LAS bf16x8*)(lds + PG8_SB(b, h) + boff + n * 2048 + k * 1024); } while (0)
#define PG8_MMA(ai, bj, At, Bt) do { __builtin_amdgcn_s_setprio(1); _Pragma("unroll") for (int m = 0; m < 4; ++m) _Pragma("unroll") for (int n = 0; n < 2; ++n) _Pragma("unroll") for (int k = 0; k < 2; ++k) \
        acc[ai][bj][m][n] = __builtin_amdgcn_mfma_f32_16x16x32_bf16(Bt[n][k], At[m][k], acc[ai][bj][m][n], 0, 0, 0); __builtin_amdgcn_s_setprio(0); } while (0)
#define PG8_WAIT_V(n) asm volatile("s_waitcnt vmcnt(" #n ")" ::: "memory")
#define PG8_WAIT_L(n) asm volatile("s_waitcnt lgkmcnt(" #n ")" ::: "memory")
#define PG8_BAR __builtin_amdgcn_s_barrier()
#define PG8_SCHED __builtin_amdgcn_sched_barrier(0)
    Unit cur, nxt; int ui = 0;
    if (!S.next(0, cur)) return;
    f32x4 acc[2][2][4][2];
#pragma unroll
    for (int a = 0; a < 2; ++a)
#pragma unroll
        for (int b = 0; b < 2; ++b)
#pragma unroll
            for (int m = 0; m < 4; ++m)
#pragma unroll
                for (int n = 0; n < 2; ++n) acc[a][b][m][n] = (f32x4){0.f, 0.f, 0.f, 0.f};
    bf16x8 At[4][2], B0[2][2], B1[2][2];
    const char* cA = cur.A; const char* cB = cur.B;
    PG8_STAGE(PG8_SB(0, 0), cB, voffB); PG8_STAGE(PG8_SB(0, 1), cB + hstep, voffB); PG8_STAGE(PG8_SA(0, 0), cA, voffA); PG8_STAGE(PG8_SA(0, 1), cA + hstep, voffA);
    if (wr == 1) PG8_BAR;
    PG8_WAIT_V(2); PG8_BAR;
    PG8_STAGE(PG8_SB(1, 0), cB + kstep, voffB); PG8_STAGE(PG8_SA(1, 0), cA + kstep, voffA); PG8_STAGE(PG8_SB(1, 1), cB + hstep + kstep, voffB);
    PG8_WAIT_V(6); PG8_BAR;
    for (;;) {
        const bool has_next = S.next(ui + 1, nxt);
        const char* nA = has_next ? nxt.A : cA; const char* nB = has_next ? nxt.B : cB;
        for (int t = 0; t < nt; t += 2) {
            const bool last = (t == nt - 2);
            const char* a1 = cA + (size_t)(t + 1) * kstep;
            const char* a2 = last ? nA : cA + (size_t)(t + 2) * kstep; const char* b2 = last ? nB : cB + (size_t)(t + 2) * kstep;
            const char* a3 = a2 + kstep; const char* b3 = b2 + kstep;
            PG8_LDB(B0, 0, 0); PG8_LDB(B1, 0, 1); PG8_SCHED; PG8_LDA(At, 0, 0); PG8_STAGE(PG8_SA(1, 1), a1 + hstep, voffA);
            PG8_WAIT_V(8); PG8_WAIT_L(0); PG8_BAR; PG8_MMA(0, 0, At, B0); PG8_MMA(0, 1, At, B1); PG8_BAR; PG8_SCHED;
            PG8_LDA(At, 0, 1); PG8_STAGE(PG8_SB(0, 0), b2, voffB); PG8_STAGE(PG8_SB(0, 1), b2 + hstep, voffB); PG8_STAGE(PG8_SA(0, 0), a2, voffA);
            PG8_WAIT_V(8); PG8_WAIT_L(0); PG8_BAR; PG8_MMA(1, 0, At, B0); PG8_MMA(1, 1, At, B1); PG8_BAR; PG8_SCHED;
            PG8_LDB(B0, 1, 0); PG8_LDB(B1, 1, 1); PG8_SCHED; PG8_LDA(At, 1, 0); PG8_STAGE(PG8_SA(0, 1), a2 + hstep, voffA);
            PG8_WAIT_V(8); PG8_WAIT_L(0); PG8_BAR; PG8_MMA(0, 0, At, B0); PG8_MMA(0, 1, At, B1); PG8_BAR; PG8_SCHED;
            PG8_LDA(At, 1, 1); PG8_STAGE(PG8_SB(1, 0), b3, voffB); PG8_STAGE(PG8_SB(1, 1), b3 + hstep, voffB); PG8_STAGE(PG8_SA(1, 0), a3, voffA);
            PG8_WAIT_V(8); PG8_WAIT_L(0); PG8_BAR; PG8_MMA(1, 0, At, B0); PG8_MMA(1, 1, At, B1); PG8_BAR; PG8_SCHED;
        }
        if (wr == 0) PG8_BAR;
        E(acc, cur, wr, wc, fr, fq);
        if (!has_next) break;
#pragma unroll
        for (int a = 0; a < 2; ++a)
#pragma unroll
            for (int b = 0; b < 2; ++b)
#pragma unroll
                for (int m = 0; m < 4; ++m)
#pragma unroll
                    for (int n = 0; n < 2; ++n) acc[a][b][m][n] = (f32x4){0.f, 0.f, 0.f, 0.f};
        cur = nxt; cA = nA; cB = nB; ++ui;
        if (wr == 1) PG8_BAR;
    }
    PG8_WAIT_V(0);
    PG8_BAR;
#undef PG8_SA
#undef PG8_SB
#undef PG8_STAGE
#undef PG8_LDA
#undef PG8_LDB
#undef PG8_MMA
#undef PG8_WAIT_V
#undef PG8_WAIT_L
#undef PG8_BAR
#undef PG8_SCHED
}
}
#define GAS __attribute__((address_space(1)))
#define LAS __attribute__((address_space(3)))
typedef unsigned short bf16;
typedef unsigned v4u __attribute__((ext_vector_type(4)));
typedef unsigned v2u __attribute__((ext_vector_type(2)));
typedef float f32x4 __attribute__((ext_vector_type(4)));
typedef float f32x2 __attribute__((ext_vector_type(2)));
typedef short bf16x8 __attribute__((ext_vector_type(8)));
typedef short bf16x4 __attribute__((ext_vector_type(4)));
typedef GAS unsigned gu32;
#define RLX_AGENT __ATOMIC_RELAXED, __HIP_MEMORY_SCOPE_AGENT
#define LDS_WAIT() asm volatile("s_waitcnt lgkmcnt(0)" ::: "memory")
#define VM_WAIT() asm volatile("s_waitcnt vmcnt(0)" ::: "memory")
__device__ __forceinline__ unsigned f2bf(float f) { return pg8::cvt_pk_bf16(f, 0.f) & 0xffffu; }
__device__ __forceinline__ unsigned pk2(float lo, float hi) { return pg8::cvt_pk_bf16(lo, hi); }
__device__ __forceinline__ float bf2f(unsigned h) { return __builtin_bit_cast(float, h << 16); }
__device__ __forceinline__ float bflo(unsigned w) { return __builtin_bit_cast(float, w << 16); }
__device__ __forceinline__ float bfhi(unsigned w) { return __builtin_bit_cast(float, w & 0xffff0000u); }
__device__ __forceinline__ float fexp(float x) { return __builtin_amdgcn_exp2f(x * 1.4426950408889634f); }
__device__ __forceinline__ float frcp(float x) { return __builtin_amdgcn_rcpf(x); }
__device__ __forceinline__ float fsigmoid(float x) { return frcp(1.f + fexp(-x)); }
__device__ __forceinline__ float fsilu(float x) { return x * fsigmoid(x); }
__device__ __forceinline__ float ftanh(float x) { const float e = fexp(2.f * x); return 1.f - 2.f * frcp(e + 1.f); }
__device__ __forceinline__ float fgelu_tanh(float x) { const float u = 0.7978845608028654f * (x + 0.044715f * x * x * x); return 0.5f * x * (1.f + ftanh(u)); }
__device__ __forceinline__ float wave_sum(float v) {
#pragma unroll
    for (int o = 1; o < 64; o <<= 1) v += __shfl_xor(v, o);
    return v;
}

#define XB_TMO      128
#define XB_XCNT(j)  (256  + 64 * (j))
#define XB_XSUB(j)  (1280 + 64 * (j))
#define XB_XGEN(j)  (2304 + 64 * (j))
#define XB_TOP      3328
#define XB_TOPGEN   3392
#define XCD_BAR_WORDS 3456
#define XB_SPIN_CAP (1u << 22)
__device__ __forceinline__ unsigned xb_ld(unsigned* p)              { return __hip_atomic_load(p, __ATOMIC_RELAXED, __HIP_MEMORY_SCOPE_AGENT); }
__device__ __forceinline__ unsigned xb_add(unsigned* p, unsigned v) { return __hip_atomic_fetch_add(p, v, __ATOMIC_RELAXED, __HIP_MEMORY_SCOPE_AGENT); }
__device__ __forceinline__ unsigned xb_xcc_id() { return (unsigned)__builtin_amdgcn_s_getreg((3 << 11) | 20) & 0xFu; }
#define XB_SPIN(cond, bar) do { unsigned _sp = 0; while (cond) { __builtin_amdgcn_s_sleep(1); \
    if ((++_sp & 255u) == 0u) { if (xb_ld(&(bar)[XB_TMO])) break; if (_sp > XB_SPIN_CAP) { atomicAdd(&(bar)[XB_TMO], 1u); break; } } } } while (0)
struct XcdBarrier { unsigned* bar; unsigned x; volatile LAS unsigned* st; };
__device__ __forceinline__ XcdBarrier xcd_barrier_post(unsigned* bar, volatile LAS unsigned* st) {
    XcdBarrier b; b.bar = bar; b.x = xb_xcc_id(); b.st = st;
    if (threadIdx.x == 0) (void)xb_add(&bar[XB_XCNT(b.x)], 1u);
    return b;
}
__device__ __forceinline__ void xcd_barrier_complete(unsigned* bar, unsigned x, unsigned& nloc, unsigned& nx) {
    const unsigned G = gridDim.x * gridDim.y * gridDim.z;
    unsigned sum, cnt, mine, sp = 0u;
    for (;;) {
        sum = 0u; cnt = 0u; mine = 0u;
#pragma unroll
        for (unsigned j = 0; j < 16; ++j) { const unsigned c = xb_ld(&bar[XB_XCNT(j)]); sum += c; cnt += (c > 0u) ? 1u : 0u; mine = (j == x) ? c : mine; }
        if (sum == G) break;
        __builtin_amdgcn_s_sleep(1);
        if ((++sp & 255u) == 0u) { if (xb_ld(&bar[XB_TMO])) break; if (sp > XB_SPIN_CAP) { atomicAdd(&bar[XB_TMO], 1u); break; } }
    }
    nloc = mine > 0u ? mine : 1u; nx = cnt > 0u ? cnt : 1u;
}
__device__ __forceinline__ void xcd_barrier(const XcdBarrier& b) {
    asm volatile("s_waitcnt vmcnt(0)" ::: "memory");
    __syncthreads();
    if (threadIdx.x == 0) {
        unsigned* bar = b.bar;
        __builtin_amdgcn_s_waitcnt(0);
        unsigned nloc = b.st[0], nx = b.st[1];
        if (nloc == 0u) { xcd_barrier_complete(bar, b.x, nloc, nx); b.st[0] = nloc; b.st[1] = nx; }
        const unsigned old = xb_add(&bar[XB_XSUB(b.x)], 1u);
        const unsigned gen = old / nloc;
        if (old + 1u == (gen + 1u) * nloc) {
            __builtin_amdgcn_fence(__ATOMIC_RELEASE, "agent");
            asm volatile("s_waitcnt vmcnt(0)" ::: "memory");
            const unsigned og = xb_add(&bar[XB_TOP], 1u);
            const unsigned tg = og / nx;
            if (og + 1u == (tg + 1u) * nx) xb_add(&bar[XB_TOPGEN], 1u);
            else XB_SPIN(xb_ld(&bar[XB_TOPGEN]) == tg, bar);
            __builtin_amdgcn_fence(__ATOMIC_ACQUIRE, "agent");
            xb_add(&bar[XB_XGEN(b.x)], 1u);
            asm volatile("s_waitcnt vmcnt(0)" ::: "memory");
        } else {
            XB_SPIN(xb_ld(&bar[XB_XGEN(b.x)]) == gen, bar);
            __builtin_amdgcn_fence(__ATOMIC_ACQUIRE, "agent");
            asm volatile("s_waitcnt vmcnt(0)" ::: "memory");
        }
    }
    __syncthreads();
}

template <int KSTEPS>
__device__ __forceinline__ f32x4 mm_tile(const LAS bf16* Am, int lda, const LAS bf16* Bn, int ldb, int m0, int n0, f32x4 acc, int fr, int fq) {
    const LAS bf16* ap = Am + (m0 + fr) * lda + fq * 8;
    const LAS bf16* bp = Bn + (n0 + fr) * ldb + fq * 8;
#pragma unroll
    for (int ks = 0; ks < KSTEPS; ++ks) {
        const bf16x8 a = *(const LAS bf16x8*)(ap + ks * 32);
        const bf16x8 b = *(const LAS bf16x8*)(bp + ks * 32);
        acc = __builtin_amdgcn_mfma_f32_16x16x32_bf16(b, a, acc, 0, 0, 0);
    }
    return acc;
}
__device__ __forceinline__ v2u pk4(f32x4 v) { v2u r; r.x = pk2(v[0], v[1]); r.y = pk2(v[2], v[3]); return r; }
constexpr int NWAVES = 8, NTHREADS = 512;
constexpr int BATCH = 2, T = 8192, D = 1024, M = BATCH * T;
constexpr int MIX_IN = 3072, DFF = 2816, NEXP = 8, DFE = 1408, NH = 16, HS = 64;
constexpr int NRW = 3328;
constexpr int XG_ROWS = 34816;
constexpr float RMS_EPS = 1e-6f, LN_EPS = 1e-5f, GN_EPS = 64e-5f;
constexpr size_t MiB = 1u << 20, KiB = 1024;
constexpr size_t WS_CTL = 0, CTL_ZERO_BYTES = 1 * MiB;
constexpr size_t WS_WSM = 1 * MiB;
constexpr size_t WS_LB = 1 * MiB + 128 * KiB;
constexpr size_t WS_WIN = 2 * MiB, WS_WOUT = 8 * MiB, WS_WGU = 10 * MiB, WS_WD = 21 * MiB, WS_WR = 26 * MiB + 512 * KiB, WS_WO = 39 * MiB + 512 * KiB, WS_W2T = 41 * MiB + 512 * KiB;
constexpr size_t WS_XN = 42 * MiB;
constexpr size_t WS_Z = 74 * MiB;
constexpr size_t WS_HGI = 170 * MiB, WS_HGS = 202 * MiB, WS_HGD = 234 * MiB;
constexpr size_t WS_HF = 74 * MiB;
constexpr size_t WS_A2 = 42 * MiB;
constexpr size_t WS_R = 106 * MiB, WS_K = 138 * MiB, WS_V = 170 * MiB, WS_LR = 202 * MiB, WS_RKS = 210 * MiB, WS_S0 = 211 * MiB;
constexpr size_t WS_OMT = 42 * MiB, WS_YL = 74 * MiB;
constexpr size_t WS_WEGU = 2 * MiB, WS_WED = 46 * MiB, WS_XG = 68 * MiB, WS_HE = 136 * MiB, WS_XN3 = 136 * MiB, WS_ROUTE = 240 * MiB;
constexpr size_t WS_END = 256 * MiB;
constexpr size_t RT_E = 0, RT_POS = 128 * KiB, RT_W = 256 * KiB, RT_SLOT = 384 * KiB, RT_SLOTW = 512 * KiB;
constexpr int CW_BAR = 4096;
constexpr int CW_CNT = 64;
constexpr int LDS_BYTES = 155648, MISC_OFF = 153600;
struct Frame {
    LAS unsigned char* lds;
    int tid, lane, wave, vcu, G;
    const float* in[37];
    float* out;
    unsigned char* ws;
};
template <class Tp> __device__ __forceinline__ Tp* wsp(const Frame& F, size_t off) { return (Tp*)(F.ws + off); }

enum { I_X = 0, I_NMG, I_NFG, I_NOG, I_WIN, I_WOUT, I_GNG, I_GWS, I_GBS, I_LBL, I_ONG, I_FG, I_FU, I_FD,
       I_RMIX, I_RWR, I_RWK, I_RWV, I_RWO, I_RW0, I_RW1, I_RW2, I_RA0, I_RA1, I_RA2, I_RG1, I_RG2, I_RKK, I_RKA, I_RRK, I_RLG, I_RLB,
       I_MR, I_MRB, I_MG, I_MU, I_MD };

struct Job { const float* src; int K, N; bf16* dst; int ldd, rowbase, kofs; const float* scale; int ilv; };
__device__ __forceinline__ int job_items(const Job& j) { return (j.K / 64) * (j.N / 32); }
__device__ __forceinline__ void conv_item(const Job& J, int item, LAS float* scr, int lane) {
    const int nblk = J.N / 32, kb = item / nblk, nb = item % nblk, k0 = 64 * kb, n0 = 32 * nb;
    const int drow0 = J.ilv ? ((n0 >> 7) * 256 + (J.ilv - 1) * 128 + (n0 & 127)) : (J.rowbase + n0);
    float tmp[32];
#pragma unroll
    for (int i = 0; i < 32; ++i) { const int kk = 2 * i + (lane >> 5); tmp[i] = __builtin_nontemporal_load(J.src + (size_t)(k0 + kk) * J.N + n0 + (lane & 31)); }
    if (J.scale) {
#pragma unroll
        for (int i = 0; i < 32; ++i) tmp[i] *= J.scale[k0 + 2 * i + (lane >> 5)]; }
#pragma unroll
    for (int i = 0; i < 32; ++i) scr[(2 * i + (lane >> 5)) * 33 + (lane & 31)] = tmp[i];
    LDS_WAIT(); asm volatile("" ::: "memory");
    const int c = lane & 7;
#pragma unroll
    for (int j = 0; j < 4; ++j) { const int n = (lane >> 3) + 8 * j; const LAS float* s = scr + (8 * c) * 33 + n;
        v4u o; o.x = pk2(s[0 * 33], s[1 * 33]); o.y = pk2(s[2 * 33], s[3 * 33]); o.z = pk2(s[4 * 33], s[5 * 33]); o.w = pk2(s[6 * 33], s[7 * 33]);
        *(v4u*)(J.dst + (size_t)(drow0 + n) * J.ldd + J.kofs + k0 + 8 * c) = o; }
    LDS_WAIT(); asm volatile("" ::: "memory");
}
__device__ __forceinline__ Job p0_job(const Frame& F, int j) {
    Job J; J.scale = nullptr; J.ilv = 0; J.rowbase = 0; J.kofs = 0;
    const float* mix = F.in[I_RMIX];
    switch (j) {
    case 0: J.src = F.in[I_WIN]; J.K = 1024; J.N = 3072; J.dst = wsp<bf16>(F, WS_WIN); J.ldd = 1024; break;
    case 1: J.src = F.in[I_WOUT]; J.K = 1024; J.N = 1024; J.dst = wsp<bf16>(F, WS_WOUT); J.ldd = 1024; break;
    case 2: J.src = F.in[I_FG]; J.K = 1024; J.N = DFF; J.dst = wsp<bf16>(F, WS_WGU); J.ldd = 1024; J.ilv = 1; break;
    case 3: J.src = F.in[I_FU]; J.K = 1024; J.N = DFF; J.dst = wsp<bf16>(F, WS_WGU); J.ldd = 1024; J.ilv = 2; break;
    case 4: J.src = F.in[I_FD]; J.K = DFF; J.N = 1024; J.dst = wsp<bf16>(F, WS_WD); J.ldd = DFF; break;
    case 5: J.src = F.in[I_RWO]; J.K = 1024; J.N = 1024; J.dst = wsp<bf16>(F, WS_WO); J.ldd = 1024; break;
    case 6: J.src = F.in[I_RW2]; J.K = 64; J.N = 1024; J.dst = wsp<bf16>(F, WS_W2T); J.ldd = 64; break;
    case 7: J.src = F.in[I_RA2]; J.K = 64; J.N = 1024; J.dst = wsp<bf16>(F, WS_W2T) + 1024 * 64; J.ldd = 64; break;
    case 8: J.src = F.in[I_RG2]; J.K = 128; J.N = 1024; J.dst = wsp<bf16>(F, WS_W2T) + 2 * 1024 * 64; J.ldd = 128; break;
    default: {
        const int q = (j - 9) >> 1, sc = (j - 9) & 1;
        J.K = 1024; J.dst = wsp<bf16>(F, WS_WR); J.ldd = 2048; J.kofs = sc ? 1024 : 0;
        if (q == 0) { J.src = F.in[I_RWR]; J.N = 1024; J.rowbase = 0; if (sc) J.scale = mix + 0 * 1024; }
        else if (q == 1) { J.src = F.in[I_RWK]; J.N = 1024; J.rowbase = 1024; if (sc) J.scale = mix + 2 * 1024; }
        else if (q == 2) { J.src = F.in[I_RWV]; J.N = 1024; J.rowbase = 2048; if (sc) J.scale = mix + 3 * 1024; }
        else if (q == 3) { J.src = F.in[I_RW1]; J.N = 64; J.rowbase = 3072; if (sc) J.scale = mix + 1 * 1024; }
        else if (q == 4) { J.src = F.in[I_RA1]; J.N = 64; J.rowbase = 3136; if (sc) J.scale = mix + 4 * 1024; }
        else { J.src = F.in[I_RG1]; J.N = 128; J.rowbase = 3200; if (sc) J.scale = mix + 5 * 1024; }
    } }
    return J;
}
constexpr int P0_NJOBS = 21;
__device__ __forceinline__ Job moe_job(const Frame& F, int j) {
    Job J; J.scale = nullptr; J.rowbase = 0; J.kofs = 0; J.ilv = 0;
    const int e = j / 3, w = j % 3;
    if (w < 2) { J.src = F.in[w == 0 ? I_MG : I_MU] + (size_t)e * 1024 * DFE; J.K = 1024; J.N = DFE; J.dst = wsp<bf16>(F, WS_WEGU) + (size_t)e * 2 * DFE * 1024; J.ldd = 1024; J.ilv = w + 1; }
    else { J.src = F.in[I_MD] + (size_t)e * DFE * 1024; J.K = DFE; J.N = 1024; J.dst = wsp<bf16>(F, WS_WED) + (size_t)e * 1024 * DFE; J.ldd = DFE; }
    return J;
}
__device__ __forceinline__ void rms_row(const float* xrow, const float* g, int lane, f32x4 (&v)[4]) {
    const f32x4* xr = (const f32x4*)xrow + lane; float s = 0.f;
#pragma unroll
    for (int j = 0; j < 4; ++j) { v[j] = xr[64 * j]; s += (v[j].x * v[j].x + v[j].y * v[j].y) + (v[j].z * v[j].z + v[j].w * v[j].w); }
    const float rs = 1.f / sqrtf(wave_sum(s) * (1.f / D) + RMS_EPS);
    const f32x4* gr = (const f32x4*)g + lane;
#pragma unroll
    for (int j = 0; j < 4; ++j) v[j] = v[j] * rs * gr[64 * j];
}
__device__ __forceinline__ void store_row_bf16(bf16* orow, int lane, const f32x4 (&v)[4]) {
    v2u* o8 = (v2u*)orow + lane;
#pragma unroll
    for (int j = 0; j < 4; ++j) o8[64 * j] = pk4(v[j]);
}
__device__ __forceinline__ void run_jobs(const Frame& F, bool moe) {
    LAS float* scr = (LAS float*)(F.lds + F.wave * 16384);
    const int gw = F.vcu * NWAVES + F.wave, NGW = F.G * NWAVES;
    const int njobs = moe ? 24 : P0_NJOBS;
    int base = 0;
    for (int j = 0; j < njobs; ++j) {
        const Job J = moe ? moe_job(F, j) : p0_job(F, j);
        const int n = job_items(J);
        int it = (gw - base % NGW + NGW) % NGW;
        for (; it < n; it += NGW) conv_item(J, it, scr, F.lane);
        base += n;
    }
}
__device__ __forceinline__ void p0_prologue(const Frame& F) {
    run_jobs(F, false);
    const int gt = F.vcu * NTHREADS + F.tid, NGT = F.G * NTHREADS;
    { const float* ws = F.in[I_GWS]; bf16* o = wsp<bf16>(F, WS_WSM);
      for (int i = gt; i < 4 * 128 * 128; i += NGT) { const int t = (i >> 7) & 127, s = i & 127; o[i] = (bf16)f2bf(s <= t ? ws[i] : 0.f); } }
    { const float* l = F.in[I_LBL]; float* o = wsp<float>(F, WS_LB);
      for (int i = gt; i < 512; i += NGT) { const float a = l[i], b = l[512 + i], mx = fmaxf(a, b), ea = expf(a - mx), eb = expf(b - mx); o[i] = ea / (ea + eb); } }
    const int gw = F.vcu * NWAVES + F.wave, NGW = F.G * NWAVES;
    bf16* XN = wsp<bf16>(F, WS_XN);
    for (int m = gw; m < M; m += NGW) { f32x4 v[4]; rms_row(F.in[I_X] + (size_t)m * D, F.in[I_NMG], F.lane, v); store_row_bf16(XN + (size_t)m * D, F.lane, v); }
}
namespace epi {
using pg8::Unit; using pg8::HALF; using pg8::BM;
typedef float f32x4 __attribute__((ext_vector_type(4)));
struct MixIn {
    static constexpr bool PERM = true;
    bf16* Z; const float* lb;
    __device__ __forceinline__ void operator()(const f32x4 (&acc)[2][2][4][2], const Unit& u, int wr, int wc, int fr, int fq) const {
        const int seg = u.pn >> 1;
        const int row0 = u.pm * BM + wr * 64 + fr, col0 = u.pn * BM + wc * 32 + 8 * fq;
#pragma unroll
        for (int ai = 0; ai < 2; ++ai)
#pragma unroll
            for (int m = 0; m < 4; ++m) { bf16* rowp = Z + (size_t)(row0 + ai * HALF + m * 16) * MIX_IN + col0;
#pragma unroll
                for (int bj = 0; bj < 2; ++bj) { float v[8];
#pragma unroll
                    for (int i = 0; i < 4; ++i) { v[i] = acc[ai][bj][m][0][i]; v[4 + i] = acc[ai][bj][m][1][i]; }
                    if (seg < 2) {
#pragma unroll
                        for (int i = 0; i < 8; ++i) v[i] = fgelu_tanh(v[i]);
                    } else if (seg == 2 || seg == 5) {
#pragma unroll
                        for (int i = 0; i < 8; ++i) v[i] = fsilu(v[i]);
                    } else if (seg == 3) {
                        const float* lbp = lb + (col0 + bj * HALF - 1536);
#pragma unroll
                        for (int i = 0; i < 8; ++i) { const float l = lbp[i]; v[i] = __logf(l + (1.f - l) * fsigmoid(v[i])); }
                    }
                    v4u w; w.x = pk2(v[0], v[1]); w.y = pk2(v[2], v[3]); w.z = pk2(v[4], v[5]); w.w = pk2(v[6], v[7]);
                    *(v4u*)(rowp + bj * HALF) = w; } }
    }
};
struct Resid {
    static constexpr bool PERM = false;
    const float* base; float* out;
    __device__ __forceinline__ void operator()(const f32x4 (&acc)[2][2][4][2], const Unit& u, int wr, int wc, int fr, int fq) const {
        const int row0 = u.pm * BM + wr * 64 + fr, col0 = u.pn * BM + wc * 32 + 4 * fq;
#pragma unroll
        for (int ai = 0; ai < 2; ++ai)
#pragma unroll
            for (int m = 0; m < 4; ++m) { const size_t off = (size_t)(row0 + ai * HALF + m * 16) * D + col0;
#pragma unroll
                for (int bj = 0; bj < 2; ++bj)
#pragma unroll
                    for (int n = 0; n < 2; ++n) { const size_t p = off + bj * HALF + n * 16; const f32x4 b = *(const f32x4*)(base + p); *(f32x4*)(out + p) = b + acc[ai][bj][m][n]; } }
    }
};
struct SwiGlu {
    static constexpr bool PERM = true;
    bf16* H; int ld; const float* rowscale;
    __device__ __forceinline__ void operator()(const f32x4 (&acc)[2][2][4][2], const Unit& u, int wr, int wc, int fr, int fq) const {
        const int row0 = u.pm * BM + wr * 64 + fr, col0 = u.pn * HALF + wc * 32 + 8 * fq;
#pragma unroll
        for (int ai = 0; ai < 2; ++ai)
#pragma unroll
            for (int m = 0; m < 4; ++m) { const int row = row0 + ai * HALF + m * 16; const float sc = rowscale ? rowscale[row] : 1.f; float v[8];
#pragma unroll
                for (int i = 0; i < 4; ++i) { v[i] = fsilu(acc[ai][0][m][0][i]) * acc[ai][1][m][0][i] * sc; v[4 + i] = fsilu(acc[ai][0][m][1][i]) * acc[ai][1][m][1][i] * sc; }
                v4u w; w.x = pk2(v[0], v[1]); w.y = pk2(v[2], v[3]); w.z = pk2(v[4], v[5]); w.w = pk2(v[6], v[7]);
                *(v4u*)(H + (size_t)row * ld + col0) = w; }
    }
};
struct RwkvProj {
    static constexpr bool PERM = true;
    bf16* R; size_t split_stride; bf16* LR;
    __device__ __forceinline__ void operator()(const f32x4 (&acc)[2][2][4][2], const Unit& u, int wr, int wc, int fr, int fq) const {
        const int row0 = u.pm * BM + wr * 64 + fr;
        const bool lora = (u.pn == 12);
        bf16* base = lora ? LR : (R + (size_t)(u.pn >> 2) * split_stride);
        const int ld = lora ? 256 : D;
        const int col0 = (lora ? 0 : (u.pn & 3) * BM) + wc * 32 + 8 * fq;
#pragma unroll
        for (int ai = 0; ai < 2; ++ai)
#pragma unroll
            for (int m = 0; m < 4; ++m) { bf16* rowp = base + (size_t)(row0 + ai * HALF + m * 16) * ld + col0;
#pragma unroll
                for (int bj = 0; bj < 2; ++bj) { float v[8];
#pragma unroll
                    for (int i = 0; i < 4; ++i) { v[i] = acc[ai][bj][m][0][i]; v[4 + i] = acc[ai][bj][m][1][i]; }
                    if (lora) {
                        if (bj == 1) {
#pragma unroll
                            for (int i = 0; i < 8; ++i) v[i] = fsigmoid(v[i]);
                        } else if (wc < 2) {
#pragma unroll
                            for (int i = 0; i < 8; ++i) v[i] = ftanh(v[i]);
                        }
                    }
                    v4u w; w.x = pk2(v[0], v[1]); w.y = pk2(v[2], v[3]); w.z = pk2(v[4], v[5]); w.w = pk2(v[6], v[7]);
                    *(v4u*)(rowp + bj * HALF) = w; } }
    }
};
struct StoreBf16 {
    static constexpr bool PERM = true;
    bf16* O; int ld;
    __device__ __forceinline__ void operator()(const f32x4 (&acc)[2][2][4][2], const Unit& u, int wr, int wc, int fr, int fq) const {
        const int row0 = u.pm * BM + wr * 64 + fr, col0 = u.pn * BM + wc * 32 + 8 * fq;
#pragma unroll
        for (int ai = 0; ai < 2; ++ai)
#pragma unroll
            for (int m = 0; m < 4; ++m) { bf16* rowp = O + (size_t)(row0 + ai * HALF + m * 16) * ld + col0;
#pragma unroll
                for (int bj = 0; bj < 2; ++bj) { const f32x4 v0 = acc[ai][bj][m][0], v1 = acc[ai][bj][m][1];
                    v4u w; w.x = pk2(v0[0], v0[1]); w.y = pk2(v0[2], v0[3]); w.z = pk2(v1[0], v1[1]); w.w = pk2(v1[2], v1[3]);
                    *(v4u*)(rowp + bj * HALF) = w; } }
    }
};
}
constexpr int HG_L = 64, HG_NC = T / HG_L;
__device__ __forceinline__ void gmlp_unit(const Frame& F, int unit) {
    const int g = unit & 3, n = (unit >> 2) & 63, b = unit >> 8;
    const int m0 = b * T + n * 128;
    LAS bf16* WM = (LAS bf16*)F.lds; LAS bf16* VNT = (LAS bf16*)(F.lds + 34816);
    const bf16* Z = wsp<bf16>(F, WS_Z); bf16* Y = wsp<bf16>(F, WS_XN);
    const bf16* wsm = wsp<bf16>(F, WS_WSM) + g * 16384;
    const float* gng = F.in[I_GNG] + g * 128;
#pragma unroll
    for (int i = 0; i < 4; ++i) { const int id = F.tid + 512 * i, row = id >> 4, cc = id & 15;
        *(LAS v4u*)(WM + row * 136 + cc * 8) = *(const v4u*)(wsm + row * 128 + cc * 8); }
#pragma unroll
    for (int i = 0; i < 4; ++i) { const int id = F.tid + 512 * i, s = id >> 4, cc = id & 15;
        const v4u raw = *(const v4u*)(Z + (size_t)(m0 + s) * MIX_IN + 512 + g * 128 + cc * 8);
        float v[8]; v[0] = bflo(raw.x); v[1] = bfhi(raw.x); v[2] = bflo(raw.y); v[3] = bfhi(raw.y); v[4] = bflo(raw.z); v[5] = bfhi(raw.z); v[6] = bflo(raw.w); v[7] = bfhi(raw.w);
        float sm = 0.f;
#pragma unroll
        for (int j = 0; j < 8; ++j) sm += v[j];
        sm += __shfl_xor(sm, 1); sm += __shfl_xor(sm, 2); sm += __shfl_xor(sm, 4); sm += __shfl_xor(sm, 8);
        const float mu = sm * (1.f / 128.f); float sq = 0.f;
#pragma unroll
        for (int j = 0; j < 8; ++j) { v[j] -= mu; sq += v[j] * v[j]; }
        sq += __shfl_xor(sq, 1); sq += __shfl_xor(sq, 2); sq += __shfl_xor(sq, 4); sq += __shfl_xor(sq, 8);
        const float rstd = 1.f / sqrtf(sq * (1.f / 128.f) + LN_EPS);
#pragma unroll
        for (int j = 0; j < 8; ++j) VNT[(cc * 8 + j) * 136 + s] = (bf16)f2bf(v[j] * rstd * gng[cc * 8 + j]); }
    __syncthreads();
    const int fr = F.lane & 15, fq = F.lane >> 4, t0 = 16 * F.wave, nks = (F.wave >> 1) + 1;
    f32x4 acc[8];
#pragma unroll
    for (int j = 0; j < 8; ++j) acc[j] = (f32x4){0.f, 0.f, 0.f, 0.f};
    for (int ks = 0; ks < nks; ++ks) {
        const bf16x8 a = *(const LAS bf16x8*)(WM + (t0 + fr) * 136 + ks * 32 + fq * 8);
#pragma unroll
        for (int j = 0; j < 8; ++j) { const bf16x8 bb = *(const LAS bf16x8*)(VNT + (16 * j + fr) * 136 + ks * 32 + fq * 8);
            acc[j] = __builtin_amdgcn_mfma_f32_16x16x32_bf16(bb, a, acc[j], 0, 0, 0); }
    }
    const int t = t0 + fr; const float bs = F.in[I_GBS][g * 128 + t];
    const bf16* zr = Z + (size_t)(m0 + t) * MIX_IN + g * 128; bf16* yr = Y + (size_t)(m0 + t) * D + g * 128;
#pragma unroll
    for (int j = 0; j < 8; ++j) { const int c = 16 * j + 4 * fq; const v2u ur = *(const v2u*)(zr + c);
        f32x4 o; o[0] = bflo(ur.x) * (acc[j][0] + bs); o[1] = bfhi(ur.x) * (acc[j][1] + bs); o[2] = bflo(ur.y) * (acc[j][2] + bs); o[3] = bfhi(ur.y) * (acc[j][3] + bs);
        *(v2u*)(yr + c) = pk4(o); }
    __syncthreads();
}
__device__ __forceinline__ void hg_load_lf(const bf16* Z, int m0, int h, int k, int tq, float (&lf)[16]) {
#pragma unroll
    for (int i = 0; i < 16; ++i) lf[i] = bf2f(Z[(size_t)(m0 + 16 * tq + i) * MIX_IN + 1536 + h * 128 + k]);
}
__device__ __forceinline__ void hgrn_pre_unit(const Frame& F, int unit) {
    const int c = unit & 127, h = (unit >> 7) & 3, b = unit >> 9;
    const int m0 = b * T + c * HG_L;
    LAS bf16* KDT = (LAS bf16*)F.lds; LAS bf16* VT = (LAS bf16*)(F.lds + 18432); LAS float* PART = (LAS float*)(F.lds + 36864);
    const bf16* Z = wsp<bf16>(F, WS_Z);
    const int k = F.tid & 127, tq = F.tid >> 7;
    float lf[16]; hg_load_lf(Z, m0, h, k, tq, lf);
    float pre[16]; float run = 0.f;
#pragma unroll
    for (int i = 0; i < 16; ++i) { run += lf[i]; pre[i] = run; }
    PART[tq * 128 + k] = run;
    __syncthreads();
    float off = 0.f, bend = 0.f;
#pragma unroll
    for (int q = 0; q < 4; ++q) { const float p = PART[q * 128 + k]; bend += p; off += (q < tq) ? p : 0.f; }
    unsigned kd[8], vv[8];
#pragma unroll
    for (int i = 0; i < 8; ++i) {
        const float k0 = (1.f - fexp(lf[2 * i])) * fexp(bend - (off + pre[2 * i])), k1 = (1.f - fexp(lf[2 * i + 1])) * fexp(bend - (off + pre[2 * i + 1]));
        kd[i] = pk2(k0, k1);
        const unsigned v0 = Z[(size_t)(m0 + 16 * tq + 2 * i) * MIX_IN + 2048 + h * 128 + k], v1 = Z[(size_t)(m0 + 16 * tq + 2 * i + 1) * MIX_IN + 2048 + h * 128 + k];
        vv[i] = v0 | (v1 << 16);
    }
    *(LAS v4u*)(KDT + k * 72 + 16 * tq) = (v4u){kd[0], kd[1], kd[2], kd[3]}; *(LAS v4u*)(KDT + k * 72 + 16 * tq + 8) = (v4u){kd[4], kd[5], kd[6], kd[7]};
    *(LAS v4u*)(VT + k * 72 + 16 * tq) = (v4u){vv[0], vv[1], vv[2], vv[3]}; *(LAS v4u*)(VT + k * 72 + 16 * tq + 8) = (v4u){vv[4], vv[5], vv[6], vv[7]};
    if (tq == 0) wsp<float>(F, WS_HGD)[unit * 128 + k] = fexp(bend);
    __syncthreads();
    const int fr = F.lane & 15, fq = F.lane >> 4, v0 = 16 * F.wave;
    bf16* inc = wsp<bf16>(F, WS_HGI) + (size_t)unit * 16384;
#pragma unroll
    for (int j = 0; j < 8; ++j) { f32x4 acc = (f32x4){0.f, 0.f, 0.f, 0.f};
        acc = mm_tile<2>(VT, 72, KDT, 72, v0, 16 * j, acc, fr, fq);
        *(v2u*)(inc + (v0 + fr) * 128 + 16 * j + 4 * fq) = pk4(acc); }
    __syncthreads();
}
__device__ __forceinline__ void hgrn_scan(const Frame& F) {
    for (int gt = F.vcu * NTHREADS + F.tid; gt < 8 * 4096; gt += F.G * NTHREADS) {
    const int bh = gt >> 12, e = (gt & 4095) * 4, k = e & 127;
    const bf16* __restrict__ inc = wsp<bf16>(F, WS_HGI) + (size_t)bh * HG_NC * 16384 + e;
    bf16* __restrict__ st = wsp<bf16>(F, WS_HGS) + (size_t)bh * HG_NC * 16384 + e;
    const float* __restrict__ dd = wsp<float>(F, WS_HGD) + (size_t)bh * HG_NC * 128 + k;
    f32x4 S = (f32x4){0.f, 0.f, 0.f, 0.f};
#pragma unroll 4
    for (int c = 0; c < HG_NC; ++c) {
        const v2u iv = *(const v2u*)(inc + (size_t)c * 16384); const f32x4 d = *(const f32x4*)(dd + c * 128);
        *(v2u*)(st + (size_t)c * 16384) = pk4(S);
        S[0] = d[0] * S[0] + bflo(iv.x); S[1] = d[1] * S[1] + bfhi(iv.x); S[2] = d[2] * S[2] + bflo(iv.y); S[3] = d[3] * S[3] + bfhi(iv.y);
    }
    }
}
__device__ __forceinline__ void hgrn_post_unit(const Frame& F, int unit) {
    const int c = unit & 127, h = (unit >> 7) & 3, b = unit >> 9;
    const int m0 = b * T + c * HG_L;
    LAS bf16* QD = (LAS bf16*)F.lds; LAS bf16* QP = (LAS bf16*)(F.lds + 17408); LAS bf16* KP = (LAS bf16*)(F.lds + 34816);
    LAS bf16* VT = (LAS bf16*)(F.lds + 52224); LAS bf16* SC = (LAS bf16*)(F.lds + 70656);
    LAS float* PART = (LAS float*)(F.lds + 79872); LAS float* RS = (LAS float*)(F.lds + 81920);
    const bf16* Z = wsp<bf16>(F, WS_Z); bf16* Y = wsp<bf16>(F, WS_XN);
    const int k = F.tid & 127, tq = F.tid >> 7;
    float lf[16]; hg_load_lf(Z, m0, h, k, tq, lf);
    float pre[16]; float run = 0.f;
#pragma unroll
    for (int i = 0; i < 16; ++i) { run += lf[i]; pre[i] = run; }
    PART[tq * 128 + k] = run;
    __syncthreads();
    const float p0 = PART[k], p1 = PART[128 + k], p2 = PART[256 + k];
    const float off = (tq > 0 ? p0 : 0.f) + (tq > 1 ? p1 : 0.f) + (tq > 2 ? p2 : 0.f), bm = p0 + p1;
    unsigned vv[8];
#pragma unroll
    for (int i = 0; i < 16; ++i) {
        const int t = 16 * tq + i; const float bb = off + pre[i];
        const float q = bf2f(Z[(size_t)(m0 + t) * MIX_IN + 1024 + h * 128 + k]);
        const float kk = 1.f - fexp(lf[i]);
        const float dq = fminf(fmaxf(bb - bm, -80.f), 80.f);
        QD[t * 136 + k] = (bf16)f2bf(q * fexp(bb)); QP[t * 136 + k] = (bf16)f2bf(q * fexp(dq)); KP[t * 136 + k] = (bf16)f2bf(kk * fexp(-dq));
        const unsigned vr = Z[(size_t)(m0 + t) * MIX_IN + 2048 + h * 128 + k];
        if (i & 1) vv[i >> 1] |= vr << 16; else vv[i >> 1] = vr;
    }
    *(LAS v4u*)(VT + k * 72 + 16 * tq) = (v4u){vv[0], vv[1], vv[2], vv[3]}; *(LAS v4u*)(VT + k * 72 + 16 * tq + 8) = (v4u){vv[4], vv[5], vv[6], vv[7]};
    __syncthreads();
    const int fr = F.lane & 15, fq = F.lane >> 4, t0 = 16 * (F.wave >> 1);
#pragma unroll
    for (int j = 0; j < 2; ++j) { const int s0 = 16 * (2 * (F.wave & 1) + j); f32x4 acc = (f32x4){0.f, 0.f, 0.f, 0.f};
        if (s0 <= t0) acc = mm_tile<4>(QP, 136, KP, 136, t0, s0, acc, fr, fq);
        const int t = t0 + fr, s = s0 + 4 * fq;
#pragma unroll
        for (int i = 0; i < 4; ++i) acc[i] = (s + i <= t) ? acc[i] : 0.f;
        *(LAS v2u*)(SC + t * 72 + s) = pk4(acc); }
    __syncthreads();
    const bf16* ST = wsp<bf16>(F, WS_HGS) + (size_t)unit * 16384;
    f32x4 o[4]; float ss = 0.f;
#pragma unroll
    for (int j = 0; j < 4; ++j) { const int v0 = 16 * (4 * (F.wave & 1) + j); f32x4 acc = (f32x4){0.f, 0.f, 0.f, 0.f};
        acc = mm_tile<2>(SC, 72, VT, 72, t0, v0, acc, fr, fq);
#pragma unroll
        for (int ks = 0; ks < 4; ++ks) { const bf16x8 a = *(const LAS bf16x8*)(QD + (t0 + fr) * 136 + ks * 32 + fq * 8);
            const bf16x8 bb = *(const bf16x8*)(ST + (v0 + fr) * 128 + ks * 32 + fq * 8);
            acc = __builtin_amdgcn_mfma_f32_16x16x32_bf16(bb, a, acc, 0, 0, 0); }
        o[j] = acc; ss += (acc[0] * acc[0] + acc[1] * acc[1]) + (acc[2] * acc[2] + acc[3] * acc[3]); }
    ss += __shfl_xor(ss, 16); ss += __shfl_xor(ss, 32);
    if (fq == 0) RS[(t0 + fr) * 2 + (F.wave & 1)] = ss;
    __syncthreads();
    const int t = t0 + fr; const float rstd = 1.f / sqrtf((RS[t * 2] + RS[t * 2 + 1]) * (1.f / 128.f) + RMS_EPS);
    const float* ong = F.in[I_ONG];
#pragma unroll
    for (int j = 0; j < 4; ++j) { const int v = 16 * (4 * (F.wave & 1) + j) + 4 * fq;
        const v2u sg = *(const v2u*)(Z + (size_t)(m0 + t) * MIX_IN + 2560 + h * 128 + v); const f32x4 gg = *(const f32x4*)(ong + v);
        f32x4 r; r[0] = o[j][0] * rstd * gg[0] * bflo(sg.x); r[1] = o[j][1] * rstd * gg[1] * bfhi(sg.x); r[2] = o[j][2] * rstd * gg[2] * bflo(sg.y); r[3] = o[j][3] * rstd * gg[3] * bfhi(sg.y);
        *(v2u*)(Y + (size_t)(m0 + t) * D + 512 + h * 128 + v) = pk4(r); }
    __syncthreads();
}
constexpr int RW_L = 64, RW_NC = T / RW_L;
constexpr int SLOT = 9216;
constexpr int RW_MISC = 16 * SLOT;
#define RW_S(i) ((LAS bf16*)(F.lds + (i) * SLOT))
__device__ __forceinline__ float softplusf(float x) { return fmaxf(x, 0.f) + __logf(1.f + fexp(-fabsf(x))); }
__device__ __forceinline__ void rwkv_pre_unit(const Frame& F, int unit) {
    const int c = unit & 127, h = (unit >> 7) & 15, b = unit >> 11;
    const int m0 = b * T + c * RW_L, hc0 = h * 64;
    bf16* Rb = wsp<bf16>(F, WS_R); bf16* Kb = wsp<bf16>(F, WS_K); const bf16* Vb = wsp<bf16>(F, WS_V); const bf16* LR = wsp<bf16>(F, WS_LR);
    const bf16* w2t = wsp<bf16>(F, WS_W2T); const bf16* a2t = w2t + 1024 * 64;
    LAS float* LW = (LAS float*)(F.lds + 5 * SLOT); LAS float* AA = (LAS float*)(F.lds + 7 * SLOT);
    LAS float* PARTW = (LAS float*)(F.lds + RW_MISC); LAS float* WLs = PARTW + 512;
    const int tid = F.tid, lane = F.lane, wave = F.wave, fr = lane & 15, fq = lane >> 4;
    const int mt = wave >> 1, ntb = 2 * (wave & 1);
    { const int row = tid >> 3, cc = tid & 7; const size_t g = (size_t)(m0 + row) * D + hc0 + cc * 8;
      *(LAS v4u*)(RW_S(0) + row * 72 + cc * 8) = *(const v4u*)(Rb + g);
      *(LAS v4u*)(RW_S(1) + row * 72 + cc * 8) = *(const v4u*)(Kb + g);
      *(LAS v4u*)(RW_S(2) + row * 72 + cc * 8) = *(const v4u*)(Vb + g);
#pragma unroll
      for (int i = 0; i < 2; ++i) { const int id = tid + 512 * i, r2 = id >> 4, c2 = id & 15;
          *(LAS v4u*)(RW_S(3) + r2 * 136 + c2 * 8) = *(const v4u*)(LR + (size_t)(m0 + r2) * 256 + c2 * 8); } }
    __syncthreads();
    { LAS bf16* LRT = RW_S(3);
#pragma unroll
      for (int j = 0; j < 2; ++j) { const int n0 = 16 * (ntb + j); f32x4 aw = (f32x4){0.f, 0.f, 0.f, 0.f}, aa = aw;
#pragma unroll
          for (int ks = 0; ks < 2; ++ks) {
              const bf16x8 xw = *(const LAS bf16x8*)(LRT + (16 * mt + fr) * 136 + ks * 32 + fq * 8);
              const bf16x8 xa = *(const LAS bf16x8*)(LRT + (16 * mt + fr) * 136 + 64 + ks * 32 + fq * 8);
              const bf16x8 bw = *(const bf16x8*)(w2t + (size_t)(hc0 + n0 + fr) * 64 + ks * 32 + fq * 8);
              const bf16x8 ba = *(const bf16x8*)(a2t + (size_t)(hc0 + n0 + fr) * 64 + ks * 32 + fq * 8);
              aw = __builtin_amdgcn_mfma_f32_16x16x32_bf16(bw, xw, aw, 0, 0, 0);
              aa = __builtin_amdgcn_mfma_f32_16x16x32_bf16(ba, xa, aa, 0, 0, 0); }
          const int t = 16 * mt + fr, cl = n0 + 4 * fq;
          const f32x4 w0 = *(const f32x4*)(F.in[I_RW0] + hc0 + cl), a0 = *(const f32x4*)(F.in[I_RA0] + hc0 + cl);
#pragma unroll
          for (int i = 0; i < 4; ++i) { const float wl = -softplusf(-(w0[i] + aw[i])) - 0.5f; LW[t * 68 + cl + i] = -fexp(wl); AA[t * 68 + cl + i] = fsigmoid(a0[i] + aa[i]); } } }
    __syncthreads();
    { const int cl = lane, tq = wave, hc = hc0 + cl;
      float lw[8], pre[8]; float run = 0.f;
#pragma unroll
      for (int i = 0; i < 8; ++i) { lw[i] = LW[(8 * tq + i) * 68 + cl]; run += lw[i]; pre[i] = run; }
      PARTW[tq * 64 + cl] = run;
      __syncthreads();
      float off = 0.f, cL = 0.f;
#pragma unroll
      for (int q = 0; q < 8; ++q) { const float p = PARTW[q * 64 + cl]; cL += p; off += (q < tq) ? p : 0.f; }
      if (tq == 0) WLs[cl] = fexp(cL);
      const float kkw = F.in[I_RKK][hc], kaw = F.in[I_RKA][hc], rkw = F.in[I_RRK][hc];
      unsigned aht[4], btt[4], ktt[4], vt[4];
#pragma unroll
      for (int i = 0; i < 8; ++i) {
          const int t = 8 * tq + i;
          const float r = bf2f(RW_S(0)[t * 72 + cl]), k = bf2f(RW_S(1)[t * 72 + cl]); const unsigned vraw = RW_S(2)[t * 72 + cl];
          const float a = AA[t * 68 + cl];
          const float kkr = k * kkw; const float ss = wave_sum(kkr * kkr);
          const float kk = kkr / fmaxf(sqrtf(ss), 1e-12f);
          const float kp = k * (1.f + (a - 1.f) * kaw), bb = kk * a;
          const float rk = wave_sum(r * kp * rkw);
          if (lane == 0) wsp<float>(F, WS_RKS)[(size_t)(m0 + t) * 16 + h] = rk;
          const float cs = off + pre[i];
          const float ep = fexp(cs), em = fexp(-cs), epv = fexp(cs - lw[i]), eL = fexp(cL - cs);
          const unsigned ah = f2bf(epv * kk), bh = f2bf(bb * em), kh = f2bf(kp * em), rh = f2bf(r * ep), bt = f2bf(bb * eL), kt = f2bf(kp * eL);
          RW_S(3)[t * 72 + cl] = (bf16)ah; RW_S(4)[t * 72 + cl] = (bf16)bh; RW_S(9)[t * 72 + cl] = (bf16)kh; RW_S(10)[t * 72 + cl] = (bf16)rh;
          if (i & 1) { aht[i >> 1] |= ah << 16; btt[i >> 1] |= bt << 16; ktt[i >> 1] |= kt << 16; vt[i >> 1] |= vraw << 16; }
          else { aht[i >> 1] = ah; btt[i >> 1] = bt; ktt[i >> 1] = kt; vt[i >> 1] = vraw; }
      }
      *(LAS v4u*)(RW_S(11) + cl * 72 + 8 * tq) = (v4u){aht[0], aht[1], aht[2], aht[3]};
      *(LAS v4u*)(RW_S(12) + cl * 72 + 8 * tq) = (v4u){btt[0], btt[1], btt[2], btt[3]};
      *(LAS v4u*)(RW_S(13) + cl * 72 + 8 * tq) = (v4u){ktt[0], ktt[1], ktt[2], ktt[3]};
      *(LAS v4u*)(RW_S(14) + cl * 72 + 8 * tq) = (v4u){vt[0], vt[1], vt[2], vt[3]}; }
    __syncthreads();
#pragma unroll
    for (int j = 0; j < 2; ++j) { const int n0 = 16 * (ntb + j), t = 16 * mt + fr, jj = n0 + 4 * fq; const f32x4 z = (f32x4){0.f, 0.f, 0.f, 0.f};
        f32x4 gab = mm_tile<2>(RW_S(3), 72, RW_S(4), 72, 16 * mt, n0, z, fr, fq);
        f32x4 gkb = mm_tile<2>(RW_S(3), 72, RW_S(9), 72, 16 * mt, n0, z, fr, fq);
        f32x4 gbr = mm_tile<2>(RW_S(10), 72, RW_S(4), 72, 16 * mt, n0, z, fr, fq);
        f32x4 gkr = mm_tile<2>(RW_S(10), 72, RW_S(9), 72, 16 * mt, n0, z, fr, fq);
#pragma unroll
        for (int i = 0; i < 4; ++i) { const bool st = (jj + i < t), inc = (jj + i <= t);
            gab[i] = st ? gab[i] : 0.f; gkb[i] = st ? gkb[i] : 0.f; gbr[i] = inc ? gbr[i] : 0.f; gkr[i] = inc ? gkr[i] : 0.f;
            RW_S(1)[(jj + i) * 72 + t] = (bf16)f2bf(gab[i]);
            RW_S(7)[(jj + i) * 72 + t] = (bf16)f2bf((jj + i == t ? 1.f : 0.f) - gab[i]); }
        *(LAS v2u*)(RW_S(0) + t * 72 + jj) = pk4(gab); *(LAS v2u*)(RW_S(2) + t * 72 + jj) = pk4(gkb);
        *(LAS v2u*)(RW_S(5) + t * 72 + jj) = pk4(gbr); *(LAS v2u*)(RW_S(6) + t * 72 + jj) = pk4(gkr); }
    __syncthreads();
    {
        int sX = 1, sXT = 0, sP = 7, sY = 8, sYT = 15, sPn = 3;
        for (int it = 1; it <= 5; ++it) {
#pragma unroll
            for (int j = 0; j < 2; ++j) { const int n0 = 16 * (ntb + j), m = 16 * mt + fr, tt = n0 + 4 * fq;
                f32x4 y = mm_tile<2>(RW_S(sX), 72, RW_S(sXT), 72, 16 * mt, n0, (f32x4){0.f, 0.f, 0.f, 0.f}, fr, fq);
                *(LAS v2u*)(RW_S(sY) + m * 72 + tt) = pk4(y);
#pragma unroll
                for (int i = 0; i < 4; ++i) RW_S(sYT)[(tt + i) * 72 + m] = (bf16)f2bf(y[i]); }
            __syncthreads();
#pragma unroll
            for (int j = 0; j < 2; ++j) { const int n0 = 16 * (ntb + j), m = 16 * mt + fr, tt = n0 + 4 * fq;
                const v2u pr = *(const LAS v2u*)(RW_S(sP) + m * 72 + tt);
                f32x4 p = (f32x4){bflo(pr.x), bfhi(pr.x), bflo(pr.y), bfhi(pr.y)};
                p = mm_tile<2>(RW_S(sP), 72, RW_S(sYT), 72, 16 * mt, n0, p, fr, fq);
                if (it < 5) *(LAS v2u*)(RW_S(sPn) + m * 72 + tt) = pk4(p);
                else {
#pragma unroll
                    for (int i = 0; i < 4; ++i) RW_S(4)[(tt + i) * 72 + m] = (bf16)f2bf(p[i]); } }
            __syncthreads();
            int tmp = sX; sX = sY; sY = tmp; tmp = sXT; sXT = sYT; sYT = tmp; tmp = sP; sP = sPn; sPn = tmp;
        }
    }
#pragma unroll
    for (int j = 0; j < 2; ++j) { const int n0 = 16 * (ntb + j), m = 16 * mt + fr, tt = n0 + 4 * fq; const f32x4 z = (f32x4){0.f, 0.f, 0.f, 0.f};
        const f32x4 ap = mm_tile<2>(RW_S(11), 72, RW_S(4), 72, 16 * mt, n0, z, fr, fq);
        const f32x4 vm = mm_tile<2>(RW_S(14), 72, RW_S(2), 72, 16 * mt, n0, z, fr, fq);
        *(LAS v2u*)(RW_S(9) + m * 72 + tt) = pk4(ap); *(LAS v2u*)(RW_S(3) + m * 72 + tt) = pk4(vm); }
    __syncthreads();
#pragma unroll
    for (int j = 0; j < 2; ++j) { const int n0 = 16 * (ntb + j), m = 16 * mt + fr, tt = n0 + 4 * fq;
        const f32x4 vp = mm_tile<2>(RW_S(3), 72, RW_S(4), 72, 16 * mt, n0, (f32x4){0.f, 0.f, 0.f, 0.f}, fr, fq);
        *(LAS v2u*)(RW_S(7) + m * 72 + tt) = pk4(vp); }
    __syncthreads();
    bf16* OMT = wsp<bf16>(F, WS_OMT); bf16* YL = wsp<bf16>(F, WS_YL);
#pragma unroll
    for (int j = 0; j < 2; ++j) { const int nt = ntb + j, n0 = 16 * nt, m = 16 * mt + fr, nn = n0 + 4 * fq; const f32x4 z = (f32x4){0.f, 0.f, 0.f, 0.f};
        { f32x4 x = mm_tile<2>(RW_S(12), 72, RW_S(9), 72, 16 * mt, n0, z, fr, fq); const float wl = WLs[m];
#pragma unroll
          for (int i = 0; i < 4; ++i) x[i] = ((nn + i == m) ? wl : 0.f) - x[i];
          const int idx = (nt >> 1) * 32 + fq * 8 + (nt & 1) * 4;
          *(v2u*)(Rb + (size_t)(m0 + m) * D + hc0 + idx) = pk4(x); }
        { const f32x4 x1 = mm_tile<2>(RW_S(14), 72, RW_S(13), 72, 16 * mt, n0, z, fr, fq), x2 = mm_tile<2>(RW_S(7), 72, RW_S(12), 72, 16 * mt, n0, z, fr, fq);
          *(v2u*)(Kb + (size_t)(m0 + m) * D + hc0 + fq * 16 + nt * 4) = pk4(x1 - x2); }
        { const f32x4 x1 = mm_tile<2>(RW_S(6), 72, RW_S(14), 72, 16 * mt, n0, z, fr, fq), x2 = mm_tile<2>(RW_S(5), 72, RW_S(7), 72, 16 * mt, n0, z, fr, fq);
          *(v2u*)(YL + (size_t)(m0 + m) * D + hc0 + nn) = pk4(x1 - x2); }
        { const f32x4 x = mm_tile<2>(RW_S(5), 72, RW_S(9), 72, 16 * mt, n0, z, fr, fq);
          const v2u rr = *(const LAS v2u*)(RW_S(10) + m * 72 + nn);
          f32x4 o; o[0] = bflo(rr.x) - x[0]; o[1] = bfhi(rr.x) - x[1]; o[2] = bflo(rr.y) - x[2]; o[3] = bfhi(rr.y) - x[3];
          *(v2u*)(OMT + (size_t)(m0 + m) * D + hc0 + nn) = pk4(o); } }
    __syncthreads();
}
constexpr int RW_SEG = 16, RW_NSEG = RW_NC / RW_SEG;
constexpr size_t WS_PSEG = 243 * MiB, WS_QSEG = 245 * MiB;
#define RW_STEP(A, ps, withpsi) do { v2u _pk[4]; \
        _Pragma("unroll") for (int mt = 0; mt < 4; ++mt) _pk[mt] = pk4(acc[mt]); \
        const v4u _b0 = (v4u){_pk[0].x, _pk[0].y, _pk[1].x, _pk[1].y}, _b1 = (v4u){_pk[2].x, _pk[2].y, _pk[3].x, _pk[3].y}; \
        const bf16x8 _sB0 = __builtin_bit_cast(bf16x8, _b0), _sB1 = __builtin_bit_cast(bf16x8, _b1); \
        _Pragma("unroll") for (int mt = 0; mt < 4; ++mt) { \
            f32x4 _a = (withpsi) ? (f32x4){bflo(ps[2 * mt]), bfhi(ps[2 * mt]), bflo(ps[2 * mt + 1]), bfhi(ps[2 * mt + 1])} : (f32x4){0.f, 0.f, 0.f, 0.f}; \
            _a = __builtin_amdgcn_mfma_f32_16x16x32_bf16(A[mt][0], _sB0, _a, 0, 0, 0); \
            _a = __builtin_amdgcn_mfma_f32_16x16x32_bf16(A[mt][1], _sB1, _a, 0, 0, 0); \
            acc[mt] = _a; } } while (0)
__device__ __forceinline__ void rwkv_scan_a(const Frame& F) {
    const bf16* Rb = wsp<bf16>(F, WS_R); const bf16* Kb = wsp<bf16>(F, WS_K);
    bf16* PSEG = wsp<bf16>(F, WS_PSEG); bf16* QSEG = wsp<bf16>(F, WS_QSEG);
    const int l15 = F.lane & 15, q = F.lane >> 4, w = F.wave;
    const size_t cstep = (size_t)RW_L * D * 2;
    for (int unit = F.vcu; unit < 32 * RW_NSEG; unit += F.G) {
        const int seg = unit & (RW_NSEG - 1), bh = unit >> 3, b = bh >> 4, h = bh & 15, hc0 = h * 64;
        const int mbase = b * T + seg * RW_SEG * RW_L;
        const char* src[2];
#pragma unroll
        for (int j = 0; j < 2; ++j) { const int p = w * 2 + j;
            if (p < 8) { const int mt = p >> 1, sk = p & 1; src[j] = (const char*)(Rb + (size_t)(mbase + 16 * mt + l15) * D + hc0 + sk * 32 + q * 8); }
            else { const int vg = (p - 8) >> 1, half = p & 1; src[j] = (const char*)(Kb + (size_t)(mbase + 16 * vg + l15) * D + hc0 + q * 16 + half * 8); } }
#define RA_ISSUE(c) do { const int _cc = (c) & (RW_SEG - 1); _Pragma("unroll") for (int j = 0; j < 2; ++j) \
        __builtin_amdgcn_global_load_lds((const unsigned*)(src[j] + (size_t)_cc * cstep), (LAS unsigned*)(F.lds + ((c) & 7) * 16384 + (w * 2 + j) * 1024), 16, 0, 0); } while (0)
        f32x4 acc[4];
        if (w < 4) {
#pragma unroll
            for (int i = 0; i < 4; ++i) acc[i] = (f32x4){0.f, 0.f, 0.f, 0.f};
        } else {
#pragma unroll
            for (int mt = 0; mt < 4; ++mt)
#pragma unroll
                for (int i = 0; i < 4; ++i) acc[mt][i] = (16 * mt + 4 * q + i == 16 * (w - 4) + l15) ? 1.f : 0.f;
        }
        for (int c = 0; c < 7; ++c) RA_ISSUE(c);
        asm volatile("s_waitcnt vmcnt(12)" ::: "memory");
        __builtin_amdgcn_s_barrier();
        for (int c = 0; c < RW_SEG; ++c) {
            RA_ISSUE(c + 7);
            LAS unsigned char* slot = F.lds + (c & 7) * 16384;
            bf16x8 A[4][2];
#pragma unroll
            for (int mt = 0; mt < 4; ++mt)
#pragma unroll
                for (int sk = 0; sk < 2; ++sk) A[mt][sk] = *(const LAS bf16x8*)(slot + (mt * 2 + sk) * 1024 + F.lane * 16);
            if (w < 4) {
                const v4u p01 = *(const LAS v4u*)(slot + (8 + w * 2) * 1024 + F.lane * 16), p23 = *(const LAS v4u*)(slot + (9 + w * 2) * 1024 + F.lane * 16);
                const unsigned ps[8] = {p01.x, p01.y, p01.z, p01.w, p23.x, p23.y, p23.z, p23.w};
                RW_STEP(A, ps, true);
            } else { const unsigned ps[8] = {0u, 0u, 0u, 0u, 0u, 0u, 0u, 0u}; RW_STEP(A, ps, false); }
            asm volatile("s_waitcnt vmcnt(12) lgkmcnt(0)" ::: "memory");
            __builtin_amdgcn_s_barrier();
        }
        asm volatile("s_waitcnt vmcnt(0)" ::: "memory");
#undef RA_ISSUE
        if (w < 4) {
#pragma unroll
            for (int mt = 0; mt < 4; ++mt) *(v2u*)(QSEG + ((size_t)unit * 64 + 16 * w + l15) * 64 + q * 16 + mt * 4) = pk4(acc[mt]);
        } else {
            const int pg = w - 4, idx = (pg >> 1) * 32 + (l15 >> 2) * 8 + (pg & 1) * 4 + (l15 & 3);
#pragma unroll
            for (int mt = 0; mt < 4; ++mt)
#pragma unroll
                for (int i = 0; i < 4; ++i) PSEG[((size_t)unit * 64 + 16 * mt + 4 * q + i) * 64 + idx] = (bf16)f2bf(acc[mt][i]);
        }
        __syncthreads();
    }
}
__device__ __forceinline__ void rwkv_scan_c(const Frame& F) {
    const bf16* Rb = wsp<bf16>(F, WS_R); const bf16* Kb = wsp<bf16>(F, WS_K); bf16* S0 = wsp<bf16>(F, WS_S0);
    const bf16* PSEG = wsp<bf16>(F, WS_PSEG); const bf16* QSEG = wsp<bf16>(F, WS_QSEG);
    const int l15 = F.lane & 15, q = F.lane >> 4;
    const size_t cstep = (size_t)RW_L * D * 2;
    for (int unit = F.vcu; unit < 32 * RW_NSEG; unit += F.G) {
        const int seg = unit & (RW_NSEG - 1), bh = unit >> 3, b = bh >> 4, h = bh & 15, hc0 = h * 64;
        const int mbase = b * T + seg * RW_SEG * RW_L;
        if (F.wave >= 4) {
            const int lw = F.wave - 4; const char* src[4];
#pragma unroll
            for (int j = 0; j < 4; ++j) { const int p = lw * 4 + j;
                if (p < 8) { const int mt = p >> 1, sk = p & 1; src[j] = (const char*)(Rb + (size_t)(mbase + 16 * mt + l15) * D + hc0 + sk * 32 + q * 8); }
                else { const int vg = (p - 8) >> 1, half = p & 1; src[j] = (const char*)(Kb + (size_t)(mbase + 16 * vg + l15) * D + hc0 + q * 16 + half * 8); } }
#define RS_ISSUE(c) do { const int _cc = (c) & (RW_SEG - 1); _Pragma("unroll") for (int j = 0; j < 4; ++j) \
        __builtin_amdgcn_global_load_lds((const unsigned*)(src[j] + (size_t)_cc * cstep), (LAS unsigned*)(F.lds + ((c) & 7) * 16384 + (lw * 4 + j) * 1024), 16, 0, 0); } while (0)
            for (int c = 0; c < 7; ++c) RS_ISSUE(c);
            asm volatile("s_waitcnt vmcnt(24)" ::: "memory");
            __builtin_amdgcn_s_barrier();
            for (int c = 0; c < RW_SEG; ++c) { RS_ISSUE(c + 7); asm volatile("s_waitcnt vmcnt(24)" ::: "memory"); __builtin_amdgcn_s_barrier(); }
            asm volatile("s_waitcnt vmcnt(0)" ::: "memory");
#undef RS_ISSUE
        } else {
            const int vg = F.wave;
            f32x4 acc[4];
#pragma unroll
            for (int i = 0; i < 4; ++i) acc[i] = (f32x4){0.f, 0.f, 0.f, 0.f};
            for (int j = 0; j < seg; ++j) { const size_t uj = (size_t)(unit - seg + j);
                bf16x8 A[4][2];
#pragma unroll
                for (int mt = 0; mt < 4; ++mt)
#pragma unroll
                    for (int sk = 0; sk < 2; ++sk) A[mt][sk] = *(const bf16x8*)(PSEG + (uj * 64 + 16 * mt + l15) * 64 + sk * 32 + q * 8);
                const v4u p01 = *(const v4u*)(QSEG + (uj * 64 + 16 * vg + l15) * 64 + q * 16), p23 = *(const v4u*)(QSEG + (uj * 64 + 16 * vg + l15) * 64 + q * 16 + 8);
                const unsigned ps[8] = {p01.x, p01.y, p01.z, p01.w, p23.x, p23.y, p23.z, p23.w};
                RW_STEP(A, ps, true); }
            __builtin_amdgcn_s_barrier();
            for (int c = 0; c < RW_SEG; ++c) {
                const int m0 = mbase + c * RW_L; LAS unsigned char* slot = F.lds + (c & 7) * 16384;
                bf16x8 A[4][2];
#pragma unroll
                for (int mt = 0; mt < 4; ++mt)
#pragma unroll
                    for (int sk = 0; sk < 2; ++sk) A[mt][sk] = *(const LAS bf16x8*)(slot + (mt * 2 + sk) * 1024 + F.lane * 16);
                const v4u p01 = *(const LAS v4u*)(slot + (8 + vg * 2) * 1024 + F.lane * 16), p23 = *(const LAS v4u*)(slot + (9 + vg * 2) * 1024 + F.lane * 16);
#pragma unroll
                for (int mt = 0; mt < 4; ++mt) *(v2u*)(S0 + (size_t)(m0 + 16 * vg + l15) * D + hc0 + 16 * mt + 4 * q) = pk4(acc[mt]);
                const unsigned ps[8] = {p01.x, p01.y, p01.z, p01.w, p23.x, p23.y, p23.z, p23.w};
                RW_STEP(A, ps, true);
                asm volatile("s_waitcnt lgkmcnt(0)" ::: "memory");
                __builtin_amdgcn_s_barrier();
            }
        }
        __syncthreads();
    }
}
__device__ __forceinline__ void rwkv_post(const Frame& F) {
    const int gw = F.vcu * NWAVES + F.wave, NGW = F.G * NWAVES, fr = F.lane & 15, fq = F.lane >> 4;
    bf16* Rb = wsp<bf16>(F, WS_R); const bf16* Vb = wsp<bf16>(F, WS_V); const bf16* LR = wsp<bf16>(F, WS_LR);
    const bf16* OMT = wsp<bf16>(F, WS_OMT); const bf16* YL = wsp<bf16>(F, WS_YL); const bf16* S0 = wsp<bf16>(F, WS_S0);
    const bf16* g2t = wsp<bf16>(F, WS_W2T) + 2 * 1024 * 64; const float* RKS = wsp<float>(F, WS_RKS);
    for (int item = gw; item < 4096 * 4; item += NGW) {
        const int unit = item >> 2, mt = item & 3;
        const int c = unit & 127, h = (unit >> 7) & 15, b = unit >> 11;
        const int m0 = b * T + c * RW_L, hc0 = h * 64, t = 16 * mt + fr; const size_t rowt = (size_t)(m0 + t);
        f32x4 y[4], g[4];
        bf16x8 om[2], lg[4];
#pragma unroll
        for (int ks = 0; ks < 2; ++ks) om[ks] = *(const bf16x8*)(OMT + rowt * D + hc0 + ks * 32 + fq * 8);
#pragma unroll
        for (int ks = 0; ks < 4; ++ks) lg[ks] = *(const bf16x8*)(LR + rowt * 256 + 128 + ks * 32 + fq * 8);
#pragma unroll
        for (int nt = 0; nt < 4; ++nt) {
            const v2u yl = *(const v2u*)(YL + rowt * D + hc0 + 16 * nt + 4 * fq);
            f32x4 a = (f32x4){bflo(yl.x), bfhi(yl.x), bflo(yl.y), bfhi(yl.y)};
#pragma unroll
            for (int ks = 0; ks < 2; ++ks) { const bf16x8 sb = *(const bf16x8*)(S0 + (size_t)(m0 + 16 * nt + fr) * D + hc0 + ks * 32 + fq * 8);
                a = __builtin_amdgcn_mfma_f32_16x16x32_bf16(sb, om[ks], a, 0, 0, 0); }
            y[nt] = a;
            f32x4 gg = (f32x4){0.f, 0.f, 0.f, 0.f};
#pragma unroll
            for (int ks = 0; ks < 4; ++ks) { const bf16x8 gb = *(const bf16x8*)(g2t + (size_t)(hc0 + 16 * nt + fr) * 128 + ks * 32 + fq * 8);
                gg = __builtin_amdgcn_mfma_f32_16x16x32_bf16(gb, lg[ks], gg, 0, 0, 0); }
            g[nt] = gg; }
        float s = 0.f;
#pragma unroll
        for (int nt = 0; nt < 4; ++nt) s += (y[nt][0] + y[nt][1]) + (y[nt][2] + y[nt][3]);
        s += __shfl_xor(s, 16); s += __shfl_xor(s, 32);
        const float mu = s * (1.f / 64.f); float qv = 0.f;
#pragma unroll
        for (int nt = 0; nt < 4; ++nt) { y[nt] = y[nt] - mu; qv += (y[nt][0] * y[nt][0] + y[nt][1] * y[nt][1]) + (y[nt][2] * y[nt][2] + y[nt][3] * y[nt][3]); }
        qv += __shfl_xor(qv, 16); qv += __shfl_xor(qv, 32);
        const float rstd = 1.f / sqrtf(qv * (1.f / 64.f) + GN_EPS);
        const float rk = RKS[rowt * 16 + h];
#pragma unroll
        for (int nt = 0; nt < 4; ++nt) { const int v = hc0 + 16 * nt + 4 * fq;
            const f32x4 lgv = *(const f32x4*)(F.in[I_RLG] + v), lbv = *(const f32x4*)(F.in[I_RLB] + v);
            const v2u vr = *(const v2u*)(Vb + rowt * D + v);
            f32x4 o; o[0] = (y[nt][0] * rstd * lgv[0] + lbv[0] + rk * bflo(vr.x)) * g[nt][0]; o[1] = (y[nt][1] * rstd * lgv[1] + lbv[1] + rk * bfhi(vr.x)) * g[nt][1];
            o[2] = (y[nt][2] * rstd * lgv[2] + lbv[2] + rk * bflo(vr.y)) * g[nt][2]; o[3] = (y[nt][3] * rstd * lgv[3] + lbv[3] + rk * bfhi(vr.y)) * g[nt][3];
            *(v2u*)(Rb + rowt * D + v) = pk4(o); }
    }
}
__device__ __forceinline__ void norm_phase(const Frame& F, const float* g, bf16* XN) {
    const int gw = F.vcu * NWAVES + F.wave, NGW = F.G * NWAVES;
    for (int m = gw; m < M; m += NGW) { f32x4 v[4]; rms_row(F.out + (size_t)m * D, g, F.lane, v); store_row_bf16(XN + (size_t)m * D, F.lane, v); }
}
__device__ __forceinline__ void a2_phase(const Frame& F) {
    const int gw = F.vcu * NWAVES + F.wave, NGW = F.G * NWAVES; const float* g = F.in[I_NMG] + D; bf16* A2 = wsp<bf16>(F, WS_A2);
    for (int blk = gw; blk < M / 8; blk += NGW) {
        const int r0 = 8 * blk; f32x4 prev[4];
        if ((r0 & (T - 1)) == 0) {
#pragma unroll
            for (int j = 0; j < 4; ++j) prev[j] = (f32x4){0.f, 0.f, 0.f, 0.f};
        } else rms_row(F.out + (size_t)(r0 - 1) * D, g, F.lane, prev);
        for (int i = 0; i < 8; ++i) { f32x4 cur[4]; rms_row(F.out + (size_t)(r0 + i) * D, g, F.lane, cur);
            store_row_bf16(A2 + (size_t)(r0 + i) * 2048, F.lane, cur);
            f32x4 dx[4];
#pragma unroll
            for (int j = 0; j < 4; ++j) { dx[j] = prev[j] - cur[j]; prev[j] = cur[j]; }
            store_row_bf16(A2 + (size_t)(r0 + i) * 2048 + D, F.lane, dx); }
    }
}
__device__ __forceinline__ void router_phase(const Frame& F) {
    LAS int* wgc = (LAS int*)(F.lds + 131072); LAS int* wbase = wgc + 8; LAS int* TE = wgc + 16; LAS int* TL = TE + 128; LAS float* TW = (LAS float*)(TL + 128);
    const float* g = F.in[I_NFG] + D; const float* rw = F.in[I_MR]; const float* rb = F.in[I_MRB]; bf16* XN3 = wsp<bf16>(F, WS_XN3);
    for (int blk = F.vcu; blk < M / 64; blk += F.G) {
    if (F.tid < 8) wgc[F.tid] = 0;
    __syncthreads();
    for (int i = 0; i < 8; ++i) {
        const int tl = 8 * F.wave + i, m = 64 * blk + tl;
        if (m < M) {
            f32x4 v[4]; rms_row(F.out + (size_t)m * D, g, F.lane, v); store_row_bf16(XN3 + (size_t)m * D, F.lane, v);
            float lg[8];
#pragma unroll
            for (int e = 0; e < 8; ++e) lg[e] = 0.f;
#pragma unroll
            for (int j = 0; j < 4; ++j)
#pragma unroll
                for (int x = 0; x < 4; ++x) { const int k = 4 * F.lane + 256 * j + x; const f32x4 r0 = *(const f32x4*)(rw + k * 8), r1 = *(const f32x4*)(rw + k * 8 + 4); const float xv = v[j][x];
                    lg[0] += xv * r0[0]; lg[1] += xv * r0[1]; lg[2] += xv * r0[2]; lg[3] += xv * r0[3]; lg[4] += xv * r1[0]; lg[5] += xv * r1[1]; lg[6] += xv * r1[2]; lg[7] += xv * r1[3]; }
#pragma unroll
            for (int e = 0; e < 8; ++e) lg[e] = wave_sum(lg[e]) + rb[e];
            int e1 = 0; float l1 = lg[0];
#pragma unroll
            for (int e = 1; e < 8; ++e) if (lg[e] > l1) { l1 = lg[e]; e1 = e; }
            int e2 = (e1 + 1) & 7; float l2 = -3.0e38f;
#pragma unroll
            for (int e = 0; e < 8; ++e) if (e != e1 && lg[e] > l2) { l2 = lg[e]; e2 = e; }
            const float w1 = 1.f / (1.f + expf(l2 - l1)), w2 = 1.f - w1;
            if (F.lane == 0) { const int a = atomicAdd((int*)&wgc[e1], 1), bb = atomicAdd((int*)&wgc[e2], 1);
                TE[2 * tl] = e1; TE[2 * tl + 1] = e2; TL[2 * tl] = a; TL[2 * tl + 1] = bb; TW[2 * tl] = w1; TW[2 * tl + 1] = w2; }
        }
    }
    __syncthreads();
    if (F.tid < 8) wbase[F.tid] = (int)__hip_atomic_fetch_add((unsigned*)(F.ws + WS_CTL) + CW_CNT + F.tid, (unsigned)wgc[F.tid], RLX_AGENT);
    __syncthreads();
    if (F.tid < 128) { const int tl = F.tid >> 1, m = 64 * blk + tl;
        if (m < M) { unsigned char* rt = F.ws + WS_ROUTE; const int e = TE[F.tid];
            ((int*)(rt + RT_E))[2 * m + (F.tid & 1)] = e; ((int*)(rt + RT_POS))[2 * m + (F.tid & 1)] = wbase[e] + TL[F.tid]; ((float*)(rt + RT_W))[2 * m + (F.tid & 1)] = TW[F.tid]; } }
    __syncthreads();
    }
    run_jobs(F, true);
}
__device__ __forceinline__ void moe_offsets(const Frame& F, int (&toff)[9]) {
    const unsigned* cnt = (const unsigned*)(F.ws + WS_CTL) + CW_CNT; int acc = 0;
#pragma unroll
    for (int e = 0; e < 8; ++e) { toff[e] = acc; acc += ((int)__hip_atomic_load(cnt + e, RLX_AGENT) + 255) >> 8; }
    toff[8] = acc;
}
__device__ __forceinline__ void gather_phase(const Frame& F) {
    int toff[9]; moe_offsets(F, toff);
    const int gw = F.vcu * NWAVES + F.wave, NGW = F.G * NWAVES; unsigned char* rt = F.ws + WS_ROUTE;
    const bf16* XN3 = wsp<bf16>(F, WS_XN3); bf16* XG = wsp<bf16>(F, WS_XG);
    for (int p = gw; p < 2 * M; p += NGW) {
        const int m = p >> 1; const int e = ((const int*)(rt + RT_E))[p], pos = ((const int*)(rt + RT_POS))[p]; const float w = ((const float*)(rt + RT_W))[p];
        int off = 0;
#pragma unroll
        for (int j = 0; j < 8; ++j) off = (e == j) ? toff[j] : off;
        int slot = off * 256 + pos; if ((unsigned)e >= 8u || (unsigned)slot >= (unsigned)XG_ROWS) slot = XG_ROWS - 1;
        const v4u* src = (const v4u*)(XN3 + (size_t)m * D); v4u* dst = (v4u*)(XG + (size_t)slot * D);
        dst[F.lane] = src[F.lane]; dst[64 + F.lane] = src[64 + F.lane];
        if (F.lane == 0) { ((int*)(rt + RT_SLOT))[p] = slot; ((float*)(rt + RT_SLOTW))[slot] = w; }
    }
}
__device__ __forceinline__ void final_phase(const Frame& F) {
    const int gw = F.vcu * NWAVES + F.wave, NGW = F.G * NWAVES; unsigned char* rt = F.ws + WS_ROUTE; const bf16* YE = wsp<bf16>(F, WS_XG);
    const float* g = F.in[I_NOG];
    for (int m = gw; m < M; m += NGW) {
        int s0 = ((const int*)(rt + RT_SLOT))[2 * m], s1 = ((const int*)(rt + RT_SLOT))[2 * m + 1];
        if ((unsigned)s0 >= (unsigned)XG_ROWS) s0 = XG_ROWS - 1; if ((unsigned)s1 >= (unsigned)XG_ROWS) s1 = XG_ROWS - 1;
        const f32x4* xr = (const f32x4*)(F.out + (size_t)m * D) + F.lane; const v2u* y0 = (const v2u*)(YE + (size_t)s0 * D) + F.lane; const v2u* y1 = (const v2u*)(YE + (size_t)s1 * D) + F.lane;
        f32x4 v[4]; float s = 0.f;
#pragma unroll
        for (int j = 0; j < 4; ++j) { const v2u a = y0[64 * j], bq = y1[64 * j]; v[j] = xr[64 * j];
            v[j][0] += bflo(a.x) + bflo(bq.x); v[j][1] += bfhi(a.x) + bfhi(bq.x); v[j][2] += bflo(a.y) + bflo(bq.y); v[j][3] += bfhi(a.y) + bfhi(bq.y);
            s += (v[j][0] * v[j][0] + v[j][1] * v[j][1]) + (v[j][2] * v[j][2] + v[j][3] * v[j][3]); }
        const float rs = 1.f / sqrtf(wave_sum(s) * (1.f / D) + RMS_EPS);
        f32x4* o = (f32x4*)(F.out + (size_t)m * D) + F.lane; const f32x4* gr = (const f32x4*)g + F.lane;
#pragma unroll
        for (int j = 0; j < 4; ++j) o[64 * j] = v[j] * rs * gr[64 * j];
    }
}
constexpr int N_PHASES = 20;
struct Args { const float* in[37]; float* out; unsigned char* ws; int ph_lo, ph_hi; };
__global__ void __launch_bounds__(NTHREADS, 2) fwd_kernel(Args args) {
    extern __shared__ __attribute__((aligned(16))) unsigned char lds_raw[];
    Frame F;
    F.lds = (LAS unsigned char*)lds_raw;
    F.tid = threadIdx.x; F.lane = F.tid & 63; F.wave = __builtin_amdgcn_readfirstlane(F.tid >> 6);
    F.G = gridDim.x; { const int bx = blockIdx.x; F.vcu = (F.G % 8 == 0) ? (bx % 8) * (F.G / 8) + bx / 8 : bx; }
#pragma unroll
    for (int i = 0; i < 37; ++i) F.in[i] = args.in[i];
    F.out = args.out; F.ws = args.ws;
    volatile LAS unsigned* MISC = (volatile LAS unsigned*)(F.lds + MISC_OFF);
    if (F.tid < 64) MISC[F.tid] = 0u;
    __syncthreads();
    const int lo = args.ph_lo, hi = args.ph_hi;
    const bool multi = (hi - lo) > 1;
    XcdBarrier bar; bar.bar = (unsigned*)(F.ws + WS_CTL) + CW_BAR; bar.x = 0; bar.st = nullptr;
    if (multi) bar = xcd_barrier_post((unsigned*)(F.ws + WS_CTL) + CW_BAR, MISC + 8);
#define IN(k) (lo <= (k) && (k) < hi)
#define SEAM(k) do { if (IN(k) && IN((k) + 1)) xcd_barrier(bar); } while (0)
    LAS unsigned char* lds = F.lds;
    const int cu = (int)blockIdx.x;

    if (IN(0)) { p0_prologue(F); } SEAM(0);
    if (IN(1)) { pg8::DenseOrder S; S.init(wsp<bf16>(F, WS_XN), wsp<bf16>(F, WS_WIN), M, MIX_IN, 1024, F.G, cu);
        epi::MixIn E{wsp<bf16>(F, WS_Z), wsp<float>(F, WS_LB)};
        pg8::gemm_phase(lds, 1024, S, E); } SEAM(1);
    if (IN(2)) { for (int u = F.vcu; u < 512; u += F.G) gmlp_unit(F, u);
        for (int u = F.vcu; u < 1024; u += F.G) hgrn_pre_unit(F, u); } SEAM(2);
    if (IN(3)) { hgrn_scan(F); } SEAM(3);
    if (IN(4)) { for (int u = F.vcu; u < 1024; u += F.G) hgrn_post_unit(F, u); } SEAM(4);
    if (IN(5)) { pg8::DenseOrder S; S.init(wsp<bf16>(F, WS_XN), wsp<bf16>(F, WS_WOUT), M, D, 1024, F.G, cu);
        epi::Resid E{F.in[I_X], F.out};
        pg8::gemm_phase(lds, 1024, S, E); } SEAM(5);
    if (IN(6)) { norm_phase(F, F.in[I_NFG], wsp<bf16>(F, WS_XN)); } SEAM(6);
    if (IN(7)) { pg8::DenseOrder S; S.init(wsp<bf16>(F, WS_XN), wsp<bf16>(F, WS_WGU), M, 2 * DFF, 1024, F.G, cu);
        epi::SwiGlu E{wsp<bf16>(F, WS_HF), DFF, nullptr};
        pg8::gemm_phase(lds, 1024, S, E); } SEAM(7);
    if (IN(8)) { pg8::DenseOrder S; S.init(wsp<bf16>(F, WS_HF), wsp<bf16>(F, WS_WD), M, D, DFF, F.G, cu);
        epi::Resid E{F.out, F.out};
        pg8::gemm_phase(lds, DFF, S, E); } SEAM(8);
    if (IN(9)) { a2_phase(F); } SEAM(9);
    if (IN(10)) { pg8::DenseOrder S; S.init(wsp<bf16>(F, WS_A2), wsp<bf16>(F, WS_WR), M, NRW, 2048, F.G, cu);
        epi::RwkvProj E{wsp<bf16>(F, WS_R), (size_t)(WS_K - WS_R) / 2, wsp<bf16>(F, WS_LR)};
        pg8::gemm_phase(lds, 2048, S, E); } SEAM(10);
    if (IN(11)) { for (int u = F.vcu; u < 4096; u += F.G) rwkv_pre_unit(F, u); } SEAM(11);
    if (IN(12)) { rwkv_scan_a(F); xcd_barrier(bar); rwkv_scan_c(F); } SEAM(12);
    if (IN(13)) { rwkv_post(F); } SEAM(13);
    if (IN(14)) { pg8::DenseOrder S; S.init(wsp<bf16>(F, WS_R), wsp<bf16>(F, WS_WO), M, D, 1024, F.G, cu);
        epi::Resid E{F.out, F.out};
        pg8::gemm_phase(lds, 1024, S, E); } SEAM(14);
    if (IN(15)) { router_phase(F); } SEAM(15);
    if (IN(16)) { gather_phase(F); } SEAM(16);
    if (IN(17)) { pg8::MoeOrder S; moe_offsets(F, S.toff); S.ntiles = S.toff[8]; S.nN = 2 * DFE / 256; S.nwg = S.ntiles * S.nN; S.G = F.G; S.c = cu;
        S.A = (const char*)wsp<bf16>(F, WS_XG); S.Bt = (const char*)wsp<bf16>(F, WS_WEGU); S.tstep = (size_t)256 * 1024 * 2; S.estride = (size_t)2 * DFE * 1024 * 2;
        epi::SwiGlu E{wsp<bf16>(F, WS_HE), DFE, (const float*)(F.ws + WS_ROUTE + RT_SLOTW)};
        pg8::gemm_phase(lds, 1024, S, E); } SEAM(17);
    if (IN(18)) { pg8::MoeOrder S; moe_offsets(F, S.toff); S.ntiles = S.toff[8]; S.nN = D / 256; S.nwg = S.ntiles * S.nN; S.G = F.G; S.c = cu;
        S.A = (const char*)wsp<bf16>(F, WS_HE); S.Bt = (const char*)wsp<bf16>(F, WS_WED); S.tstep = (size_t)256 * DFE * 2; S.estride = (size_t)1024 * DFE * 2;
        epi::StoreBf16 E{wsp<bf16>(F, WS_XG), D};
        pg8::gemm_phase(lds, DFE, S, E); } SEAM(18);
    if (IN(19)) { final_phase(F); }
#undef IN
#undef SEAM
}


struct DiagReg { size_t off; int rows, stride, col0, ncols, isf32; float lo, hi; };
struct DiagArgs { DiagReg r[12]; int n; int pad; };
__global__ void diag_count(unsigned char* ws, unsigned* cnt, DiagArgs da) {
    for (int ri = 0; ri < da.n; ++ri) { const DiagReg R = da.r[ri]; const long tot = (long)R.rows * R.ncols; float worst = 0.f;
        for (long i = (long)blockIdx.x * blockDim.x + threadIdx.x; i < tot; i += (long)gridDim.x * blockDim.x) { const long row = i / R.ncols; const int col = (int)(i % R.ncols);
            float v;
            if (R.isf32) v = ((const float*)(ws + R.off))[row * R.stride + R.col0 + col];
            else v = __builtin_bit_cast(float, (unsigned)((const unsigned short*)(ws + R.off))[row * R.stride + R.col0 + col] << 16);
            if (!(v <= R.hi && v >= R.lo)) { float a = fabsf(v); if (!(a < 1e30f)) a = 1e30f; if (a < 1e-30f) a = 1e-30f; worst = fmaxf(worst, a); } }
        if (worst > 0.f) atomicMax(cnt + ri, __float_as_uint(worst)); }
}
__global__ void diag_mark(float* out, unsigned* cnt, DiagArgs da, int total) {
    for (int i = blockIdx.x * blockDim.x + threadIdx.x; i < total; i += gridDim.x * blockDim.x) out[i] = 0.f;
    if (threadIdx.x == 0 && blockIdx.x == 0) { int first = -1; for (int i = da.n - 1; i >= 0; --i) if (cnt[i]) first = i;
        if (first >= 0) { const float w = __uint_as_float(cnt[first]), bound = fmaxf(fabsf(da.r[first].lo), fabsf(da.r[first].hi));
            float m = 1.f + log10f(fmaxf(w / bound, 1.f)) * 0.25f; if (m > 9.5f) m = 9.5f;
            out[0] = sqrtf(1.678e7f * m * powf(10.f, 2.f + first)); } }
}
extern "C" void kernel_launch(void* const* d_in, const int* in_sizes, int n_in, void* d_out, int out_size, void* d_ws, size_t ws_size, hipStream_t stream) {
    static int grid = 0;
    if (grid == 0) {
        if (n_in != 37 || out_size != M * D || ws_size < WS_END) { fprintf(stderr, "kernel_launch: unexpected shapes (n_in %d out %d ws %zu)\n", n_in, out_size, ws_size); grid = -1; return; }
        int dev = 0, cus = 0, per_cu = 0;
        hipGetDevice(&dev); hipDeviceGetAttribute(&cus, hipDeviceAttributeMultiprocessorCount, dev);
        hipFuncSetAttribute((const void*)fwd_kernel, hipFuncAttributeMaxDynamicSharedMemorySize, LDS_BYTES);
        hipOccupancyMaxActiveBlocksPerMultiprocessor(&per_cu, (const void*)fwd_kernel, NTHREADS, LDS_BYTES);
        (void)hipGetLastError();
        grid = cus;
        if (per_cu < 1) fprintf(stderr, "kernel_launch: occupancy query says %d blocks per CU\n", per_cu);
    }
    if (grid < 0) return;
    hipMemsetAsync((char*)d_ws + WS_CTL, 0, CTL_ZERO_BYTES, stream);
    Args a{};
    for (int i = 0; i < 37; ++i) a.in[i] = (const float*)d_in[i];
    a.out = (float*)d_out; a.ws = (unsigned char*)d_ws;
#if MK_N_LAUNCHES == 1
    a.ph_lo = 0; a.ph_hi = N_PHASES;
    hipLaunchKernelGGL(fwd_kernel, dim3(grid), dim3(NTHREADS), LDS_BYTES, stream, a);
#else
    for (int p = 0; p < MK_PH_HI; ++p) { a.ph_lo = p; a.ph_hi = p + 1; hipLaunchKernelGGL(fwd_kernel, dim3(grid), dim3(NTHREADS), LDS_BYTES, stream, a); }
#endif
}
```

```cpp
#include <hip/hip_runtime.h>
#include <cstdio>
#include <cstdint>
#ifndef MK_N_LAUNCHES
#define MK_N_LAUNCHES 1
#endif
#ifndef MK_PH_HI
#define MK_PH_HI 20
#endif
namespace pg8 {
#define PG8_LAS __attribute__((address_space(3)))
typedef unsigned short bf16_t;
typedef short bf16x8 __attribute__((ext_vector_type(8)));
typedef float f32x4 __attribute__((ext_vector_type(4)));
typedef float f32x2 __attribute__((ext_vector_type(2)));
typedef unsigned u32x4 __attribute__((ext_vector_type(4)));
constexpr int BM = 256, BK = 64, HALF = 128, HTB = HALF * BK * 2, STAGE_BYTES = 8 * HTB, NXCD = 8, WGM = 8;

__host__ __device__ __forceinline__ int lds_byte(int r, int c) { const int st = (r >> 4) * 2 + (c >> 5), rr = r & 15, cc = c & 31, ob = rr * 64 + cc * 2; return st * 1024 + (ob ^ (((ob >> 9) & 1) << 5)); }
__host__ __device__ __forceinline__ void stage_rc(int b, int& R, int& C) { const int st = b / 1024, sb = b % 1024, swz = sb ^ (((sb >> 9) & 1) << 5); R = (st >> 1) * 16 + swz / 64; C = (st & 1) * 32 + (swz % 64) / 2; }
__host__ __device__ __forceinline__ int perm32(int rho) { const int n = rho >> 4, i = rho & 15; return 8 * (i >> 2) + 4 * n + (i & 3); }

struct Unit { int pm, pn; const char* A; const char* B; };

struct DenseOrder {
    int nM, nN, nwg, G, c; const char* A; const char* Bt; size_t tstep;
    __device__ void init(const void* A_, const void* Bt_, int M, int N, int K, int G_, int c_) { nM = M / BM; nN = N / BM; nwg = nM * nN; G = G_; c = c_; A = (const char*)A_; Bt = (const char*)Bt_; tstep = (size_t)BM * K * 2; }
    __device__ bool next(int i, Unit& u) const {
        const long L = (long)i * G + c; if (L >= nwg) return false;
        int wgid = (int)L; { const int q = nwg / NXCD, r = nwg % NXCD, xcd = wgid % NXCD, off = wgid / NXCD; wgid = (xcd < r ? xcd * (q + 1) : r * (q + 1) + (xcd - r) * q) + off; }
        const int nig = WGM * nN, gid = wgid / nig, fm = gid * WGM, gsz = (nM - fm) < WGM ? (nM - fm) : WGM;
        u.pm = fm + ((wgid % nig) % gsz); u.pn = (wgid % nig) / gsz;
        u.A = A + (size_t)u.pm * tstep; u.B = Bt + (size_t)u.pn * tstep; return true;
    }
};
struct MoeOrder {
    int ntiles, nN, nwg, G, c; int toff[9]; const char* A; const char* Bt; size_t tstep, estride;
    __device__ bool next(int i, Unit& u) const {
        const long L = (long)i * G + c; if (L >= nwg) return false;
        const int rt = (int)(L % ntiles), pn = (int)(L / ntiles);
        int e = 0;
#pragma unroll
        for (int j = 1; j < 8; ++j) e += (rt >= toff[j]) ? 1 : 0;
        u.pm = rt; u.pn = pn; u.A = A + (size_t)rt * tstep; u.B = Bt + (size_t)e * estride + (size_t)pn * tstep; return true;
    }
};

typedef __bf16 bf16x2_t __attribute__((ext_vector_type(2)));
__device__ __forceinline__ unsigned cvt_pk_bf16(float lo, float hi) { f32x2 v = {lo, hi}; bf16x2_t b = __builtin_convertvector(v, bf16x2_t); return __builtin_bit_cast(unsigned, b); }

template <class Epi, class Sched>
__device__ __forceinline__ void gemm_phase(PG8_LAS unsigned char* lds, const int K, const Sched& S, const Epi& E) {
    const int tid = threadIdx.x, wid = __builtin_amdgcn_readfirstlane(tid >> 6), lane = tid & 63, wr = wid >> 2, wc = wid & 3, fr = lane & 15, fq = lane >> 4;
    const int nt = K / BK;
    unsigned voffA[2], voffB[2];
#pragma unroll
    for (int i = 0; i < 2; ++i) { int R, C; stage_rc(tid * 16 + i * 8192, R, C); const int Rb = Epi::PERM ? ((R & ~31) + perm32(R & 31)) : R;
        voffA[i] = (unsigned)(R * K + C) * 2u; voffB[i] = (unsigned)(Rb * K + C) * 2u; }
    const size_t kstep = (size_t)(BK * 2);
    const size_t hstep = (size_t)HALF * K * 2;
    const unsigned ldsw = (unsigned)wid * 1024u;
    const int aoff = lds_byte(wr * 64 + fr, fq * 8), boff = lds_byte(wc * 32 + fr, fq * 8);
#define PG8_SA(b, h) (((b) * 2 + (h)) * HTB)
#define PG8_SB(b, h) ((4 + (b) * 2 + (h)) * HTB)
#define PG8_STAGE(bufoff, gbase, voff) do { _Pragma("unroll") for (int _i = 0; _i < 2; ++_i) \
        __builtin_amdgcn_global_load_lds((const unsigned*)((const char*)(gbase) + (voff)[_i]), (PG8_LAS unsigned*)(lds + (bufoff) + ldsw + _i * 8192), 16, 0, 0); } while (0)
#define PG8_LDA(dst, b, h) do { _Pragma("unroll") for (int m = 0; m < 4; ++m) _Pragma("unroll") for (int k = 0; k < 2; ++k) dst[m][k] = *(const PG8_LAS bf16x8*)(lds + PG8_SA(b, h) + aoff + m * 2048 + k * 1024); } while (0)
#define PG8_LDB(dst, b, h) do { _Pragma("unroll") for (int n = 0; n < 2; ++n) _Pragma("unroll") for (int k = 0; k < 2; ++k) dst[n][k] = *(const PG8_LAS bf16x8*)(lds + PG8_SB(b, h) + boff + n * 2048 + k * 1024); } while (0)
#define PG8_MMA(ai, bj, At, Bt) do { __builtin_amdgcn_s_setprio(1); _Pragma("unroll") for (int m = 0; m < 4; ++m) _Pragma("unroll") for (int n = 0; n < 2; ++n) _Pragma("unroll") for (int k = 0; k < 2; ++k) \
        acc[ai][bj][m][n] = __builtin_amdgcn_mfma_f32_16x16x32_bf16(Bt[n][k], At[m][k], acc[ai][bj][m][n], 0, 0, 0); __builtin_amdgcn_s_setprio(0); } while (0)
#define PG8_WAIT_V(n) asm volatile("s_waitcnt vmcnt(" #n ")" ::: "memory")
#define PG8_WAIT_L(n) asm volatile("s_waitcnt lgkmcnt(" #n ")" ::: "memory")
#define PG8_BAR __builtin_amdgcn_s_barrier()
#define PG8_SCHED __builtin_amdgcn_sched_barrier(0)
    Unit cur, nxt; int ui = 0;
    if (!S.next(0, cur)) return;
    f32x4 acc[2][2][4][2];
#pragma unroll
    for (int a = 0; a < 2; ++a)
#pragma unroll
        for (int b = 0; b < 2; ++b)
#pragma unroll
            for (int m = 0; m < 4; ++m)
#pragma unroll
                for (int n = 0; n < 2; ++n) acc[a][b][m][n] = (f32x4){0.f, 0.f, 0.f, 0.f};
    bf16x8 At[4][2], B0[2][2], B1[2][2];
    const char* cA = cur.A; const char* cB = cur.B;
    PG8_STAGE(PG8_SB(0, 0), cB, voffB); PG8_STAGE(PG8_SB(0, 1), cB + hstep, voffB); PG8_STAGE(PG8_SA(0, 0), cA, voffA); PG8_STAGE(PG8_SA(0, 1), cA + hstep, voffA);
    if (wr == 1) PG8_BAR;
    PG8_WAIT_V(2); PG8_BAR;
    PG8_STAGE(PG8_SB(1, 0), cB + kstep, voffB); PG8_STAGE(PG8_SA(1, 0), cA + kstep, voffA); PG8_STAGE(PG8_SB(1, 1), cB + hstep + kstep, voffB);
    PG8_WAIT_V(6); PG8_BAR;
    for (;;) {
        const bool has_next = S.next(ui + 1, nxt);
        const char* nA = has_next ? nxt.A : cA; const char* nB = has_next ? nxt.B : cB;
        for (int t = 0; t < nt; t += 2) {
            const bool last = (t == nt - 2);
            const char* a1 = cA + (size_t)(t + 1) * kstep;
            const char* a2 = last ? nA : cA + (size_t)(t + 2) * kstep; const char* b2 = last ? nB : cB + (size_t)(t + 2) * kstep;
            const char* a3 = a2 + kstep; const char* b3 = b2 + kstep;
            PG8_LDB(B0, 0, 0); PG8_LDB(B1, 0, 1); PG8_SCHED; PG8_LDA(At, 0, 0); PG8_STAGE(PG8_SA(1, 1), a1 + hstep, voffA);
            PG8_WAIT_V(8); PG8_WAIT_L(0); PG8_BAR; PG8_MMA(0, 0, At, B0); PG8_MMA(0, 1, At, B1); PG8_BAR; PG8_SCHED;
            PG8_LDA(At, 0, 1); PG8_STAGE(PG8_SB(0, 0), b2, voffB); PG8_STAGE(PG8_SB(0, 1), b2 + hstep, voffB); PG8_STAGE(PG8_SA(0, 0), a2, voffA);
            PG8_WAIT_V(8); PG8_WAIT_L(0); PG8_BAR; PG8_MMA(1, 0, At, B0); PG8_MMA(1, 1, At, B1); PG8_BAR; PG8_SCHED;
            PG8_LDB(B0, 1, 0); PG8_LDB(B1, 1, 1); PG8_SCHED; PG8_LDA(At, 1, 0); PG8_STAGE(PG8_SA(0, 1), a2 + hstep, voffA);
            PG8_WAIT_V(8); PG8_WAIT_L(0); PG8_BAR; PG8_MMA(0, 0, At, B0); PG8_MMA(0, 1, At, B1); PG8_BAR; PG8_SCHED;
            PG8_LDA(At, 1, 1); PG8_STAGE(PG8_SB(1, 0), b3, voffB); PG8_STAGE(PG8_SB(1, 1), b3 + hstep, voffB); PG8_STAGE(PG8_SA(1, 0), a3, voffA);
            PG8_WAIT_V(8); PG8_WAIT_L(0); PG8_BAR; PG8_MMA(1, 0, At, B0); PG8_MMA(1, 1, At, B1); PG8_BAR; PG8_SCHED;
        }
        if (wr == 0) PG8_BAR;
        E(acc, cur, wr, wc, fr, fq);
        if (!has_next) break;
#pragma unroll
        for (int a = 0; a < 2; ++a)
#pragma unroll
            for (int b = 0; b < 2; ++b)
#pragma unroll
                for (int m = 0; m < 4; ++m)
#pragma unroll
                    for (int n = 0; n < 2; ++n) acc[a][b][m][n] = (f32x4){0.f, 0.f, 0.f, 0.f};
        cur = nxt; cA = nA; cB = nB; ++ui;
        if (wr == 1) PG8_BAR;
    }
    PG8_WAIT_V(0);
    PG8_BAR;
#undef PG8_SA
#undef PG8_SB
#undef PG8_STAGE
#undef PG8_LDA
#undef PG8_LDB
#undef PG8_MMA
#undef PG8_WAIT_V
#undef PG8_WAIT_L
#undef PG8_BAR
#undef PG8_SCHED
}
}
#define GAS __attribute__((address_space(1)))
#define LAS __attribute__((address_space(3)))
typedef unsigned short bf16;
typedef unsigned v4u __attribute__((ext_vector_type(4)));
typedef unsigned v2u __attribute__((ext_vector_type(2)));
typedef float f32x4 __attribute__((ext_vector_type(4)));
typedef float f32x2 __attribute__((ext_vector_type(2)));
typedef short bf16x8 __attribute__((ext_vector_type(8)));
typedef short bf16x4 __attribute__((ext_vector_type(4)));
typedef GAS unsigned gu32;
#define RLX_AGENT __ATOMIC_RELAXED, __HIP_MEMORY_SCOPE_AGENT
#define LDS_WAIT() asm volatile("s_waitcnt lgkmcnt(0)" ::: "memory")
#define VM_WAIT() asm volatile("s_waitcnt vmcnt(0)" ::: "memory")
#define LBAR() do { asm volatile("s_waitcnt lgkmcnt(0)" ::: "memory"); __builtin_amdgcn_s_barrier(); asm volatile("" ::: "memory"); } while (0)
__device__ __forceinline__ unsigned f2bf(float f) { return pg8::cvt_pk_bf16(f, 0.f) & 0xffffu; }
__device__ __forceinline__ unsigned pk2(float lo, float hi) { return pg8::cvt_pk_bf16(lo, hi); }
__device__ __forceinline__ float bf2f(unsigned h) { return __builtin_bit_cast(float, h << 16); }
__device__ __forceinline__ float bflo(unsigned w) { return __builtin_bit_cast(float, w << 16); }
__device__ __forceinline__ float bfhi(unsigned w) { return __builtin_bit_cast(float, w & 0xffff0000u); }
__device__ __forceinline__ float fexp(float x) { return __builtin_amdgcn_exp2f(x * 1.4426950408889634f); }
__device__ __forceinline__ float frcp(float x) { return __builtin_amdgcn_rcpf(x); }
__device__ __forceinline__ float fsigmoid(float x) { return frcp(1.f + fexp(-x)); }
__device__ __forceinline__ float fsilu(float x) { return x * fsigmoid(x); }
__device__ __forceinline__ float ftanh(float x) { const float e = fexp(2.f * x); return 1.f - 2.f * frcp(e + 1.f); }
__device__ __forceinline__ float fgelu_tanh(float x) { const float u = 0.7978845608028654f * (x + 0.044715f * x * x * x); return 0.5f * x * (1.f + ftanh(u)); }
__device__ __forceinline__ float wave_sum(float v) {
#pragma unroll
    for (int o = 1; o < 64; o <<= 1) v += __shfl_xor(v, o);
    return v;
}

#define XB_TMO      128
#define XB_XCNT(j)  (256  + 64 * (j))
#define XB_XSUB(j)  (1280 + 64 * (j))
#define XB_XGEN(j)  (2304 + 64 * (j))
#define XB_TOP      3328
#define XB_TOPGEN   3392
#define XCD_BAR_WORDS 3456
#define XB_SPIN_CAP (1u << 22)
__device__ __forceinline__ unsigned xb_ld(unsigned* p)              { return __hip_atomic_load(p, __ATOMIC_RELAXED, __HIP_MEMORY_SCOPE_AGENT); }
__device__ __forceinline__ unsigned xb_add(unsigned* p, unsigned v) { return __hip_atomic_fetch_add(p, v, __ATOMIC_RELAXED, __HIP_MEMORY_SCOPE_AGENT); }
__device__ __forceinline__ unsigned xb_xcc_id() { return (unsigned)__builtin_amdgcn_s_getreg((3 << 11) | 20) & 0xFu; }
#define XB_SPIN(cond, bar) do { unsigned _sp = 0; while (cond) { __builtin_amdgcn_s_sleep(1); \
    if ((++_sp & 255u) == 0u) { if (xb_ld(&(bar)[XB_TMO])) break; if (_sp > XB_SPIN_CAP) { atomicAdd(&(bar)[XB_TMO], 1u); break; } } } } while (0)
struct XcdBarrier { unsigned* bar; unsigned x; volatile LAS unsigned* st; };
__device__ __forceinline__ XcdBarrier xcd_barrier_post(unsigned* bar, volatile LAS unsigned* st) {
    XcdBarrier b; b.bar = bar; b.x = xb_xcc_id(); b.st = st;
    if (threadIdx.x == 0) (void)xb_add(&bar[XB_XCNT(b.x)], 1u);
    return b;
}
__device__ __forceinline__ void xcd_barrier_complete(unsigned* bar, unsigned x, unsigned& nloc, unsigned& nx) {
    const unsigned G = gridDim.x * gridDim.y * gridDim.z;
    unsigned sum, cnt, mine, sp = 0u;
    for (;;) {
        sum = 0u; cnt = 0u; mine = 0u;
#pragma unroll
        for (unsigned j = 0; j < 16; ++j) { const unsigned c = xb_ld(&bar[XB_XCNT(j)]); sum += c; cnt += (c > 0u) ? 1u : 0u; mine = (j == x) ? c : mine; }
        if (sum == G) break;
        __builtin_amdgcn_s_sleep(1);
        if ((++sp & 255u) == 0u) { if (xb_ld(&bar[XB_TMO])) break; if (sp > XB_SPIN_CAP) { atomicAdd(&bar[XB_TMO], 1u); break; } }
    }
    nloc = mine > 0u ? mine : 1u; nx = cnt > 0u ? cnt : 1u;
}
__device__ __forceinline__ void xcd_barrier(const XcdBarrier& b) {
    asm volatile("s_waitcnt vmcnt(0)" ::: "memory");
    __syncthreads();
    if (threadIdx.x == 0) {
        unsigned* bar = b.bar;
        __builtin_amdgcn_s_waitcnt(0);
        unsigned nloc = b.st[0], nx = b.st[1];
        if (nloc == 0u) { xcd_barrier_complete(bar, b.x, nloc, nx); b.st[0] = nloc; b.st[1] = nx; }
        const unsigned old = xb_add(&bar[XB_XSUB(b.x)], 1u);
        const unsigned gen = old / nloc;
        if (old + 1u == (gen + 1u) * nloc) {
            __builtin_amdgcn_fence(__ATOMIC_RELEASE, "agent");
            asm volatile("s_waitcnt vmcnt(0)" ::: "memory");
            const unsigned og = xb_add(&bar[XB_TOP], 1u);
            const unsigned tg = og / nx;
            if (og + 1u == (tg + 1u) * nx) xb_add(&bar[XB_TOPGEN], 1u);
            else XB_SPIN(xb_ld(&bar[XB_TOPGEN]) == tg, bar);
            __builtin_amdgcn_fence(__ATOMIC_ACQUIRE, "agent");
            xb_add(&bar[XB_XGEN(b.x)], 1u);
            asm volatile("s_waitcnt vmcnt(0)" ::: "memory");
        } else {
            XB_SPIN(xb_ld(&bar[XB_XGEN(b.x)]) == gen, bar);
            __builtin_amdgcn_fence(__ATOMIC_ACQUIRE, "agent");
            asm volatile("s_waitcnt vmcnt(0)" ::: "memory");
        }
    }
    __syncthreads();
}

template <int KSTEPS>
__device__ __forceinline__ f32x4 mm_tile(const LAS bf16* Am, int lda, const LAS bf16* Bn, int ldb, int m0, int n0, f32x4 acc, int fr, int fq) {
    const LAS bf16* ap = Am + (m0 + fr) * lda + fq * 8;
    const LAS bf16* bp = Bn + (n0 + fr) * ldb + fq * 8;
#pragma unroll
    for (int ks = 0; ks < KSTEPS; ++ks) {
        const bf16x8 a = *(const LAS bf16x8*)(ap + ks * 32);
        const bf16x8 b = *(const LAS bf16x8*)(bp + ks * 32);
        acc = __builtin_amdgcn_mfma_f32_16x16x32_bf16(b, a, acc, 0, 0, 0);
    }
    return acc;
}
__device__ __forceinline__ v2u pk4(f32x4 v) { v2u r; r.x = pk2(v[0], v[1]); r.y = pk2(v[2], v[3]); return r; }
constexpr int NWAVES = 8, NTHREADS = 512;
constexpr int BATCH = 2, T = 8192, D = 1024, M = BATCH * T;
constexpr int MIX_IN = 3072, DFF = 2816, NEXP = 8, DFE = 1408, NH = 16, HS = 64;
constexpr int NRW = 3328;
constexpr int XG_ROWS = 34816;
constexpr float RMS_EPS = 1e-6f, LN_EPS = 1e-5f, GN_EPS = 64e-5f;
constexpr size_t MiB = 1u << 20, KiB = 1024;
constexpr size_t WS_CTL = 0, CTL_ZERO_BYTES = 1 * MiB;
constexpr size_t WS_WSM = 1 * MiB;
constexpr size_t WS_LB = 1 * MiB + 128 * KiB;
constexpr size_t WS_WIN = 2 * MiB, WS_WOUT = 8 * MiB, WS_WGU = 10 * MiB, WS_WD = 21 * MiB, WS_WR = 26 * MiB + 512 * KiB, WS_WO = 39 * MiB + 512 * KiB, WS_W2T = 41 * MiB + 512 * KiB;
constexpr size_t WS_XN = 42 * MiB;
constexpr size_t WS_Z = 74 * MiB;
constexpr size_t WS_HGI = 170 * MiB, WS_HGS = 202 * MiB, WS_HGD = 234 * MiB;
constexpr size_t WS_HF = 74 * MiB;
constexpr size_t WS_A2 = 42 * MiB;
constexpr size_t WS_R = 106 * MiB, WS_K = 138 * MiB, WS_V = 170 * MiB, WS_LR = 202 * MiB, WS_RKS = 210 * MiB, WS_S0 = 211 * MiB;
constexpr size_t WS_OMT = 42 * MiB, WS_YL = 74 * MiB;
constexpr size_t WS_WEGU = 2 * MiB, WS_WED = 46 * MiB, WS_XG = 68 * MiB, WS_HE = 136 * MiB, WS_XN3 = 136 * MiB, WS_ROUTE = 240 * MiB;
constexpr size_t WS_END = 256 * MiB;
constexpr size_t RT_E = 0, RT_POS = 128 * KiB, RT_W = 256 * KiB, RT_SLOT = 384 * KiB, RT_SLOTW = 512 * KiB;
constexpr int CW_BAR = 4096;
constexpr int CW_CNT = 64;
constexpr int LDS_BYTES = 155648, MISC_OFF = 153600;
struct Frame {
    LAS unsigned char* lds;
    int tid, lane, wave, vcu, G;
    const float* in[37];
    float* out;
    unsigned char* ws;
};
template <class Tp> __device__ __forceinline__ Tp* wsp(const Frame& F, size_t off) { return (Tp*)(F.ws + off); }
__device__ __forceinline__ bf16* HBp(const Frame& F) { return (bf16*)F.out + (size_t)16384 * 1024; }

enum { I_X = 0, I_NMG, I_NFG, I_NOG, I_WIN, I_WOUT, I_GNG, I_GWS, I_GBS, I_LBL, I_ONG, I_FG, I_FU, I_FD,
       I_RMIX, I_RWR, I_RWK, I_RWV, I_RWO, I_RW0, I_RW1, I_RW2, I_RA0, I_RA1, I_RA2, I_RG1, I_RG2, I_RKK, I_RKA, I_RRK, I_RLG, I_RLB,
       I_MR, I_MRB, I_MG, I_MU, I_MD };

struct Job { const float* src; int K, N; bf16* dst; int ldd, rowbase, kofs; const float* scale; int ilv; };
__device__ __forceinline__ int job_items(const Job& j) { return (j.K / 64) * (j.N / 32); }
__device__ __forceinline__ void conv_item(const Job& J, int item, LAS float* scr, int lane) {
    const int nblk = J.N / 32, kb = item / nblk, nb = item % nblk, k0 = 64 * kb, n0 = 32 * nb;
    const int drow0 = J.ilv ? ((n0 >> 7) * 256 + (J.ilv - 1) * 128 + (n0 & 127)) : (J.rowbase + n0);
    float tmp[32];
#pragma unroll
    for (int i = 0; i < 32; ++i) { const int kk = 2 * i + (lane >> 5); tmp[i] = __builtin_nontemporal_load(J.src + (size_t)(k0 + kk) * J.N + n0 + (lane & 31)); }
    if (J.scale) {
#pragma unroll
        for (int i = 0; i < 32; ++i) tmp[i] *= J.scale[k0 + 2 * i + (lane >> 5)]; }
#pragma unroll
    for (int i = 0; i < 32; ++i) scr[(2 * i + (lane >> 5)) * 33 + (lane & 31)] = tmp[i];
    LDS_WAIT(); asm volatile("" ::: "memory");
    const int c = lane & 7;
#pragma unroll
    for (int j = 0; j < 4; ++j) { const int n = (lane >> 3) + 8 * j; const LAS float* s = scr + (8 * c) * 33 + n;
        v4u o; o.x = pk2(s[0 * 33], s[1 * 33]); o.y = pk2(s[2 * 33], s[3 * 33]); o.z = pk2(s[4 * 33], s[5 * 33]); o.w = pk2(s[6 * 33], s[7 * 33]);
        *(v4u*)(J.dst + (size_t)(drow0 + n) * J.ldd + J.kofs + k0 + 8 * c) = o; }
    LDS_WAIT(); asm volatile("" ::: "memory");
}
__device__ __forceinline__ Job p0_job(const Frame& F, int j) {
    Job J; J.scale = nullptr; J.ilv = 0; J.rowbase = 0; J.kofs = 0;
    const float* mix = F.in[I_RMIX];
    switch (j) {
    case 0: J.src = F.in[I_WIN]; J.K = 1024; J.N = 3072; J.dst = wsp<bf16>(F, WS_WIN); J.ldd = 1024; break;
    case 1: J.src = F.in[I_WOUT]; J.K = 1024; J.N = 1024; J.dst = wsp<bf16>(F, WS_WOUT); J.ldd = 1024; break;
    case 2: J.src = F.in[I_FG]; J.K = 1024; J.N = DFF; J.dst = wsp<bf16>(F, WS_WGU); J.ldd = 1024; J.ilv = 1; break;
    case 3: J.src = F.in[I_FU]; J.K = 1024; J.N = DFF; J.dst = wsp<bf16>(F, WS_WGU); J.ldd = 1024; J.ilv = 2; break;
    case 4: J.src = F.in[I_FD]; J.K = DFF; J.N = 1024; J.dst = wsp<bf16>(F, WS_WD); J.ldd = DFF; break;
    case 5: J.src = F.in[I_RWO]; J.K = 1024; J.N = 1024; J.dst = wsp<bf16>(F, WS_WO); J.ldd = 1024; break;
    case 6: J.src = F.in[I_RW2]; J.K = 64; J.N = 1024; J.dst = wsp<bf16>(F, WS_W2T); J.ldd = 64; break;
    case 7: J.src = F.in[I_RA2]; J.K = 64; J.N = 1024; J.dst = wsp<bf16>(F, WS_W2T) + 1024 * 64; J.ldd = 64; break;
    case 8: J.src = F.in[I_RG2]; J.K = 128; J.N = 1024; J.dst = wsp<bf16>(F, WS_W2T) + 2 * 1024 * 64; J.ldd = 128; break;
    default: {
        const int q = (j - 9) >> 1, sc = (j - 9) & 1;
        J.K = 1024; J.dst = wsp<bf16>(F, WS_WR); J.ldd = 2048; J.kofs = sc ? 1024 : 0;
        if (q == 0) { J.src = F.in[I_RWR]; J.N = 1024; J.rowbase = 0; if (sc) J.scale = mix + 0 * 1024; }
        else if (q == 1) { J.src = F.in[I_RWK]; J.N = 1024; J.rowbase = 1024; if (sc) J.scale = mix + 2 * 1024; }
        else if (q == 2) { J.src = F.in[I_RWV]; J.N = 1024; J.rowbase = 2048; if (sc) J.scale = mix + 3 * 1024; }
        else if (q == 3) { J.src = F.in[I_RW1]; J.N = 64; J.rowbase = 3072; if (sc) J.scale = mix + 1 * 1024; }
        else if (q == 4) { J.src = F.in[I_RA1]; J.N = 64; J.rowbase = 3136; if (sc) J.scale = mix + 4 * 1024; }
        else { J.src = F.in[I_RG1]; J.N = 128; J.rowbase = 3200; if (sc) J.scale = mix + 5 * 1024; }
    } }
    return J;
}
constexpr int P0_NJOBS = 21;
__device__ __forceinline__ Job moe_job(const Frame& F, int j) {
    Job J; J.scale = nullptr; J.rowbase = 0; J.kofs = 0; J.ilv = 0;
    const int e = j / 3, w = j % 3;
    if (w < 2) { J.src = F.in[w == 0 ? I_MG : I_MU] + (size_t)e * 1024 * DFE; J.K = 1024; J.N = DFE; J.dst = wsp<bf16>(F, WS_WEGU) + (size_t)e * 2 * DFE * 1024; J.ldd = 1024; J.ilv = w + 1; }
    else { J.src = F.in[I_MD] + (size_t)e * DFE * 1024; J.K = DFE; J.N = 1024; J.dst = wsp<bf16>(F, WS_WED) + (size_t)e * 1024 * DFE; J.ldd = DFE; }
    return J;
}
__device__ __forceinline__ void rms_row(const float* xrow, const float* g, int lane, f32x4 (&v)[4]) {
    const f32x4* xr = (const f32x4*)xrow + lane; float s = 0.f;
#pragma unroll
    for (int j = 0; j < 4; ++j) { v[j] = xr[64 * j]; s += (v[j].x * v[j].x + v[j].y * v[j].y) + (v[j].z * v[j].z + v[j].w * v[j].w); }
    const float rs = 1.f / sqrtf(wave_sum(s) * (1.f / D) + RMS_EPS);
    const f32x4* gr = (const f32x4*)g + lane;
#pragma unroll
    for (int j = 0; j < 4; ++j) v[j] = v[j] * rs * gr[64 * j];
}
__device__ __forceinline__ void load_row_bf16(const bf16* hrow, int lane, f32x4 (&v)[4]) {
    const v2u* hr = (const v2u*)hrow + lane;
#pragma unroll
    for (int j = 0; j < 4; ++j) { const v2u a = hr[64 * j]; v[j] = (f32x4){bflo(a.x), bfhi(a.x), bflo(a.y), bfhi(a.y)}; }
}
__device__ __forceinline__ void rms_row_h(const bf16* hrow, const float* g, int lane, f32x4 (&v)[4]) {
    load_row_bf16(hrow, lane, v); float s = 0.f;
#pragma unroll
    for (int j = 0; j < 4; ++j) s += (v[j].x * v[j].x + v[j].y * v[j].y) + (v[j].z * v[j].z + v[j].w * v[j].w);
    const float rs = 1.f / sqrtf(wave_sum(s) * (1.f / D) + RMS_EPS);
    const f32x4* gr = (const f32x4*)g + lane;
#pragma unroll
    for (int j = 0; j < 4; ++j) v[j] = v[j] * rs * gr[64 * j];
}
__device__ __forceinline__ void store_row_bf16(bf16* orow, int lane, const f32x4 (&v)[4]) {
    v2u* o8 = (v2u*)orow + lane;
#pragma unroll
    for (int j = 0; j < 4; ++j) o8[64 * j] = pk4(v[j]);
}
__device__ __forceinline__ void run_jobs(const Frame& F, bool moe) {
    LAS float* scr = (LAS float*)(F.lds + F.wave * 16384);
    const int gw = F.vcu * NWAVES + F.wave, NGW = F.G * NWAVES;
    const int njobs = moe ? 24 : P0_NJOBS;
    int base = 0;
    for (int j = 0; j < njobs; ++j) {
        const Job J = moe ? moe_job(F, j) : p0_job(F, j);
        const int n = job_items(J);
        int it = (gw - base % NGW + NGW) % NGW;
        for (; it < n; it += NGW) conv_item(J, it, scr, F.lane);
        base += n;
    }
}
__device__ __forceinline__ void p0_prologue(const Frame& F) {
    run_jobs(F, false);
    const int gt = F.vcu * NTHREADS + F.tid, NGT = F.G * NTHREADS;
    { const float* ws = F.in[I_GWS]; bf16* o = wsp<bf16>(F, WS_WSM);
      for (int i = gt; i < 4 * 128 * 128; i += NGT) { const int t = (i >> 7) & 127, s = i & 127; o[i] = (bf16)f2bf(s <= t ? ws[i] : 0.f); } }
    { const float* l = F.in[I_LBL]; float* o = wsp<float>(F, WS_LB);
      for (int i = gt; i < 512; i += NGT) { const float a = l[i], b = l[512 + i], mx = fmaxf(a, b), ea = expf(a - mx), eb = expf(b - mx); o[i] = ea / (ea + eb); } }
    const int gw = F.vcu * NWAVES + F.wave, NGW = F.G * NWAVES;
    bf16* XN = wsp<bf16>(F, WS_XN);
    for (int m = gw; m < M; m += NGW) { f32x4 v[4]; rms_row(F.in[I_X] + (size_t)m * D, F.in[I_NMG], F.lane, v); store_row_bf16(XN + (size_t)m * D, F.lane, v); }
}
namespace epi {
using pg8::Unit; using pg8::HALF; using pg8::BM;
typedef float f32x4 __attribute__((ext_vector_type(4)));
struct MixIn {
    static constexpr bool PERM = true;
    bf16* Z; const float* lb;
    __device__ __forceinline__ void operator()(const f32x4 (&acc)[2][2][4][2], const Unit& u, int wr, int wc, int fr, int fq) const {
        const int seg = u.pn >> 1;
        const int row0 = u.pm * BM + wr * 64 + fr, col0 = u.pn * BM + wc * 32 + 8 * fq;
#pragma unroll
        for (int ai = 0; ai < 2; ++ai)
#pragma unroll
            for (int m = 0; m < 4; ++m) { bf16* rowp = Z + (size_t)(row0 + ai * HALF + m * 16) * MIX_IN + col0;
#pragma unroll
                for (int bj = 0; bj < 2; ++bj) { float v[8];
#pragma unroll
                    for (int i = 0; i < 4; ++i) { v[i] = acc[ai][bj][m][0][i]; v[4 + i] = acc[ai][bj][m][1][i]; }
                    if (seg < 2) {
#pragma unroll
                        for (int i = 0; i < 8; ++i) v[i] = fgelu_tanh(v[i]);
                    } else if (seg == 2 || seg == 5) {
#pragma unroll
                        for (int i = 0; i < 8; ++i) v[i] = fsilu(v[i]);
                    } else if (seg == 3) {
                        const float* lbp = lb + (col0 + bj * HALF - 1536);
#pragma unroll
                        for (int i = 0; i < 8; ++i) { const float l = lbp[i]; v[i] = __logf(l + (1.f - l) * fsigmoid(v[i])); }
                    }
                    v4u w; w.x = pk2(v[0], v[1]); w.y = pk2(v[2], v[3]); w.z = pk2(v[4], v[5]); w.w = pk2(v[6], v[7]);
                    *(v4u*)(rowp + bj * HALF) = w; } }
    }
};
template <bool XF> struct Resid {
    static constexpr bool PERM = true;
    const float* xf; bf16* H;
    __device__ __forceinline__ void operator()(const f32x4 (&acc)[2][2][4][2], const Unit& u, int wr, int wc, int fr, int fq) const {
        const int row0 = u.pm * BM + wr * 64 + fr, col0 = u.pn * BM + wc * 32 + 8 * fq;
#pragma unroll
        for (int ai = 0; ai < 2; ++ai)
#pragma unroll
            for (int m = 0; m < 4; ++m) { const size_t off = (size_t)(row0 + ai * HALF + m * 16) * D + col0;
#pragma unroll
                for (int bj = 0; bj < 2; ++bj) { const size_t p = off + bj * HALF; f32x4 v0 = acc[ai][bj][m][0], v1 = acc[ai][bj][m][1];
                    if (XF) { v0 = v0 + *(const f32x4*)(xf + p); v1 = v1 + *(const f32x4*)(xf + p + 4); }
                    else { const v4u b = *(const v4u*)(H + p); v0[0] += bflo(b.x); v0[1] += bfhi(b.x); v0[2] += bflo(b.y); v0[3] += bfhi(b.y); v1[0] += bflo(b.z); v1[1] += bfhi(b.z); v1[2] += bflo(b.w); v1[3] += bfhi(b.w); }
                    v4u w; w.x = pk2(v0[0], v0[1]); w.y = pk2(v0[2], v0[3]); w.z = pk2(v1[0], v1[1]); w.w = pk2(v1[2], v1[3]);
                    *(v4u*)(H + p) = w; } }
    }
};
struct SwiGlu {
    static constexpr bool PERM = true;
    bf16* H; int ld; const float* rowscale;
    __device__ __forceinline__ void operator()(const f32x4 (&acc)[2][2][4][2], const Unit& u, int wr, int wc, int fr, int fq) const {
        const int row0 = u.pm * BM + wr * 64 + fr, col0 = u.pn * HALF + wc * 32 + 8 * fq;
#pragma unroll
        for (int ai = 0; ai < 2; ++ai)
#pragma unroll
            for (int m = 0; m < 4; ++m) { const int row = row0 + ai * HALF + m * 16; const float sc = rowscale ? rowscale[row] : 1.f; float v[8];
#pragma unroll
                for (int i = 0; i < 4; ++i) { v[i] = fsilu(acc[ai][0][m][0][i]) * acc[ai][1][m][0][i] * sc; v[4 + i] = fsilu(acc[ai][0][m][1][i]) * acc[ai][1][m][1][i] * sc; }
                v4u w; w.x = pk2(v[0], v[1]); w.y = pk2(v[2], v[3]); w.z = pk2(v[4], v[5]); w.w = pk2(v[6], v[7]);
                *(v4u*)(H + (size_t)row * ld + col0) = w; }
    }
};
struct RwkvProj {
    static constexpr bool PERM = true;
    bf16* R; size_t split_stride; bf16* LR;
    __device__ __forceinline__ void operator()(const f32x4 (&acc)[2][2][4][2], const Unit& u, int wr, int wc, int fr, int fq) const {
        const int row0 = u.pm * BM + wr * 64 + fr;
        const bool lora = (u.pn == 12);
        bf16* base = lora ? LR : (R + (size_t)(u.pn >> 2) * split_stride);
        const int ld = lora ? 256 : D;
        const int col0 = (lora ? 0 : (u.pn & 3) * BM) + wc * 32 + 8 * fq;
#pragma unroll
        for (int ai = 0; ai < 2; ++ai)
#pragma unroll
            for (int m = 0; m < 4; ++m) { bf16* rowp = base + (size_t)(row0 + ai * HALF + m * 16) * ld + col0;
#pragma unroll
                for (int bj = 0; bj < 2; ++bj) { float v[8];
#pragma unroll
                    for (int i = 0; i < 4; ++i) { v[i] = acc[ai][bj][m][0][i]; v[4 + i] = acc[ai][bj][m][1][i]; }
                    if (lora) {
                        if (bj == 1) {
#pragma unroll
                            for (int i = 0; i < 8; ++i) v[i] = fsigmoid(v[i]);
                        } else if (wc < 2) {
#pragma unroll
                            for (int i = 0; i < 8; ++i) v[i] = ftanh(v[i]);
                        }
                    }
                    v4u w; w.x = pk2(v[0], v[1]); w.y = pk2(v[2], v[3]); w.z = pk2(v[4], v[5]); w.w = pk2(v[6], v[7]);
                    *(v4u*)(rowp + bj * HALF) = w; } }
    }
};
struct StoreBf16 {
    static constexpr bool PERM = true;
    bf16* O; int ld;
    __device__ __forceinline__ void operator()(const f32x4 (&acc)[2][2][4][2], const Unit& u, int wr, int wc, int fr, int fq) const {
        const int row0 = u.pm * BM + wr * 64 + fr, col0 = u.pn * BM + wc * 32 + 8 * fq;
#pragma unroll
        for (int ai = 0; ai < 2; ++ai)
#pragma unroll
            for (int m = 0; m < 4; ++m) { bf16* rowp = O + (size_t)(row0 + ai * HALF + m * 16) * ld + col0;
#pragma unroll
                for (int bj = 0; bj < 2; ++bj) { const f32x4 v0 = acc[ai][bj][m][0], v1 = acc[ai][bj][m][1];
                    v4u w; w.x = pk2(v0[0], v0[1]); w.y = pk2(v0[2], v0[3]); w.z = pk2(v1[0], v1[1]); w.w = pk2(v1[2], v1[3]);
                    *(v4u*)(rowp + bj * HALF) = w; } }
    }
};
}
constexpr int HG_L = 64, HG_NC = T / HG_L;
__device__ __forceinline__ void gmlp_unit(const Frame& F, int unit) {
    const int g = unit & 3, n = (unit >> 2) & 63, b = unit >> 8;
    const int m0 = b * T + n * 128;
    LAS bf16* WM = (LAS bf16*)F.lds; LAS bf16* VNT = (LAS bf16*)(F.lds + 34816);
    const bf16* Z = wsp<bf16>(F, WS_Z); bf16* Y = wsp<bf16>(F, WS_XN);
    const bf16* wsm = wsp<bf16>(F, WS_WSM) + g * 16384;
    const float* gng = F.in[I_GNG] + g * 128;
#pragma unroll
    for (int i = 0; i < 4; ++i) { const int id = F.tid + 512 * i, row = id >> 4, cc = id & 15;
        *(LAS v4u*)(WM + row * 136 + cc * 8) = *(const v4u*)(wsm + row * 128 + cc * 8); }
#pragma unroll
    for (int i = 0; i < 4; ++i) { const int id = F.tid + 512 * i, s = id >> 4, cc = id & 15;
        const v4u raw = *(const v4u*)(Z + (size_t)(m0 + s) * MIX_IN + 512 + g * 128 + cc * 8);
        float v[8]; v[0] = bflo(raw.x); v[1] = bfhi(raw.x); v[2] = bflo(raw.y); v[3] = bfhi(raw.y); v[4] = bflo(raw.z); v[5] = bfhi(raw.z); v[6] = bflo(raw.w); v[7] = bfhi(raw.w);
        float sm = 0.f;
#pragma unroll
        for (int j = 0; j < 8; ++j) sm += v[j];
        sm += __shfl_xor(sm, 1); sm += __shfl_xor(sm, 2); sm += __shfl_xor(sm, 4); sm += __shfl_xor(sm, 8);
        const float mu = sm * (1.f / 128.f); float sq = 0.f;
#pragma unroll
        for (int j = 0; j < 8; ++j) { v[j] -= mu; sq += v[j] * v[j]; }
        sq += __shfl_xor(sq, 1); sq += __shfl_xor(sq, 2); sq += __shfl_xor(sq, 4); sq += __shfl_xor(sq, 8);
        const float rstd = 1.f / sqrtf(sq * (1.f / 128.f) + LN_EPS);
#pragma unroll
        for (int j = 0; j < 8; ++j) VNT[(cc * 8 + j) * 136 + s] = (bf16)f2bf(v[j] * rstd * gng[cc * 8 + j]); }
    LBAR();
    const int fr = F.lane & 15, fq = F.lane >> 4, t0 = 16 * F.wave, nks = (F.wave >> 1) + 1;
    f32x4 acc[8];
#pragma unroll
    for (int j = 0; j < 8; ++j) acc[j] = (f32x4){0.f, 0.f, 0.f, 0.f};
    for (int ks = 0; ks < nks; ++ks) {
        const bf16x8 a = *(const LAS bf16x8*)(WM + (t0 + fr) * 136 + ks * 32 + fq * 8);
#pragma unroll
        for (int j = 0; j < 8; ++j) { const bf16x8 bb = *(const LAS bf16x8*)(VNT + (16 * j + fr) * 136 + ks * 32 + fq * 8);
            acc[j] = __builtin_amdgcn_mfma_f32_16x16x32_bf16(bb, a, acc[j], 0, 0, 0); }
    }
    const int t = t0 + fr; const float bs = F.in[I_GBS][g * 128 + t];
    const bf16* zr = Z + (size_t)(m0 + t) * MIX_IN + g * 128; bf16* yr = Y + (size_t)(m0 + t) * D + g * 128;
#pragma unroll
    for (int j = 0; j < 8; ++j) { const int c = 16 * j + 4 * fq; const v2u ur = *(const v2u*)(zr + c);
        f32x4 o; o[0] = bflo(ur.x) * (acc[j][0] + bs); o[1] = bfhi(ur.x) * (acc[j][1] + bs); o[2] = bflo(ur.y) * (acc[j][2] + bs); o[3] = bfhi(ur.y) * (acc[j][3] + bs);
        *(v2u*)(yr + c) = pk4(o); }
    LBAR();
}
__device__ __forceinline__ void hg_load_lf(const bf16* Z, int m0, int h, int k, int tq, float (&lf)[16]) {
#pragma unroll
    for (int i = 0; i < 16; ++i) lf[i] = bf2f(Z[(size_t)(m0 + 16 * tq + i) * MIX_IN + 1536 + h * 128 + k]);
}
struct HgRaw2 { v4u a[2], b[2]; };
struct HgRaw3 { v4u a[2], b[2], c[2]; };
__device__ __forceinline__ void hg_tile_load(const bf16* Z, int m0, int col0, int tid, v4u (&x)[2]) {
#pragma unroll
    for (int i = 0; i < 2; ++i) { const int id = tid + 512 * i, row = id >> 4, c2 = id & 15; x[i] = *(const v4u*)(Z + (size_t)(m0 + row) * MIX_IN + col0 + c2 * 8); }
}
__device__ __forceinline__ void hg_tile_store(LAS bf16* dst, int tid, const v4u (&x)[2]) {
#pragma unroll
    for (int i = 0; i < 2; ++i) { const int id = tid + 512 * i, row = id >> 4, c2 = id & 15; *(LAS v4u*)(dst + row * 136 + c2 * 8) = x[i]; }
}
__device__ __forceinline__ void hgrn_pre_phase(const Frame& F) {
    LAS bf16* KDT = (LAS bf16*)F.lds; LAS bf16* VT = (LAS bf16*)(F.lds + 18432); LAS float* PART = (LAS float*)(F.lds + 36864);
    LAS bf16* LFR = (LAS bf16*)(F.lds + 40960); LAS bf16* VR = (LAS bf16*)(F.lds + 58368);
    const bf16* Z = wsp<bf16>(F, WS_Z);
    const int k = F.tid & 127, tq = F.tid >> 7;
    HgRaw2 raw;
    if (F.vcu < 1024) { const int u = F.vcu, c = u & 127, h = (u >> 7) & 3, b = u >> 9, m0 = b * T + c * HG_L; hg_tile_load(Z, m0, 1536 + h * 128, F.tid, raw.a); hg_tile_load(Z, m0, 2048 + h * 128, F.tid, raw.b); }
    for (int unit = F.vcu; unit < 1024; unit += F.G) {
        hg_tile_store(LFR, F.tid, raw.a); hg_tile_store(VR, F.tid, raw.b);
        if (unit + F.G < 1024) { const int u = unit + F.G, c = u & 127, h = (u >> 7) & 3, b = u >> 9, m0 = b * T + c * HG_L; hg_tile_load(Z, m0, 1536 + h * 128, F.tid, raw.a); hg_tile_load(Z, m0, 2048 + h * 128, F.tid, raw.b); }
        LBAR();
        float lf[16], pre[16]; float run = 0.f;
#pragma unroll
        for (int i = 0; i < 16; ++i) { lf[i] = bf2f(LFR[(16 * tq + i) * 136 + k]); run += lf[i]; pre[i] = run; }
        PART[tq * 128 + k] = run;
        LBAR();
        float off = 0.f, bend = 0.f;
#pragma unroll
        for (int q = 0; q < 4; ++q) { const float p = PART[q * 128 + k]; bend += p; off += (q < tq) ? p : 0.f; }
        unsigned kd[8], vv[8];
#pragma unroll
        for (int i = 0; i < 8; ++i) {
            const float k0 = (1.f - fexp(lf[2 * i])) * fexp(bend - (off + pre[2 * i])), k1 = (1.f - fexp(lf[2 * i + 1])) * fexp(bend - (off + pre[2 * i + 1]));
            kd[i] = pk2(k0, k1);
            const unsigned v0 = VR[(16 * tq + 2 * i) * 136 + k], v1 = VR[(16 * tq + 2 * i + 1) * 136 + k];
            vv[i] = v0 | (v1 << 16);
        }
        *(LAS v4u*)(KDT + k * 72 + 16 * tq) = (v4u){kd[0], kd[1], kd[2], kd[3]}; *(LAS v4u*)(KDT + k * 72 + 16 * tq + 8) = (v4u){kd[4], kd[5], kd[6], kd[7]};
        *(LAS v4u*)(VT + k * 72 + 16 * tq) = (v4u){vv[0], vv[1], vv[2], vv[3]}; *(LAS v4u*)(VT + k * 72 + 16 * tq + 8) = (v4u){vv[4], vv[5], vv[6], vv[7]};
        if (tq == 0) wsp<float>(F, WS_HGD)[unit * 128 + k] = fexp(bend);
        LBAR();
        const int fr = F.lane & 15, fq = F.lane >> 4, v0 = 16 * F.wave;
        bf16* inc = wsp<bf16>(F, WS_HGI) + (size_t)unit * 16384;
#pragma unroll
        for (int j = 0; j < 8; ++j) { f32x4 acc = (f32x4){0.f, 0.f, 0.f, 0.f};
            acc = mm_tile<2>(VT, 72, KDT, 72, v0, 16 * j, acc, fr, fq);
            *(v2u*)(inc + (v0 + fr) * 128 + 16 * j + 4 * fq) = pk4(acc); }
        LBAR();
    }
}
__device__ __forceinline__ void hgrn_scan(const Frame& F) {
    for (int gt = F.vcu * NTHREADS + F.tid; gt < 8 * 4096; gt += F.G * NTHREADS) {
    const int bh = gt >> 12, e = (gt & 4095) * 4, k = e & 127;
    const bf16* __restrict__ inc = wsp<bf16>(F, WS_HGI) + (size_t)bh * HG_NC * 16384 + e;
    bf16* __restrict__ st = wsp<bf16>(F, WS_HGS) + (size_t)bh * HG_NC * 16384 + e;
    const float* __restrict__ dd = wsp<float>(F, WS_HGD) + (size_t)bh * HG_NC * 128 + k;
    f32x4 S = (f32x4){0.f, 0.f, 0.f, 0.f};
#pragma unroll 4
    for (int c = 0; c < HG_NC; ++c) {
        const v2u iv = *(const v2u*)(inc + (size_t)c * 16384); const f32x4 d = *(const f32x4*)(dd + c * 128);
        *(v2u*)(st + (size_t)c * 16384) = pk4(S);
        S[0] = d[0] * S[0] + bflo(iv.x); S[1] = d[1] * S[1] + bfhi(iv.x); S[2] = d[2] * S[2] + bflo(iv.y); S[3] = d[3] * S[3] + bfhi(iv.y);
    }
    }
}
__device__ __forceinline__ void hgrn_post_phase(const Frame& F) {
    LAS bf16* QD = (LAS bf16*)F.lds; LAS bf16* QP = (LAS bf16*)(F.lds + 17408); LAS bf16* KP = (LAS bf16*)(F.lds + 34816);
    LAS bf16* VT = (LAS bf16*)(F.lds + 52224); LAS bf16* SC = (LAS bf16*)(F.lds + 70656);
    LAS float* PART = (LAS float*)(F.lds + 79872); LAS float* RS = (LAS float*)(F.lds + 81920);
    LAS bf16* LFR = (LAS bf16*)(F.lds + 83968); LAS bf16* QR = (LAS bf16*)(F.lds + 101376); LAS bf16* VR = (LAS bf16*)(F.lds + 118784);
    const bf16* Z = wsp<bf16>(F, WS_Z); bf16* Y = wsp<bf16>(F, WS_XN);
    const int k = F.tid & 127, tq = F.tid >> 7;
    HgRaw3 raw;
    if (F.vcu < 1024) { const int u = F.vcu, c = u & 127, h = (u >> 7) & 3, b = u >> 9, m0 = b * T + c * HG_L;
        hg_tile_load(Z, m0, 1536 + h * 128, F.tid, raw.a); hg_tile_load(Z, m0, 1024 + h * 128, F.tid, raw.b); hg_tile_load(Z, m0, 2048 + h * 128, F.tid, raw.c); }
    for (int unit = F.vcu; unit < 1024; unit += F.G) {
    const int c = unit & 127, h = (unit >> 7) & 3, b = unit >> 9;
    const int m0 = b * T + c * HG_L;
    hg_tile_store(LFR, F.tid, raw.a); hg_tile_store(QR, F.tid, raw.b); hg_tile_store(VR, F.tid, raw.c);
    if (unit + F.G < 1024) { const int u = unit + F.G, c2 = u & 127, h2 = (u >> 7) & 3, b2 = u >> 9, m2 = b2 * T + c2 * HG_L;
        hg_tile_load(Z, m2, 1536 + h2 * 128, F.tid, raw.a); hg_tile_load(Z, m2, 1024 + h2 * 128, F.tid, raw.b); hg_tile_load(Z, m2, 2048 + h2 * 128, F.tid, raw.c); }
    LBAR();
    float lf[16], pre[16]; float run = 0.f;
#pragma unroll
    for (int i = 0; i < 16; ++i) { lf[i] = bf2f(LFR[(16 * tq + i) * 136 + k]); run += lf[i]; pre[i] = run; }
    PART[tq * 128 + k] = run;
    LBAR();
    const float p0 = PART[k], p1 = PART[128 + k], p2 = PART[256 + k];
    const float off = (tq > 0 ? p0 : 0.f) + (tq > 1 ? p1 : 0.f) + (tq > 2 ? p2 : 0.f), bm = p0 + p1;
    unsigned vv[8];
#pragma unroll
    for (int i = 0; i < 16; ++i) {
        const int t = 16 * tq + i; const float bb = off + pre[i];
        const float q = bf2f(QR[t * 136 + k]);
        const float kk = 1.f - fexp(lf[i]);
        const float dq = fminf(fmaxf(bb - bm, -80.f), 80.f);
        QD[t * 136 + k] = (bf16)f2bf(q * fexp(bb)); QP[t * 136 + k] = (bf16)f2bf(q * fexp(dq)); KP[t * 136 + k] = (bf16)f2bf(kk * fexp(-dq));
        const unsigned vr = VR[t * 136 + k];
        if (i & 1) vv[i >> 1] |= vr << 16; else vv[i >> 1] = vr;
    }
    *(LAS v4u*)(VT + k * 72 + 16 * tq) = (v4u){vv[0], vv[1], vv[2], vv[3]}; *(LAS v4u*)(VT + k * 72 + 16 * tq + 8) = (v4u){vv[4], vv[5], vv[6], vv[7]};
    LBAR();
    const int fr = F.lane & 15, fq = F.lane >> 4, t0 = 16 * (F.wave >> 1);
#pragma unroll
    for (int j = 0; j < 2; ++j) { const int s0 = 16 * (2 * (F.wave & 1) + j); f32x4 acc = (f32x4){0.f, 0.f, 0.f, 0.f};
        if (s0 <= t0) acc = mm_tile<4>(QP, 136, KP, 136, t0, s0, acc, fr, fq);
        const int t = t0 + fr, s = s0 + 4 * fq;
#pragma unroll
        for (int i = 0; i < 4; ++i) acc[i] = (s + i <= t) ? acc[i] : 0.f;
        *(LAS v2u*)(SC + t * 72 + s) = pk4(acc); }
    LBAR();
    const bf16* ST = wsp<bf16>(F, WS_HGS) + (size_t)unit * 16384;
    f32x4 o[4]; float ss = 0.f;
#pragma unroll
    for (int j = 0; j < 4; ++j) { const int v0 = 16 * (4 * (F.wave & 1) + j); f32x4 acc = (f32x4){0.f, 0.f, 0.f, 0.f};
        acc = mm_tile<2>(SC, 72, VT, 72, t0, v0, acc, fr, fq);
#pragma unroll
        for (int ks = 0; ks < 4; ++ks) { const bf16x8 a = *(const LAS bf16x8*)(QD + (t0 + fr) * 136 + ks * 32 + fq * 8);
            const bf16x8 bb = *(const bf16x8*)(ST + (v0 + fr) * 128 + ks * 32 + fq * 8);
            acc = __builtin_amdgcn_mfma_f32_16x16x32_bf16(bb, a, acc, 0, 0, 0); }
        o[j] = acc; ss += (acc[0] * acc[0] + acc[1] * acc[1]) + (acc[2] * acc[2] + acc[3] * acc[3]); }
    ss += __shfl_xor(ss, 16); ss += __shfl_xor(ss, 32);
    if (fq == 0) RS[(t0 + fr) * 2 + (F.wave & 1)] = ss;
    LBAR();
    const int t = t0 + fr; const float rstd = 1.f / sqrtf((RS[t * 2] + RS[t * 2 + 1]) * (1.f / 128.f) + RMS_EPS);
    const float* ong = F.in[I_ONG];
#pragma unroll
    for (int j = 0; j < 4; ++j) { const int v = 16 * (4 * (F.wave & 1) + j) + 4 * fq;
        const v2u sg = *(const v2u*)(Z + (size_t)(m0 + t) * MIX_IN + 2560 + h * 128 + v); const f32x4 gg = *(const f32x4*)(ong + v);
        f32x4 r; r[0] = o[j][0] * rstd * gg[0] * bflo(sg.x); r[1] = o[j][1] * rstd * gg[1] * bfhi(sg.x); r[2] = o[j][2] * rstd * gg[2] * bflo(sg.y); r[3] = o[j][3] * rstd * gg[3] * bfhi(sg.y);
        *(v2u*)(Y + (size_t)(m0 + t) * D + 512 + h * 128 + v) = pk4(r); }
    LBAR();
    }
}
constexpr int RW_L = 64, RW_NC = T / RW_L;
constexpr int SLOT = 9216;
constexpr int RW_MISC = 16 * SLOT;
#define RW_S(i) ((LAS bf16*)(F.lds + (i) * SLOT))
__device__ __forceinline__ float softplusf(float x) { return fmaxf(x, 0.f) + __logf(1.f + fexp(-fabsf(x))); }
__device__ __forceinline__ void wave_sum16(float (&v)[16], int lane) {
    const bool b5 = lane & 32, b4 = lane & 16, b3 = lane & 8, b2 = lane & 4;
    float w[8], x[4], y[2], z;
#pragma unroll
    for (int j = 0; j < 8; ++j) { const float send = b5 ? v[j] : v[j + 8], keep = b5 ? v[j + 8] : v[j]; w[j] = keep + __shfl_xor(send, 32); }
#pragma unroll
    for (int j = 0; j < 4; ++j) { const float send = b4 ? w[j] : w[j + 4], keep = b4 ? w[j + 4] : w[j]; x[j] = keep + __shfl_xor(send, 16); }
#pragma unroll
    for (int j = 0; j < 2; ++j) { const float send = b3 ? x[j] : x[j + 2], keep = b3 ? x[j + 2] : x[j]; y[j] = keep + __shfl_xor(send, 8); }
    { const float send = b2 ? y[0] : y[1], keep = b2 ? y[1] : y[0]; z = keep + __shfl_xor(send, 4); }
    z += __shfl_xor(z, 2); z += __shfl_xor(z, 1);
#pragma unroll
    for (int j = 0; j < 16; ++j) v[j] = __builtin_bit_cast(float, __builtin_amdgcn_readlane(__builtin_bit_cast(int, z), 4 * j));
}
struct RwRaw { v4u r, k, v, l0, l1; };
__device__ __forceinline__ void rwkv_pre_load(const Frame& F, int unit, RwRaw& x) {
    const int c = unit & 127, h = (unit >> 7) & 15, b = unit >> 11; const int m0 = b * T + c * RW_L, hc0 = h * 64;
    const int row = F.tid >> 3, cc = F.tid & 7; const size_t g = (size_t)(m0 + row) * D + hc0 + cc * 8;
    x.r = *(const v4u*)(wsp<bf16>(F, WS_R) + g); x.k = *(const v4u*)(wsp<bf16>(F, WS_K) + g); x.v = *(const v4u*)(wsp<bf16>(F, WS_V) + g);
    const bf16* LR = wsp<bf16>(F, WS_LR);
    { const int id = F.tid, r2 = id >> 4, c2 = id & 15; x.l0 = *(const v4u*)(LR + (size_t)(m0 + r2) * 256 + c2 * 8); }
    { const int id = F.tid + 512, r2 = id >> 4, c2 = id & 15; x.l1 = *(const v4u*)(LR + (size_t)(m0 + r2) * 256 + c2 * 8); }
}
__device__ __forceinline__ void rwkv_pre_phase(const Frame& F) {
    bf16* Rb = wsp<bf16>(F, WS_R); bf16* Kb = wsp<bf16>(F, WS_K);
    const bf16* w2t = wsp<bf16>(F, WS_W2T); const bf16* a2t = w2t + 1024 * 64;
    LAS float* LW = (LAS float*)(F.lds + 5 * SLOT); LAS float* AA = (LAS float*)(F.lds + 7 * SLOT);
    LAS float* PARTW = (LAS float*)(F.lds + RW_MISC); LAS float* WLs = PARTW + 512;
    const int tid = F.tid, lane = F.lane, wave = F.wave, fr = lane & 15, fq = lane >> 4;
    const int mt = wave >> 1, ntb = 2 * (wave & 1);
    RwRaw raw;
    const int per = (4096 + F.G - 1) / F.G, u_lo = F.vcu * per, u_hi = (u_lo + per < 4096) ? u_lo + per : 4096;
    if (u_lo < u_hi) rwkv_pre_load(F, u_lo, raw);
    int h_cur = -1; bf16x8 bwf[2][2], baf[2][2]; f32x4 w0f[2], a0f[2]; float kkw = 0.f, kaw = 0.f, rkw = 0.f;
    for (int unit = u_lo; unit < u_hi; ++unit) {
    const int c = unit & 127, h = (unit >> 7) & 15, b = unit >> 11;
    const int m0 = b * T + c * RW_L, hc0 = h * 64;
    if (h != h_cur) { h_cur = h;
#pragma unroll
        for (int j = 0; j < 2; ++j) { const int n0 = 16 * (ntb + j);
#pragma unroll
            for (int ks = 0; ks < 2; ++ks) { bwf[j][ks] = *(const bf16x8*)(w2t + (size_t)(hc0 + n0 + fr) * 64 + ks * 32 + fq * 8); baf[j][ks] = *(const bf16x8*)(a2t + (size_t)(hc0 + n0 + fr) * 64 + ks * 32 + fq * 8); }
            w0f[j] = *(const f32x4*)(F.in[I_RW0] + hc0 + n0 + 4 * fq); a0f[j] = *(const f32x4*)(F.in[I_RA0] + hc0 + n0 + 4 * fq); }
        kkw = F.in[I_RKK][hc0 + lane]; kaw = F.in[I_RKA][hc0 + lane]; rkw = F.in[I_RRK][hc0 + lane]; }
    { const int row = tid >> 3, cc = tid & 7;
      *(LAS v4u*)(RW_S(0) + row * 72 + cc * 8) = raw.r; *(LAS v4u*)(RW_S(1) + row * 72 + cc * 8) = raw.k; *(LAS v4u*)(RW_S(2) + row * 72 + cc * 8) = raw.v;
      { const int id = tid, r2 = id >> 4, c2 = id & 15; *(LAS v4u*)(RW_S(3) + r2 * 136 + c2 * 8) = raw.l0; }
      { const int id = tid + 512, r2 = id >> 4, c2 = id & 15; *(LAS v4u*)(RW_S(3) + r2 * 136 + c2 * 8) = raw.l1; } }
    if (unit + 1 < u_hi) rwkv_pre_load(F, unit + 1, raw);
    LBAR();
    { LAS bf16* LRT = RW_S(3);
#pragma unroll
      for (int j = 0; j < 2; ++j) { const int n0 = 16 * (ntb + j); f32x4 aw = (f32x4){0.f, 0.f, 0.f, 0.f}, aa = aw;
#pragma unroll
          for (int ks = 0; ks < 2; ++ks) {
              const bf16x8 xw = *(const LAS bf16x8*)(LRT + (16 * mt + fr) * 136 + ks * 32 + fq * 8);
              const bf16x8 xa = *(const LAS bf16x8*)(LRT + (16 * mt + fr) * 136 + 64 + ks * 32 + fq * 8);
              aw = __builtin_amdgcn_mfma_f32_16x16x32_bf16(bwf[j][ks], xw, aw, 0, 0, 0);
              aa = __builtin_amdgcn_mfma_f32_16x16x32_bf16(baf[j][ks], xa, aa, 0, 0, 0); }
          const int t = 16 * mt + fr, cl = n0 + 4 * fq;
          const f32x4 w0 = w0f[j], a0 = a0f[j];
#pragma unroll
          for (int i = 0; i < 4; ++i) { const float wl = -softplusf(-(w0[i] + aw[i])) - 0.5f; LW[t * 68 + cl + i] = -fexp(wl); AA[t * 68 + cl + i] = fsigmoid(a0[i] + aa[i]); } } }
    LBAR();
    { const int cl = lane, tq = wave;
      float lw[8], pre[8]; float run = 0.f;
#pragma unroll
      for (int i = 0; i < 8; ++i) { lw[i] = LW[(8 * tq + i) * 68 + cl]; run += lw[i]; pre[i] = run; }
      PARTW[tq * 64 + cl] = run;
      float rr[8], kp[8], kkr[8], av[8], red[16]; unsigned vraw[8];
#pragma unroll
      for (int i = 0; i < 8; ++i) { const int t = 8 * tq + i;
          rr[i] = bf2f(RW_S(0)[t * 72 + cl]); const float k = bf2f(RW_S(1)[t * 72 + cl]); vraw[i] = RW_S(2)[t * 72 + cl];
          av[i] = AA[t * 68 + cl]; kkr[i] = k * kkw; kp[i] = k * (1.f + (av[i] - 1.f) * kaw);
          red[i] = kkr[i] * kkr[i]; red[8 + i] = rr[i] * kp[i] * rkw; }
      wave_sum16(red, lane);
      LBAR();
      float off = 0.f, cL = 0.f;
#pragma unroll
      for (int q = 0; q < 8; ++q) { const float p = PARTW[q * 64 + cl]; cL += p; off += (q < tq) ? p : 0.f; }
      if (tq == 0) WLs[cl] = fexp(cL);
      if (lane < 8) wsp<float>(F, WS_RKS)[(size_t)(m0 + 8 * tq + lane) * 16 + h] = red[8 + (lane & 7)];
      unsigned aht[4], btt[4], ktt[4], vt[4];
#pragma unroll
      for (int i = 0; i < 8; ++i) {
          const int t = 8 * tq + i;
          const float kk = kkr[i] * __builtin_amdgcn_rsqf(fmaxf(red[i], 1e-24f)), bb = kk * av[i];
          const float cs = off + pre[i];
          const float ep = fexp(cs), em = fexp(-cs), epv = fexp(cs - lw[i]), eL = fexp(cL - cs);
          const unsigned ah = f2bf(epv * kk), bh = f2bf(bb * em), kh = f2bf(kp[i] * em), rh = f2bf(rr[i] * ep), bt = f2bf(bb * eL), kt = f2bf(kp[i] * eL);
          RW_S(3)[t * 72 + cl] = (bf16)ah; RW_S(4)[t * 72 + cl] = (bf16)bh; RW_S(9)[t * 72 + cl] = (bf16)kh; RW_S(10)[t * 72 + cl] = (bf16)rh;
          if (i & 1) { aht[i >> 1] |= ah << 16; btt[i >> 1] |= bt << 16; ktt[i >> 1] |= kt << 16; vt[i >> 1] |= vraw[i] << 16; }
          else { aht[i >> 1] = ah; btt[i >> 1] = bt; ktt[i >> 1] = kt; vt[i >> 1] = vraw[i]; }
      }
      *(LAS v4u*)(RW_S(11) + cl * 72 + 8 * tq) = (v4u){aht[0], aht[1], aht[2], aht[3]};
      *(LAS v4u*)(RW_S(12) + cl * 72 + 8 * tq) = (v4u){btt[0], btt[1], btt[2], btt[3]};
      *(LAS v4u*)(RW_S(13) + cl * 72 + 8 * tq) = (v4u){ktt[0], ktt[1], ktt[2], ktt[3]};
      *(LAS v4u*)(RW_S(14) + cl * 72 + 8 * tq) = (v4u){vt[0], vt[1], vt[2], vt[3]}; }
    LBAR();
#pragma unroll
    for (int j = 0; j < 2; ++j) { const int n0 = 16 * (ntb + j), t = 16 * mt + fr, jj = n0 + 4 * fq; const f32x4 z = (f32x4){0.f, 0.f, 0.f, 0.f};
        f32x4 gab = mm_tile<2>(RW_S(3), 72, RW_S(4), 72, 16 * mt, n0, z, fr, fq);
        f32x4 gkb = mm_tile<2>(RW_S(3), 72, RW_S(9), 72, 16 * mt, n0, z, fr, fq);
        f32x4 gbr = mm_tile<2>(RW_S(10), 72, RW_S(4), 72, 16 * mt, n0, z, fr, fq);
        f32x4 gkr = mm_tile<2>(RW_S(10), 72, RW_S(9), 72, 16 * mt, n0, z, fr, fq);
#pragma unroll
        for (int i = 0; i < 4; ++i) { const bool st = (jj + i < t), inc = (jj + i <= t);
            gab[i] = st ? gab[i] : 0.f; gkb[i] = st ? gkb[i] : 0.f; gbr[i] = inc ? gbr[i] : 0.f; gkr[i] = inc ? gkr[i] : 0.f;
            RW_S(1)[(jj + i) * 72 + t] = (bf16)f2bf(gab[i]);
            RW_S(7)[(jj + i) * 72 + t] = (bf16)f2bf((jj + i == t ? 1.f : 0.f) - gab[i]); }
        *(LAS v2u*)(RW_S(0) + t * 72 + jj) = pk4(gab); *(LAS v2u*)(RW_S(2) + t * 72 + jj) = pk4(gkb);
        *(LAS v2u*)(RW_S(5) + t * 72 + jj) = pk4(gbr); *(LAS v2u*)(RW_S(6) + t * 72 + jj) = pk4(gkr); }
    LBAR();
    {
        int sX = 1, sXT = 0, sP = 7, sY = 8, sYT = 15, sPn = 3;
        for (int it = 1; it <= 5; ++it) {
#pragma unroll
            for (int j = 0; j < 2; ++j) { const int n0 = 16 * (ntb + j), m = 16 * mt + fr, tt = n0 + 4 * fq;
                f32x4 y = mm_tile<2>(RW_S(sX), 72, RW_S(sXT), 72, 16 * mt, n0, (f32x4){0.f, 0.f, 0.f, 0.f}, fr, fq);
                *(LAS v2u*)(RW_S(sY) + m * 72 + tt) = pk4(y);
#pragma unroll
                for (int i = 0; i < 4; ++i) RW_S(sYT)[(tt + i) * 72 + m] = (bf16)f2bf(y[i]);
                if (it == 1) { const f32x4 vm = mm_tile<2>(RW_S(14), 72, RW_S(2), 72, 16 * mt, n0, (f32x4){0.f, 0.f, 0.f, 0.f}, fr, fq); *(LAS v2u*)(RW_S(9) + m * 72 + tt) = pk4(vm); } }
            LBAR();
#pragma unroll
            for (int j = 0; j < 2; ++j) { const int n0 = 16 * (ntb + j), m = 16 * mt + fr, tt = n0 + 4 * fq;
                const v2u pr = *(const LAS v2u*)(RW_S(sP) + m * 72 + tt);
                f32x4 p = (f32x4){bflo(pr.x), bfhi(pr.x), bflo(pr.y), bfhi(pr.y)};
                p = mm_tile<2>(RW_S(sP), 72, RW_S(sYT), 72, 16 * mt, n0, p, fr, fq);
                if (it < 5) *(LAS v2u*)(RW_S(sPn) + m * 72 + tt) = pk4(p);
                else {
#pragma unroll
                    for (int i = 0; i < 4; ++i) RW_S(4)[(tt + i) * 72 + m] = (bf16)f2bf(p[i]); } }
            LBAR();
            int tmp = sX; sX = sY; sY = tmp; tmp = sXT; sXT = sYT; sYT = tmp; tmp = sP; sP = sPn; sPn = tmp;
        }
    }
#pragma unroll
    for (int j = 0; j < 2; ++j) { const int n0 = 16 * (ntb + j), m = 16 * mt + fr, tt = n0 + 4 * fq; const f32x4 z = (f32x4){0.f, 0.f, 0.f, 0.f};
        const f32x4 ap = mm_tile<2>(RW_S(11), 72, RW_S(4), 72, 16 * mt, n0, z, fr, fq);
        const f32x4 vp = mm_tile<2>(RW_S(9), 72, RW_S(4), 72, 16 * mt, n0, z, fr, fq);
        *(LAS v2u*)(RW_S(0) + m * 72 + tt) = pk4(ap); *(LAS v2u*)(RW_S(1) + m * 72 + tt) = pk4(vp); }
    LBAR();
    bf16* OMT = wsp<bf16>(F, WS_OMT); bf16* YL = wsp<bf16>(F, WS_YL);
#pragma unroll
    for (int j = 0; j < 2; ++j) { const int nt = ntb + j, n0 = 16 * nt, m = 16 * mt + fr, nn = n0 + 4 * fq; const f32x4 z = (f32x4){0.f, 0.f, 0.f, 0.f};
        { f32x4 x = mm_tile<2>(RW_S(12), 72, RW_S(0), 72, 16 * mt, n0, z, fr, fq); const float wl = WLs[m];
#pragma unroll
          for (int i = 0; i < 4; ++i) x[i] = ((nn + i == m) ? wl : 0.f) - x[i];
          const int idx = (nt >> 1) * 32 + fq * 8 + (nt & 1) * 4;
          *(v2u*)(Rb + (size_t)(m0 + m) * D + hc0 + idx) = pk4(x); }
        { const f32x4 x1 = mm_tile<2>(RW_S(14), 72, RW_S(13), 72, 16 * mt, n0, z, fr, fq), x2 = mm_tile<2>(RW_S(1), 72, RW_S(12), 72, 16 * mt, n0, z, fr, fq);
          *(v2u*)(Kb + (size_t)(m0 + m) * D + hc0 + fq * 16 + nt * 4) = pk4(x1 - x2); }
        { const f32x4 x1 = mm_tile<2>(RW_S(6), 72, RW_S(14), 72, 16 * mt, n0, z, fr, fq), x2 = mm_tile<2>(RW_S(5), 72, RW_S(1), 72, 16 * mt, n0, z, fr, fq);
          *(v2u*)(YL + (size_t)(m0 + m) * D + hc0 + nn) = pk4(x1 - x2); }
        { const f32x4 x = mm_tile<2>(RW_S(5), 72, RW_S(0), 72, 16 * mt, n0, z, fr, fq);
          const v2u rr2 = *(const LAS v2u*)(RW_S(10) + m * 72 + nn);
          f32x4 o; o[0] = bflo(rr2.x) - x[0]; o[1] = bfhi(rr2.x) - x[1]; o[2] = bflo(rr2.y) - x[2]; o[3] = bfhi(rr2.y) - x[3];
          *(v2u*)(OMT + (size_t)(m0 + m) * D + hc0 + nn) = pk4(o); } }
    LBAR();
    }
}
constexpr int RW_SEG = 16, RW_NSEG = RW_NC / RW_SEG;
constexpr size_t WS_PSEG = 243 * MiB, WS_QSEG = 245 * MiB;
#define RW_STEP(A, ps, withpsi) do { v2u _pk[4]; \
        _Pragma("unroll") for (int mt = 0; mt < 4; ++mt) _pk[mt] = pk4(acc[mt]); \
        const v4u _b0 = (v4u){_pk[0].x, _pk[0].y, _pk[1].x, _pk[1].y}, _b1 = (v4u){_pk[2].x, _pk[2].y, _pk[3].x, _pk[3].y}; \
        const bf16x8 _sB0 = __builtin_bit_cast(bf16x8, _b0), _sB1 = __builtin_bit_cast(bf16x8, _b1); \
        _Pragma("unroll") for (int mt = 0; mt < 4; ++mt) { \
            f32x4 _a = (withpsi) ? (f32x4){bflo(ps[2 * mt]), bfhi(ps[2 * mt]), bflo(ps[2 * mt + 1]), bfhi(ps[2 * mt + 1])} : (f32x4){0.f, 0.f, 0.f, 0.f}; \
            _a = __builtin_amdgcn_mfma_f32_16x16x32_bf16(A[mt][0], _sB0, _a, 0, 0, 0); \
            _a = __builtin_amdgcn_mfma_f32_16x16x32_bf16(A[mt][1], _sB1, _a, 0, 0, 0); \
            acc[mt] = _a; } } while (0)
__device__ __forceinline__ void rwkv_scan_a(const Frame& F) {
    const bf16* Rb = wsp<bf16>(F, WS_R); const bf16* Kb = wsp<bf16>(F, WS_K);
    bf16* PSEG = wsp<bf16>(F, WS_PSEG); bf16* QSEG = wsp<bf16>(F, WS_QSEG);
    const int l15 = F.lane & 15, q = F.lane >> 4, w = F.wave;
    const size_t cstep = (size_t)RW_L * D * 2;
    for (int unit = F.vcu; unit < 32 * RW_NSEG; unit += F.G) {
        const int seg = unit & (RW_NSEG - 1), bh = unit >> 3, b = bh >> 4, h = bh & 15, hc0 = h * 64;
        const int mbase = b * T + seg * RW_SEG * RW_L;
        const char* src[2];
#pragma unroll
        for (int j = 0; j < 2; ++j) { const int p = w * 2 + j;
            if (p < 8) { const int mt = p >> 1, sk = p & 1; src[j] = (const char*)(Rb + (size_t)(mbase + 16 * mt + l15) * D + hc0 + sk * 32 + q * 8); }
            else { const int vg = (p - 8) >> 1, half = p & 1; src[j] = (const char*)(Kb + (size_t)(mbase + 16 * vg + l15) * D + hc0 + q * 16 + half * 8); } }
#define RA_ISSUE(c) do { const int _cc = (c) & (RW_SEG - 1); _Pragma("unroll") for (int j = 0; j < 2; ++j) \
        __builtin_amdgcn_global_load_lds((const unsigned*)(src[j] + (size_t)_cc * cstep), (LAS unsigned*)(F.lds + ((c) & 7) * 16384 + (w * 2 + j) * 1024), 16, 0, 0); } while (0)
        f32x4 acc[4];
        if (w < 4) {
#pragma unroll
            for (int i = 0; i < 4; ++i) acc[i] = (f32x4){0.f, 0.f, 0.f, 0.f};
        } else {
#pragma unroll
            for (int mt = 0; mt < 4; ++mt)
#pragma unroll
                for (int i = 0; i < 4; ++i) acc[mt][i] = (16 * mt + 4 * q + i == 16 * (w - 4) + l15) ? 1.f : 0.f;
        }
        for (int c = 0; c < 7; ++c) RA_ISSUE(c);
        asm volatile("s_waitcnt vmcnt(12)" ::: "memory");
        __builtin_amdgcn_s_barrier();
        for (int c = 0; c < RW_SEG; ++c) {
            RA_ISSUE(c + 7);
            LAS unsigned char* slot = F.lds + (c & 7) * 16384;
            bf16x8 A[4][2];
#pragma unroll
            for (int mt = 0; mt < 4; ++mt)
#pragma unroll
                for (int sk = 0; sk < 2; ++sk) A[mt][sk] = *(const LAS bf16x8*)(slot + (mt * 2 + sk) * 1024 + F.lane * 16);
            if (w < 4) {
                const v4u p01 = *(const LAS v4u*)(slot + (8 + w * 2) * 1024 + F.lane * 16), p23 = *(const LAS v4u*)(slot + (9 + w * 2) * 1024 + F.lane * 16);
                const unsigned ps[8] = {p01.x, p01.y, p01.z, p01.w, p23.x, p23.y, p23.z, p23.w};
                RW_STEP(A, ps, true);
            } else { const unsigned ps[8] = {0u, 0u, 0u, 0u, 0u, 0u, 0u, 0u}; RW_STEP(A, ps, false); }
            asm volatile("s_waitcnt vmcnt(12) lgkmcnt(0)" ::: "memory");
            __builtin_amdgcn_s_barrier();
        }
        asm volatile("s_waitcnt vmcnt(0)" ::: "memory");
#undef RA_ISSUE
        if (w < 4) {
#pragma unroll
            for (int mt = 0; mt < 4; ++mt) *(v2u*)(QSEG + ((size_t)unit * 64 + 16 * w + l15) * 64 + q * 16 + mt * 4) = pk4(acc[mt]);
        } else {
            const int pg = w - 4, idx = (pg >> 1) * 32 + (l15 >> 2) * 8 + (pg & 1) * 4 + (l15 & 3);
#pragma unroll
            for (int mt = 0; mt < 4; ++mt)
#pragma unroll
                for (int i = 0; i < 4; ++i) PSEG[((size_t)unit * 64 + 16 * mt + 4 * q + i) * 64 + idx] = (bf16)f2bf(acc[mt][i]);
        }
        __syncthreads();
    }
}
__device__ __forceinline__ void rwkv_scan_c(const Frame& F) {
    const bf16* Rb = wsp<bf16>(F, WS_R); const bf16* Kb = wsp<bf16>(F, WS_K); bf16* S0 = wsp<bf16>(F, WS_S0);
    const bf16* PSEG = wsp<bf16>(F, WS_PSEG); const bf16* QSEG = wsp<bf16>(F, WS_QSEG);
    const int l15 = F.lane & 15, q = F.lane >> 4;
    const size_t cstep = (size_t)RW_L * D * 2;
    for (int unit = F.vcu; unit < 32 * RW_NSEG; unit += F.G) {
        const int seg = unit & (RW_NSEG - 1), bh = unit >> 3, b = bh >> 4, h = bh & 15, hc0 = h * 64;
        const int mbase = b * T + seg * RW_SEG * RW_L;
        if (F.wave >= 4) {
            const int lw = F.wave - 4; const char* src[4];
#pragma unroll
            for (int j = 0; j < 4; ++j) { const int p = lw * 4 + j;
                if (p < 8) { const int mt = p >> 1, sk = p & 1; src[j] = (const char*)(Rb + (size_t)(mbase + 16 * mt + l15) * D + hc0 + sk * 32 + q * 8); }
                else { const int vg = (p - 8) >> 1, half = p & 1; src[j] = (const char*)(Kb + (size_t)(mbase + 16 * vg + l15) * D + hc0 + q * 16 + half * 8); } }
#define RS_ISSUE(c) do { const int _cc = (c) & (RW_SEG - 1); _Pragma("unroll") for (int j = 0; j < 4; ++j) \
        __builtin_amdgcn_global_load_lds((const unsigned*)(src[j] + (size_t)_cc * cstep), (LAS unsigned*)(F.lds + ((c) & 7) * 16384 + (lw * 4 + j) * 1024), 16, 0, 0); } while (0)
            for (int c = 0; c < 7; ++c) RS_ISSUE(c);
            asm volatile("s_waitcnt vmcnt(24)" ::: "memory");
            __builtin_amdgcn_s_barrier();
            for (int c = 0; c < RW_SEG; ++c) { RS_ISSUE(c + 7); asm volatile("s_waitcnt vmcnt(24)" ::: "memory"); __builtin_amdgcn_s_barrier(); }
            asm volatile("s_waitcnt vmcnt(0)" ::: "memory");
#undef RS_ISSUE
        } else {
            const int vg = F.wave;
            f32x4 acc[4];
#pragma unroll
            for (int i = 0; i < 4; ++i) acc[i] = (f32x4){0.f, 0.f, 0.f, 0.f};
            for (int j = 0; j < seg; ++j) { const size_t uj = (size_t)(unit - seg + j);
                bf16x8 A[4][2];
#pragma unroll
                for (int mt = 0; mt < 4; ++mt)
#pragma unroll
                    for (int sk = 0; sk < 2; ++sk) A[mt][sk] = *(const bf16x8*)(PSEG + (uj * 64 + 16 * mt + l15) * 64 + sk * 32 + q * 8);
                const v4u p01 = *(const v4u*)(QSEG + (uj * 64 + 16 * vg + l15) * 64 + q * 16), p23 = *(const v4u*)(QSEG + (uj * 64 + 16 * vg + l15) * 64 + q * 16 + 8);
                const unsigned ps[8] = {p01.x, p01.y, p01.z, p01.w, p23.x, p23.y, p23.z, p23.w};
                RW_STEP(A, ps, true); }
            __builtin_amdgcn_s_barrier();
            for (int c = 0; c < RW_SEG; ++c) {
                const int m0 = mbase + c * RW_L; LAS unsigned char* slot = F.lds + (c & 7) * 16384;
                bf16x8 A[4][2];
#pragma unroll
                for (int mt = 0; mt < 4; ++mt)
#pragma unroll
                    for (int sk = 0; sk < 2; ++sk) A[mt][sk] = *(const LAS bf16x8*)(slot + (mt * 2 + sk) * 1024 + F.lane * 16);
                const v4u p01 = *(const LAS v4u*)(slot + (8 + vg * 2) * 1024 + F.lane * 16), p23 = *(const LAS v4u*)(slot + (9 + vg * 2) * 1024 + F.lane * 16);
#pragma unroll
                for (int mt = 0; mt < 4; ++mt) *(v2u*)(S0 + (size_t)(m0 + 16 * vg + l15) * D + hc0 + 16 * mt + 4 * q) = pk4(acc[mt]);
                const unsigned ps[8] = {p01.x, p01.y, p01.z, p01.w, p23.x, p23.y, p23.z, p23.w};
                RW_STEP(A, ps, true);
                asm volatile("s_waitcnt lgkmcnt(0)" ::: "memory");
                __builtin_amdgcn_s_barrier();
            }
        }
        __syncthreads();
    }
}
__device__ __forceinline__ void rwkv_post(const Frame& F) {
    const int gw = F.vcu * NWAVES + F.wave, NGW = F.G * NWAVES, fr = F.lane & 15, fq = F.lane >> 4;
    bf16* Rb = wsp<bf16>(F, WS_R); const bf16* Vb = wsp<bf16>(F, WS_V); const bf16* LR = wsp<bf16>(F, WS_LR);
    const bf16* OMT = wsp<bf16>(F, WS_OMT); const bf16* YL = wsp<bf16>(F, WS_YL); const bf16* S0 = wsp<bf16>(F, WS_S0);
    const bf16* g2t = wsp<bf16>(F, WS_W2T) + 2 * 1024 * 64; const float* RKS = wsp<float>(F, WS_RKS);
    for (int item = gw; item < 4096 * 4; item += NGW) {
        const int unit = item >> 2, mt = item & 3;
        const int c = unit & 127, h = (unit >> 7) & 15, b = unit >> 11;
        const int m0 = b * T + c * RW_L, hc0 = h * 64, t = 16 * mt + fr; const size_t rowt = (size_t)(m0 + t);
        f32x4 y[4], g[4];
        bf16x8 om[2], lg[4];
#pragma unroll
        for (int ks = 0; ks < 2; ++ks) om[ks] = *(const bf16x8*)(OMT + rowt * D + hc0 + ks * 32 + fq * 8);
#pragma unroll
        for (int ks = 0; ks < 4; ++ks) lg[ks] = *(const bf16x8*)(LR + rowt * 256 + 128 + ks * 32 + fq * 8);
#pragma unroll
        for (int nt = 0; nt < 4; ++nt) {
            const v2u yl = *(const v2u*)(YL + rowt * D + hc0 + 16 * nt + 4 * fq);
            f32x4 a = (f32x4){bflo(yl.x), bfhi(yl.x), bflo(yl.y), bfhi(yl.y)};
#pragma unroll
            for (int ks = 0; ks < 2; ++ks) { const bf16x8 sb = *(const bf16x8*)(S0 + (size_t)(m0 + 16 * nt + fr) * D + hc0 + ks * 32 + fq * 8);
                a = __builtin_amdgcn_mfma_f32_16x16x32_bf16(sb, om[ks], a, 0, 0, 0); }
            y[nt] = a;
            f32x4 gg = (f32x4){0.f, 0.f, 0.f, 0.f};
#pragma unroll
            for (int ks = 0; ks < 4; ++ks) { const bf16x8 gb = *(const bf16x8*)(g2t + (size_t)(hc0 + 16 * nt + fr) * 128 + ks * 32 + fq * 8);
                gg = __builtin_amdgcn_mfma_f32_16x16x32_bf16(gb, lg[ks], gg, 0, 0, 0); }
            g[nt] = gg; }
        float s = 0.f;
#pragma unroll
        for (int nt = 0; nt < 4; ++nt) s += (y[nt][0] + y[nt][1]) + (y[nt][2] + y[nt][3]);
        s += __shfl_xor(s, 16); s += __shfl_xor(s, 32);
        const float mu = s * (1.f / 64.f); float qv = 0.f;
#pragma unroll
        for (int nt = 0; nt < 4; ++nt) { y[nt] = y[nt] - mu; qv += (y[nt][0] * y[nt][0] + y[nt][1] * y[nt][1]) + (y[nt][2] * y[nt][2] + y[nt][3] * y[nt][3]); }
        qv += __shfl_xor(qv, 16); qv += __shfl_xor(qv, 32);
        const float rstd = 1.f / sqrtf(qv * (1.f / 64.f) + GN_EPS);
        const float rk = RKS[rowt * 16 + h];
#pragma unroll
        for (int nt = 0; nt < 4; ++nt) { const int v = hc0 + 16 * nt + 4 * fq;
            const f32x4 lgv = *(const f32x4*)(F.in[I_RLG] + v), lbv = *(const f32x4*)(F.in[I_RLB] + v);
            const v2u vr = *(const v2u*)(Vb + rowt * D + v);
            f32x4 o; o[0] = (y[nt][0] * rstd * lgv[0] + lbv[0] + rk * bflo(vr.x)) * g[nt][0]; o[1] = (y[nt][1] * rstd * lgv[1] + lbv[1] + rk * bfhi(vr.x)) * g[nt][1];
            o[2] = (y[nt][2] * rstd * lgv[2] + lbv[2] + rk * bflo(vr.y)) * g[nt][2]; o[3] = (y[nt][3] * rstd * lgv[3] + lbv[3] + rk * bfhi(vr.y)) * g[nt][3];
            *(v2u*)(Rb + rowt * D + v) = pk4(o); }
    }
}
__device__ __forceinline__ void norm_phase(const Frame& F, const float* g, bf16* XN) {
    const int gw = F.vcu * NWAVES + F.wave, NGW = F.G * NWAVES;
    for (int m = gw; m < M; m += NGW) { f32x4 v[4]; rms_row_h(HBp(F) + (size_t)m * D, g, F.lane, v); store_row_bf16(XN + (size_t)m * D, F.lane, v); }
}
__device__ __forceinline__ void a2_phase(const Frame& F) {
    const int gw = F.vcu * NWAVES + F.wave, NGW = F.G * NWAVES; const float* g = F.in[I_NMG] + D; bf16* A2 = wsp<bf16>(F, WS_A2);
    for (int blk = gw; blk < M / 8; blk += NGW) {
        const int r0 = 8 * blk; f32x4 prev[4];
        if ((r0 & (T - 1)) == 0) {
#pragma unroll
            for (int j = 0; j < 4; ++j) prev[j] = (f32x4){0.f, 0.f, 0.f, 0.f};
        } else rms_row_h(HBp(F) + (size_t)(r0 - 1) * D, g, F.lane, prev);
        for (int i = 0; i < 8; ++i) { f32x4 cur[4]; rms_row_h(HBp(F) + (size_t)(r0 + i) * D, g, F.lane, cur);
            store_row_bf16(A2 + (size_t)(r0 + i) * 2048, F.lane, cur);
            f32x4 dx[4];
#pragma unroll
            for (int j = 0; j < 4; ++j) { dx[j] = prev[j] - cur[j]; prev[j] = cur[j]; }
            store_row_bf16(A2 + (size_t)(r0 + i) * 2048 + D, F.lane, dx); }
    }
}
__device__ __forceinline__ void router_phase(const Frame& F) {
    LAS int* wgc = (LAS int*)(F.lds + 131072); LAS int* wbase = wgc + 8; LAS int* TE = wgc + 16; LAS int* TL = TE + 128; LAS float* TW = (LAS float*)(TL + 128);
    const float* g = F.in[I_NFG] + D; const float* rw = F.in[I_MR]; const float* rb = F.in[I_MRB]; bf16* XN3 = wsp<bf16>(F, WS_XN3);
    for (int blk = F.vcu; blk < M / 64; blk += F.G) {
    if (F.tid < 8) wgc[F.tid] = 0;
    __syncthreads();
    for (int i = 0; i < 8; ++i) {
        const int tl = 8 * F.wave + i, m = 64 * blk + tl;
        if (m < M) {
            f32x4 v[4]; rms_row_h(HBp(F) + (size_t)m * D, g, F.lane, v); store_row_bf16(XN3 + (size_t)m * D, F.lane, v);
            float lg[8];
#pragma unroll
            for (int e = 0; e < 8; ++e) lg[e] = 0.f;
#pragma unroll
            for (int j = 0; j < 4; ++j)
#pragma unroll
                for (int x = 0; x < 4; ++x) { const int k = 4 * F.lane + 256 * j + x; const f32x4 r0 = *(const f32x4*)(rw + k * 8), r1 = *(const f32x4*)(rw + k * 8 + 4); const float xv = v[j][x];
                    lg[0] += xv * r0[0]; lg[1] += xv * r0[1]; lg[2] += xv * r0[2]; lg[3] += xv * r0[3]; lg[4] += xv * r1[0]; lg[5] += xv * r1[1]; lg[6] += xv * r1[2]; lg[7] += xv * r1[3]; }
#pragma unroll
            for (int e = 0; e < 8; ++e) lg[e] = wave_sum(lg[e]) + rb[e];
            int e1 = 0; float l1 = lg[0];
#pragma unroll
            for (int e = 1; e < 8; ++e) if (lg[e] > l1) { l1 = lg[e]; e1 = e; }
            int e2 = (e1 + 1) & 7; float l2 = -3.0e38f;
#pragma unroll
            for (int e = 0; e < 8; ++e) if (e != e1 && lg[e] > l2) { l2 = lg[e]; e2 = e; }
            const float w1 = 1.f / (1.f + expf(l2 - l1)), w2 = 1.f - w1;
            if (F.lane == 0) { const int a = atomicAdd((int*)&wgc[e1], 1), bb = atomicAdd((int*)&wgc[e2], 1);
                TE[2 * tl] = e1; TE[2 * tl + 1] = e2; TL[2 * tl] = a; TL[2 * tl + 1] = bb; TW[2 * tl] = w1; TW[2 * tl + 1] = w2; }
        }
    }
    __syncthreads();
    if (F.tid < 8) wbase[F.tid] = (int)__hip_atomic_fetch_add((unsigned*)(F.ws + WS_CTL) + CW_CNT + F.tid, (unsigned)wgc[F.tid], RLX_AGENT);
    __syncthreads();
    if (F.tid < 128) { const int tl = F.tid >> 1, m = 64 * blk + tl;
        if (m < M) { unsigned char* rt = F.ws + WS_ROUTE; const int e = TE[F.tid];
            ((int*)(rt + RT_E))[2 * m + (F.tid & 1)] = e; ((int*)(rt + RT_POS))[2 * m + (F.tid & 1)] = wbase[e] + TL[F.tid]; ((float*)(rt + RT_W))[2 * m + (F.tid & 1)] = TW[F.tid]; } }
    __syncthreads();
    }
    run_jobs(F, true);
}
__device__ __forceinline__ void moe_offsets(const Frame& F, int (&toff)[9]) {
    const unsigned* cnt = (const unsigned*)(F.ws + WS_CTL) + CW_CNT; int acc = 0;
#pragma unroll
    for (int e = 0; e < 8; ++e) { toff[e] = acc; acc += ((int)__hip_atomic_load(cnt + e, RLX_AGENT) + 255) >> 8; }
    toff[8] = acc;
}
__device__ __forceinline__ void gather_phase(const Frame& F) {
    int toff[9]; moe_offsets(F, toff);
    const int gw = F.vcu * NWAVES + F.wave, NGW = F.G * NWAVES; unsigned char* rt = F.ws + WS_ROUTE;
    const bf16* XN3 = wsp<bf16>(F, WS_XN3); bf16* XG = wsp<bf16>(F, WS_XG);
    for (int p = gw; p < 2 * M; p += NGW) {
        const int m = p >> 1; const int e = ((const int*)(rt + RT_E))[p], pos = ((const int*)(rt + RT_POS))[p]; const float w = ((const float*)(rt + RT_W))[p];
        int off = 0;
#pragma unroll
        for (int j = 0; j < 8; ++j) off = (e == j) ? toff[j] : off;
        int slot = off * 256 + pos; if ((unsigned)e >= 8u || (unsigned)slot >= (unsigned)XG_ROWS) slot = XG_ROWS - 1;
        const v4u* src = (const v4u*)(XN3 + (size_t)m * D); v4u* dst = (v4u*)(XG + (size_t)slot * D);
        dst[F.lane] = src[F.lane]; dst[64 + F.lane] = src[64 + F.lane];
        if (F.lane == 0) { ((int*)(rt + RT_SLOT))[p] = slot; ((float*)(rt + RT_SLOTW))[slot] = w; }
    }
}
__device__ __forceinline__ void final_stage1(const Frame& F, int blk) {
    const v4u* src = (const v4u*)(HBp(F) + (size_t)blk * 64 * D);
#pragma unroll
    for (int i = 0; i < 16; ++i) { const int id = F.tid + 512 * i; *(LAS v4u*)(F.lds + id * 16) = src[id]; }
}
__device__ __forceinline__ void final_stage2(const Frame& F, int blk) {
    unsigned char* rt = F.ws + WS_ROUTE; const bf16* YE = wsp<bf16>(F, WS_XG); const float* g = F.in[I_NOG];
    for (int i = 0; i < 8; ++i) {
        const int rl = 8 * F.wave + i, m = 64 * blk + rl;
        int s0 = ((const int*)(rt + RT_SLOT))[2 * m], s1 = ((const int*)(rt + RT_SLOT))[2 * m + 1];
        if ((unsigned)s0 >= (unsigned)XG_ROWS) s0 = XG_ROWS - 1; if ((unsigned)s1 >= (unsigned)XG_ROWS) s1 = XG_ROWS - 1;
        const LAS v2u* hr = (const LAS v2u*)(F.lds + rl * 2048) + F.lane; const v2u* y0 = (const v2u*)(YE + (size_t)s0 * D) + F.lane; const v2u* y1 = (const v2u*)(YE + (size_t)s1 * D) + F.lane;
        f32x4 v[4]; float s = 0.f;
#pragma unroll
        for (int j = 0; j < 4; ++j) { const v2u a = y0[64 * j], bq = y1[64 * j], hh = hr[64 * j];
            v[j][0] = bflo(hh.x) + bflo(a.x) + bflo(bq.x); v[j][1] = bfhi(hh.x) + bfhi(a.x) + bfhi(bq.x); v[j][2] = bflo(hh.y) + bflo(a.y) + bflo(bq.y); v[j][3] = bfhi(hh.y) + bfhi(a.y) + bfhi(bq.y);
            s += (v[j][0] * v[j][0] + v[j][1] * v[j][1]) + (v[j][2] * v[j][2] + v[j][3] * v[j][3]); }
        const float rs = 1.f / sqrtf(wave_sum(s) * (1.f / D) + RMS_EPS);
        f32x4* o = (f32x4*)(F.out + (size_t)m * D) + F.lane; const f32x4* gr = (const f32x4*)g + F.lane;
#pragma unroll
        for (int j = 0; j < 4; ++j) o[64 * j] = v[j] * rs * gr[64 * j];
    }
}
constexpr int N_PHASES = 20;
struct Args { const float* in[37]; float* out; unsigned char* ws; int ph_lo, ph_hi; };
__global__ void __launch_bounds__(NTHREADS, 2) fwd_kernel(Args args) {
    extern __shared__ __attribute__((aligned(16))) unsigned char lds_raw[];
    Frame F;
    F.lds = (LAS unsigned char*)lds_raw;
    F.tid = threadIdx.x; F.lane = F.tid & 63; F.wave = __builtin_amdgcn_readfirstlane(F.tid >> 6);
    F.G = gridDim.x; { const int bx = blockIdx.x; F.vcu = (F.G % 8 == 0) ? (bx % 8) * (F.G / 8) + bx / 8 : bx; }
#pragma unroll
    for (int i = 0; i < 37; ++i) F.in[i] = args.in[i];
    F.out = args.out; F.ws = args.ws;
    volatile LAS unsigned* MISC = (volatile LAS unsigned*)(F.lds + MISC_OFF);
    if (F.tid < 64) MISC[F.tid] = 0u;
    __syncthreads();
    const int lo = args.ph_lo, hi = args.ph_hi;
    const bool multi = (hi - lo) > 1;
    XcdBarrier bar; bar.bar = (unsigned*)(F.ws + WS_CTL) + CW_BAR; bar.x = 0; bar.st = nullptr;
    if (multi) bar = xcd_barrier_post((unsigned*)(F.ws + WS_CTL) + CW_BAR, MISC + 8);
#define IN(k) (lo <= (k) && (k) < hi)
#define SEAM(k) do { if (IN(k) && IN((k) + 1)) xcd_barrier(bar); } while (0)
    LAS unsigned char* lds = F.lds;
    const int cu = (int)blockIdx.x;

    if (IN(0)) { p0_prologue(F); } SEAM(0);
    if (IN(1)) { pg8::DenseOrder S; S.init(wsp<bf16>(F, WS_XN), wsp<bf16>(F, WS_WIN), M, MIX_IN, 1024, F.G, cu);
        epi::MixIn E{wsp<bf16>(F, WS_Z), wsp<float>(F, WS_LB)};
        pg8::gemm_phase(lds, 1024, S, E); } SEAM(1);
    if (IN(2)) { for (int u = F.vcu; u < 512; u += F.G) gmlp_unit(F, u);
        hgrn_pre_phase(F); } SEAM(2);
    if (IN(3)) { hgrn_scan(F); } SEAM(3);
    if (IN(4)) { hgrn_post_phase(F); } SEAM(4);
    if (IN(5)) { pg8::DenseOrder S; S.init(wsp<bf16>(F, WS_XN), wsp<bf16>(F, WS_WOUT), M, D, 1024, F.G, cu);
        epi::Resid<true> E{F.in[I_X], HBp(F)};
        pg8::gemm_phase(lds, 1024, S, E); } SEAM(5);
    if (IN(6)) { norm_phase(F, F.in[I_NFG], wsp<bf16>(F, WS_XN)); } SEAM(6);
    if (IN(7)) { pg8::DenseOrder S; S.init(wsp<bf16>(F, WS_XN), wsp<bf16>(F, WS_WGU), M, 2 * DFF, 1024, F.G, cu);
        epi::SwiGlu E{wsp<bf16>(F, WS_HF), DFF, nullptr};
        pg8::gemm_phase(lds, 1024, S, E); } SEAM(7);
    if (IN(8)) { pg8::DenseOrder S; S.init(wsp<bf16>(F, WS_HF), wsp<bf16>(F, WS_WD), M, D, DFF, F.G, cu);
        epi::Resid<false> E{nullptr, HBp(F)};
        pg8::gemm_phase(lds, DFF, S, E); } SEAM(8);
    if (IN(9)) { a2_phase(F); } SEAM(9);
    if (IN(10)) { pg8::DenseOrder S; S.init(wsp<bf16>(F, WS_A2), wsp<bf16>(F, WS_WR), M, NRW, 2048, F.G, cu);
        epi::RwkvProj E{wsp<bf16>(F, WS_R), (size_t)(WS_K - WS_R) / 2, wsp<bf16>(F, WS_LR)};
        pg8::gemm_phase(lds, 2048, S, E); } SEAM(10);
    if (IN(11)) { rwkv_pre_phase(F); } SEAM(11);
    if (IN(12)) { rwkv_scan_a(F); xcd_barrier(bar); rwkv_scan_c(F); } SEAM(12);
    if (IN(13)) { rwkv_post(F); } SEAM(13);
    if (IN(14)) { pg8::DenseOrder S; S.init(wsp<bf16>(F, WS_R), wsp<bf16>(F, WS_WO), M, D, 1024, F.G, cu);
        epi::Resid<false> E{nullptr, HBp(F)};
        pg8::gemm_phase(lds, 1024, S, E); } SEAM(14);
    if (IN(15)) { router_phase(F); } SEAM(15);
    if (IN(16)) { gather_phase(F); } SEAM(16);
    if (IN(17)) { pg8::MoeOrder S; moe_offsets(F, S.toff); S.ntiles = S.toff[8]; S.nN = 2 * DFE / 256; S.nwg = S.ntiles * S.nN; S.G = F.G; S.c = cu;
        S.A = (const char*)wsp<bf16>(F, WS_XG); S.Bt = (const char*)wsp<bf16>(F, WS_WEGU); S.tstep = (size_t)256 * 1024 * 2; S.estride = (size_t)2 * DFE * 1024 * 2;
        epi::SwiGlu E{wsp<bf16>(F, WS_HE), DFE, (const float*)(F.ws + WS_ROUTE + RT_SLOTW)};
        pg8::gemm_phase(lds, 1024, S, E); } SEAM(17);
    if (IN(18)) { pg8::MoeOrder S; moe_offsets(F, S.toff); S.ntiles = S.toff[8]; S.nN = D / 256; S.nwg = S.ntiles * S.nN; S.G = F.G; S.c = cu;
        S.A = (const char*)wsp<bf16>(F, WS_HE); S.Bt = (const char*)wsp<bf16>(F, WS_WED); S.tstep = (size_t)256 * DFE * 2; S.estride = (size_t)1024 * DFE * 2;
        epi::StoreBf16 E{wsp<bf16>(F, WS_XG), D};
        pg8::gemm_phase(lds, DFE, S, E); } SEAM(18);
    if (IN(19)) {
        for (int b0 = 0; b0 < M / 64; b0 += F.G) { const int blk = b0 + F.vcu;
            if (blk < M / 64) final_stage1(F, blk);
            xcd_barrier(bar);
            if (blk < M / 64) final_stage2(F, blk);
            if (b0 + F.G < M / 64) xcd_barrier(bar); } }
#undef IN
#undef SEAM
}


struct DiagReg { size_t off; int rows, stride, col0, ncols, isf32; float lo, hi; };
struct DiagArgs { DiagReg r[12]; int n; int pad; };
__global__ void diag_count(unsigned char* ws, unsigned* cnt, DiagArgs da) {
    for (int ri = 0; ri < da.n; ++ri) { const DiagReg R = da.r[ri]; const long tot = (long)R.rows * R.ncols; float worst = 0.f;
        for (long i = (long)blockIdx.x * blockDim.x + threadIdx.x; i < tot; i += (long)gridDim.x * blockDim.x) { const long row = i / R.ncols; const int col = (int)(i % R.ncols);
            float v;
            if (R.isf32) v = ((const float*)(ws + R.off))[row * R.stride + R.col0 + col];
            else v = __builtin_bit_cast(float, (unsigned)((const unsigned short*)(ws + R.off))[row * R.stride + R.col0 + col] << 16);
            if (!(v <= R.hi && v >= R.lo)) { float a = fabsf(v); if (!(a < 1e30f)) a = 1e30f; if (a < 1e-30f) a = 1e-30f; worst = fmaxf(worst, a); } }
        if (worst > 0.f) atomicMax(cnt + ri, __float_as_uint(worst)); }
}
__global__ void diag_mark(float* out, unsigned* cnt, DiagArgs da, int total) {
    for (int i = blockIdx.x * blockDim.x + threadIdx.x; i < total; i += gridDim.x * blockDim.x) out[i] = 0.f;
    if (threadIdx.x == 0 && blockIdx.x == 0) { int first = -1; for (int i = da.n - 1; i >= 0; --i) if (cnt[i]) first = i;
        if (first >= 0) { const float w = __uint_as_float(cnt[first]), bound = fmaxf(fabsf(da.r[first].lo), fabsf(da.r[first].hi));
            float m = 1.f + log10f(fmaxf(w / bound, 1.f)) * 0.25f; if (m > 9.5f) m = 9.5f;
            out[0] = sqrtf(1.678e7f * m * powf(10.f, 2.f + first)); } }
}
extern "C" void kernel_launch(void* const* d_in, const int* in_sizes, int n_in, void* d_out, int out_size, void* d_ws, size_t ws_size, hipStream_t stream) {
    static int grid = 0;
    if (grid == 0) {
        if (n_in != 37 || out_size != M * D || ws_size < WS_END) { fprintf(stderr, "kernel_launch: unexpected shapes (n_in %d out %d ws %zu)\n", n_in, out_size, ws_size); grid = -1; return; }
        int dev = 0, cus = 0, per_cu = 0;
        hipGetDevice(&dev); hipDeviceGetAttribute(&cus, hipDeviceAttributeMultiprocessorCount, dev);
        hipFuncSetAttribute((const void*)fwd_kernel, hipFuncAttributeMaxDynamicSharedMemorySize, LDS_BYTES);
        hipOccupancyMaxActiveBlocksPerMultiprocessor(&per_cu, (const void*)fwd_kernel, NTHREADS, LDS_BYTES);
        (void)hipGetLastError();
        grid = cus;
        if (per_cu < 1) fprintf(stderr, "kernel_launch: occupancy query says %d blocks per CU\n", per_cu);
    }
    if (grid < 0) return;
    hipMemsetAsync((char*)d_ws + WS_CTL, 0, CTL_ZERO_BYTES, stream);
    Args a{};
    for (int i = 0; i < 37; ++i) a.in[i] = (const float*)d_in[i];
    a.out = (float*)d_out; a.ws = (unsigned char*)d_ws;
#if MK_N_LAUNCHES == 1
    a.ph_lo = 0; a.ph_hi = N_PHASES;
    hipLaunchKernelGGL(fwd_kernel, dim3(grid), dim3(NTHREADS), LDS_BYTES, stream, a);
#else
    for (int p = 0; p < MK_PH_HI; ++p) { a.ph_lo = p; a.ph_hi = p + 1; hipLaunchKernelGGL(fwd_kernel, dim3(grid), dim3(NTHREADS), LDS_BYTES, stream, a); }
#endif
}
```

```cpp
#include <hip/hip_runtime.h>
#include <cstdio>
#include <cstdint>
#ifndef MK_N_LAUNCHES
#define MK_N_LAUNCHES 1
#endif
#ifndef MK_PH_HI
#define MK_PH_HI 20
#endif
namespace pg8 {
#define PG8_LAS __attribute__((address_space(3)))
typedef unsigned short bf16_t;
typedef short bf16x8 __attribute__((ext_vector_type(8)));
typedef float f32x4 __attribute__((ext_vector_type(4)));
typedef float f32x2 __attribute__((ext_vector_type(2)));
typedef unsigned u32x4 __attribute__((ext_vector_type(4)));
constexpr int BM = 256, BK = 64, HALF = 128, HTB = HALF * BK * 2, STAGE_BYTES = 8 * HTB, NXCD = 8, WGM = 8;

__host__ __device__ __forceinline__ int lds_byte(int r, int c) { const int st = (r >> 4) * 2 + (c >> 5), rr = r & 15, cc = c & 31, ob = rr * 64 + cc * 2; return st * 1024 + (ob ^ (((ob >> 9) & 1) << 5)); }
__host__ __device__ __forceinline__ void stage_rc(int b, int& R, int& C) { const int st = b / 1024, sb = b % 1024, swz = sb ^ (((sb >> 9) & 1) << 5); R = (st >> 1) * 16 + swz / 64; C = (st & 1) * 32 + (swz % 64) / 2; }
__host__ __device__ __forceinline__ int perm32(int rho) { const int n = rho >> 4, i = rho & 15; return 8 * (i >> 2) + 4 * n + (i & 3); }

struct Unit { int pm, pn; const char* A; const char* B; int aux; };

struct DenseOrder {
    static constexpr bool GATHER = false;
    int nM, nN, nwg, G, c; const char* A; const char* Bt; size_t tstep;
    __device__ void init(const void* A_, const void* Bt_, int M, int N, int K, int G_, int c_) { nM = M / BM; nN = N / BM; nwg = nM * nN; G = G_; c = c_; A = (const char*)A_; Bt = (const char*)Bt_; tstep = (size_t)BM * K * 2; }
    __device__ bool next(int i, Unit& u) const {
        const long L = (long)i * G + c; if (L >= nwg) return false;
        int wgid = (int)L; { const int q = nwg / NXCD, r = nwg % NXCD, xcd = wgid % NXCD, off = wgid / NXCD; wgid = (xcd < r ? xcd * (q + 1) : r * (q + 1) + (xcd - r) * q) + off; }
        const int nig = WGM * nN, gid = wgid / nig, fm = gid * WGM, gsz = (nM - fm) < WGM ? (nM - fm) : WGM;
        u.pm = fm + ((wgid % nig) % gsz); u.pn = (wgid % nig) / gsz;
        u.A = A + (size_t)u.pm * tstep; u.B = Bt + (size_t)u.pn * tstep; u.aux = 0; return true;
    }
};
template <bool GA> struct MoeOrder {
    static constexpr bool GATHER = GA;
    int ntiles, nN, nwg, G, c; int toff[9]; int cnt[8]; const char* A; const char* Bt; size_t tstep, estride; const int* p2t; int rowbytes;
    __device__ bool next(int i, Unit& u) const {
        const long L = (long)i * G + c; if (L >= nwg) return false;
        int wgid = (int)L; { const int q = nwg / NXCD, r = nwg % NXCD, xcd = wgid % NXCD, off = wgid / NXCD; wgid = (xcd < r ? xcd * (q + 1) : r * (q + 1) + (xcd - r) * q) + off; }
        const int nig = WGM * nN, gid = wgid / nig, fm = gid * WGM, gsz = (ntiles - fm) < WGM ? (ntiles - fm) : WGM;
        const int rt = fm + ((wgid % nig) % gsz), pn = (wgid % nig) / gsz;
        int e = 0;
#pragma unroll
        for (int j = 1; j < 8; ++j) e += (rt >= toff[j]) ? 1 : 0;
        int te = 0;
#pragma unroll
        for (int j = 0; j < 8; ++j) te = (e == j) ? toff[j] : te;
        u.pm = rt; u.pn = pn; u.A = GA ? A : A + (size_t)rt * tstep; u.B = Bt + (size_t)e * estride + (size_t)pn * tstep;
        u.aux = e * 16384 + 256 * (rt - te) - 256 * rt;
        return true;
    }
    __device__ __forceinline__ void gather(const Unit& u, const int (&R)[2], const int (&C)[2], unsigned (&off)[2][2]) const {
        const int e = (u.aux + 256 * u.pm) >> 14; int ce = 0;
#pragma unroll
        for (int j = 0; j < 8; ++j) ce = (e == j) ? cnt[j] : ce;
        const int pos0 = (u.aux + 256 * u.pm) & 16383;
#pragma unroll
        for (int h = 0; h < 2; ++h)
#pragma unroll
            for (int i = 0; i < 2; ++i) { const int pos = pos0 + 128 * h + R[i]; const int tok = (pos < ce) ? p2t[e * 16384 + pos] : 0; off[h][i] = (unsigned)tok * (unsigned)rowbytes + (unsigned)C[i] * 2u; }
    }
};

typedef __bf16 bf16x2_t __attribute__((ext_vector_type(2)));
__device__ __forceinline__ unsigned cvt_pk_bf16(float lo, float hi) { f32x2 v = {lo, hi}; bf16x2_t b = __builtin_convertvector(v, bf16x2_t); return __builtin_bit_cast(unsigned, b); }

template <class Epi, class Sched>
__device__ __forceinline__ void gemm_phase(PG8_LAS unsigned char* lds, const int K, const Sched& S, const Epi& E) {
    const int tid = threadIdx.x, wid = __builtin_amdgcn_readfirstlane(tid >> 6), lane = tid & 63, wr = wid >> 2, wc = wid & 3, fr = lane & 15, fq = lane >> 4;
    const int nt = K / BK;
    constexpr bool GA = Sched::GATHER;
    unsigned voffA[2], voffB[2]; int gR[2], gC[2];
#pragma unroll
    for (int i = 0; i < 2; ++i) { int R, C; stage_rc(tid * 16 + i * 8192, R, C); const int Rb = Epi::PERM ? ((R & ~31) + perm32(R & 31)) : R; gR[i] = R; gC[i] = C;
        voffA[i] = (unsigned)(R * K + C) * 2u; voffB[i] = (unsigned)(Rb * K + C) * 2u; }
    unsigned gcur[2][2], gnxt[2][2];
    const size_t kstep = (size_t)(BK * 2);
    const size_t hstep = (size_t)HALF * K * 2;
    const unsigned ldsw = (unsigned)wid * 1024u;
    const int aoff = lds_byte(wr * 64 + fr, fq * 8), boff = lds_byte(wc * 32 + fr, fq * 8);
#define PG8_SA(b, h) (((b) * 2 + (h)) * HTB)
#define PG8_SB(b, h) ((4 + (b) * 2 + (h)) * HTB)
#define PG8_STAGE(bufoff, gbase, voff) do { _Pragma("unroll") for (int _i = 0; _i < 2; ++_i) \
        __builtin_amdgcn_global_load_lds((const unsigned*)((const char*)(gbase) + (voff)[_i]), (PG8_LAS unsigned*)(lds + (bufoff) + ldsw + _i * 8192), 16, 0, 0); } while (0)
#define PG8_STAGE_A(bufoff, h, abase, nx) do { if constexpr (GA) { _Pragma("unroll") for (int _i = 0; _i < 2; ++_i) \
        __builtin_amdgcn_global_load_lds((const unsigned*)((const char*)(abase) + ((nx) ? gnxt[h][_i] : gcur[h][_i])), (PG8_LAS unsigned*)(lds + (bufoff) + ldsw + _i * 8192), 16, 0, 0); } \
    else { PG8_STAGE(bufoff, (const char*)(abase) + (h) * hstep, voffA); } } while (0)
#define PG8_LDA(dst, b, h) do { _Pragma("unroll") for (int m = 0; m < 4; ++m) _Pragma("unroll") for (int k = 0; k < 2; ++k) dst[m][k] = *(const PG8_LAS bf16x8*)(lds + PG8_SA(b, h) + aoff + m * 2048 + k * 1024); } while (0)
#define PG8_LDB(dst, b, h) do { _Pragma("unroll") for (int n = 0; n < 2; ++n) _Pragma("unroll") for (int k = 0; k < 2; ++k) dst[n][k] = *(const PG8_LAS bf16x8*)(lds + PG8_SB(b, h) + boff + n * 2048 + k * 1024); } while (0)
#define PG8_MMA(ai, bj, At, Bt) do { __builtin_amdgcn_s_setprio(1); _Pragma("unroll") for (int m = 0; m < 4; ++m) _Pragma("unroll") for (int n = 0; n < 2; ++n) _Pragma("unroll") for (int k = 0; k < 2; ++k) \
        acc[ai][bj][m][n] = __builtin_amdgcn_mfma_f32_16x16x32_bf16(Bt[n][k], At[m][k], acc[ai][bj][m][n], 0, 0, 0); __builtin_amdgcn_s_setprio(0); } while (0)
#define PG8_WAIT_V(n) asm volatile("s_waitcnt vmcnt(" #n ")" ::: "memory")
#define PG8_WAIT_L(n) asm volatile("s_waitcnt lgkmcnt(" #n ")" ::: "memory")
#define PG8_BAR __builtin_amdgcn_s_barrier()
#define PG8_SCHED __builtin_amdgcn_sched_barrier(0)
    Unit cur, nxt; int ui = 0;
    if (!S.next(0, cur)) return;
    f32x4 acc[2][2][4][2];
#pragma unroll
    for (int a = 0; a < 2; ++a)
#pragma unroll
        for (int b = 0; b < 2; ++b)
#pragma unroll
            for (int m = 0; m < 4; ++m)
#pragma unroll
                for (int n = 0; n < 2; ++n) acc[a][b][m][n] = (f32x4){0.f, 0.f, 0.f, 0.f};
    bf16x8 At[4][2], B0[2][2], B1[2][2];
    const char* cA = cur.A; const char* cB = cur.B;
    if constexpr (GA) S.gather(cur, gR, gC, gcur);
    PG8_STAGE(PG8_SB(0, 0), cB, voffB); PG8_STAGE(PG8_SB(0, 1), cB + hstep, voffB); PG8_STAGE_A(PG8_SA(0, 0), 0, cA, false); PG8_STAGE_A(PG8_SA(0, 1), 1, cA, false);
    if (wr == 1) PG8_BAR;
    PG8_WAIT_V(2); PG8_BAR;
    PG8_STAGE(PG8_SB(1, 0), cB + kstep, voffB); PG8_STAGE_A(PG8_SA(1, 0), 0, cA + kstep, false); PG8_STAGE(PG8_SB(1, 1), cB + hstep + kstep, voffB);
    PG8_WAIT_V(6); PG8_BAR;
    for (;;) {
        const bool has_next = S.next(ui + 1, nxt);
        const char* nA = has_next ? nxt.A : cA; const char* nB = has_next ? nxt.B : cB;
        if constexpr (GA) { if (has_next) S.gather(nxt, gR, gC, gnxt); else {
#pragma unroll
            for (int h = 0; h < 2; ++h)
#pragma unroll
                for (int i = 0; i < 2; ++i) gnxt[h][i] = gcur[h][i]; } }
        for (int t = 0; t < nt; t += 2) {
            const bool last = (t == nt - 2);
            const char* a1 = cA + (size_t)(t + 1) * kstep;
            const char* a2 = last ? nA : cA + (size_t)(t + 2) * kstep; const char* b2 = last ? nB : cB + (size_t)(t + 2) * kstep;
            const char* a3 = a2 + kstep; const char* b3 = b2 + kstep;
            PG8_LDB(B0, 0, 0); PG8_LDB(B1, 0, 1); PG8_SCHED; PG8_LDA(At, 0, 0); PG8_STAGE_A(PG8_SA(1, 1), 1, a1, false);
            PG8_WAIT_V(8); PG8_WAIT_L(0); PG8_BAR; PG8_MMA(0, 0, At, B0); PG8_MMA(0, 1, At, B1); PG8_BAR; PG8_SCHED;
            PG8_LDA(At, 0, 1); PG8_STAGE(PG8_SB(0, 0), b2, voffB); PG8_STAGE(PG8_SB(0, 1), b2 + hstep, voffB); PG8_STAGE_A(PG8_SA(0, 0), 0, a2, last);
            PG8_WAIT_V(8); PG8_WAIT_L(0); PG8_BAR; PG8_MMA(1, 0, At, B0); PG8_MMA(1, 1, At, B1); PG8_BAR; PG8_SCHED;
            PG8_LDB(B0, 1, 0); PG8_LDB(B1, 1, 1); PG8_SCHED; PG8_LDA(At, 1, 0); PG8_STAGE_A(PG8_SA(0, 1), 1, a2, last);
            PG8_WAIT_V(8); PG8_WAIT_L(0); PG8_BAR; PG8_MMA(0, 0, At, B0); PG8_MMA(0, 1, At, B1); PG8_BAR; PG8_SCHED;
            PG8_LDA(At, 1, 1); PG8_STAGE(PG8_SB(1, 0), b3, voffB); PG8_STAGE(PG8_SB(1, 1), b3 + hstep, voffB); PG8_STAGE_A(PG8_SA(1, 0), 0, a3, last);
            PG8_WAIT_V(8); PG8_WAIT_L(0); PG8_BAR; PG8_MMA(1, 0, At, B0); PG8_MMA(1, 1, At, B1); PG8_BAR; PG8_SCHED;
        }
        if (wr == 0) PG8_BAR;
        E(acc, cur, wr, wc, fr, fq);
        if (!has_next) break;
#pragma unroll
        for (int a = 0; a < 2; ++a)
#pragma unroll
            for (int b = 0; b < 2; ++b)
#pragma unroll
                for (int m = 0; m < 4; ++m)
#pragma unroll
                    for (int n = 0; n < 2; ++n) acc[a][b][m][n] = (f32x4){0.f, 0.f, 0.f, 0.f};
        cur = nxt; cA = nA; cB = nB; ++ui;
        if constexpr (GA) {
#pragma unroll
            for (int h = 0; h < 2; ++h)
#pragma unroll
                for (int i = 0; i < 2; ++i) gcur[h][i] = gnxt[h][i]; }
        if (wr == 1) PG8_BAR;
    }
    PG8_WAIT_V(0);
    PG8_BAR;
#undef PG8_SA
#undef PG8_SB
#undef PG8_STAGE
#undef PG8_STAGE_A
#undef PG8_LDA
#undef PG8_LDB
#undef PG8_MMA
#undef PG8_WAIT_V
#undef PG8_WAIT_L
#undef PG8_BAR
#undef PG8_SCHED
}
}
#define GAS __attribute__((address_space(1)))
#define LAS __attribute__((address_space(3)))
typedef unsigned short bf16;
typedef unsigned v4u __attribute__((ext_vector_type(4)));
typedef unsigned v2u __attribute__((ext_vector_type(2)));
typedef float f32x4 __attribute__((ext_vector_type(4)));
typedef float f32x2 __attribute__((ext_vector_type(2)));
typedef short bf16x8 __attribute__((ext_vector_type(8)));
typedef short bf16x4 __attribute__((ext_vector_type(4)));
typedef GAS unsigned gu32;
#define RLX_AGENT __ATOMIC_RELAXED, __HIP_MEMORY_SCOPE_AGENT
#define LDS_WAIT() asm volatile("s_waitcnt lgkmcnt(0)" ::: "memory")
#define VM_WAIT() asm volatile("s_waitcnt vmcnt(0)" ::: "memory")
#define LBAR() do { asm volatile("s_waitcnt lgkmcnt(0)" ::: "memory"); __builtin_amdgcn_s_barrier(); asm volatile("" ::: "memory"); } while (0)
__device__ __forceinline__ unsigned f2bf(float f) { return pg8::cvt_pk_bf16(f, 0.f) & 0xffffu; }
__device__ __forceinline__ unsigned pk2(float lo, float hi) { return pg8::cvt_pk_bf16(lo, hi); }
__device__ __forceinline__ float bf2f(unsigned h) { return __builtin_bit_cast(float, h << 16); }
__device__ __forceinline__ float bflo(unsigned w) { return __builtin_bit_cast(float, w << 16); }
__device__ __forceinline__ float bfhi(unsigned w) { return __builtin_bit_cast(float, w & 0xffff0000u); }
__device__ __forceinline__ float fexp(float x) { return __builtin_amdgcn_exp2f(x * 1.4426950408889634f); }
__device__ __forceinline__ float frcp(float x) { return __builtin_amdgcn_rcpf(x); }
__device__ __forceinline__ float fsigmoid(float x) { return frcp(1.f + fexp(-x)); }
__device__ __forceinline__ float fsilu(float x) { return x * fsigmoid(x); }
__device__ __forceinline__ float ftanh(float x) { const float e = fexp(2.f * x); return 1.f - 2.f * frcp(e + 1.f); }
__device__ __forceinline__ float fgelu_tanh(float x) { const float u = 0.7978845608028654f * (x + 0.044715f * x * x * x); return 0.5f * x * (1.f + ftanh(u)); }
__device__ __forceinline__ float wave_sum(float v) {
#pragma unroll
    for (int o = 1; o < 64; o <<= 1) v += __shfl_xor(v, o);
    return v;
}

#define XB_TMO      128
#define XB_XCNT(j)  (256  + 64 * (j))
#define XB_XSUB(j)  (1280 + 64 * (j))
#define XB_XGEN(j)  (2304 + 64 * (j))
#define XB_TOP      3328
#define XB_TOPGEN   3392
#define XCD_BAR_WORDS 3456
#define XB_SPIN_CAP (1u << 22)
__device__ __forceinline__ unsigned xb_ld(unsigned* p)              { return __hip_atomic_load(p, __ATOMIC_RELAXED, __HIP_MEMORY_SCOPE_AGENT); }
__device__ __forceinline__ unsigned xb_add(unsigned* p, unsigned v) { return __hip_atomic_fetch_add(p, v, __ATOMIC_RELAXED, __HIP_MEMORY_SCOPE_AGENT); }
__device__ __forceinline__ unsigned xb_xcc_id() { return (unsigned)__builtin_amdgcn_s_getreg((3 << 11) | 20) & 0xFu; }
#define XB_SPIN(cond, bar) do { unsigned _sp = 0; while (cond) { __builtin_amdgcn_s_sleep(1); \
    if ((++_sp & 255u) == 0u) { if (xb_ld(&(bar)[XB_TMO])) break; if (_sp > XB_SPIN_CAP) { atomicAdd(&(bar)[XB_TMO], 1u); break; } } } } while (0)
struct XcdBarrier { unsigned* bar; unsigned x; volatile LAS unsigned* st; };
__device__ __forceinline__ XcdBarrier xcd_barrier_post(unsigned* bar, volatile LAS unsigned* st) {
    XcdBarrier b; b.bar = bar; b.x = xb_xcc_id(); b.st = st;
    if (threadIdx.x == 0) (void)xb_add(&bar[XB_XCNT(b.x)], 1u);
    return b;
}
__device__ __forceinline__ void xcd_barrier_complete(unsigned* bar, unsigned x, unsigned& nloc, unsigned& nx) {
    const unsigned G = gridDim.x * gridDim.y * gridDim.z;
    unsigned sum, cnt, mine, sp = 0u;
    for (;;) {
        sum = 0u; cnt = 0u; mine = 0u;
#pragma unroll
        for (unsigned j = 0; j < 16; ++j) { const unsigned c = xb_ld(&bar[XB_XCNT(j)]); sum += c; cnt += (c > 0u) ? 1u : 0u; mine = (j == x) ? c : mine; }
        if (sum == G) break;
        __builtin_amdgcn_s_sleep(1);
        if ((++sp & 255u) == 0u) { if (xb_ld(&bar[XB_TMO])) break; if (sp > XB_SPIN_CAP) { atomicAdd(&bar[XB_TMO], 1u); break; } }
    }
    nloc = mine > 0u ? mine : 1u; nx = cnt > 0u ? cnt : 1u;
}
__device__ __forceinline__ void xcd_barrier(const XcdBarrier& b) {
    asm volatile("s_waitcnt vmcnt(0)" ::: "memory");
    __syncthreads();
    if (threadIdx.x == 0) {
        unsigned* bar = b.bar;
        __builtin_amdgcn_s_waitcnt(0);
        unsigned nloc = b.st[0], nx = b.st[1];
        if (nloc == 0u) { xcd_barrier_complete(bar, b.x, nloc, nx); b.st[0] = nloc; b.st[1] = nx; }
        const unsigned old = xb_add(&bar[XB_XSUB(b.x)], 1u);
        const unsigned gen = old / nloc;
        if (old + 1u == (gen + 1u) * nloc) {
            __builtin_amdgcn_fence(__ATOMIC_RELEASE, "agent");
            asm volatile("s_waitcnt vmcnt(0)" ::: "memory");
            const unsigned og = xb_add(&bar[XB_TOP], 1u);
            const unsigned tg = og / nx;
            if (og + 1u == (tg + 1u) * nx) xb_add(&bar[XB_TOPGEN], 1u);
            else XB_SPIN(xb_ld(&bar[XB_TOPGEN]) == tg, bar);
            __builtin_amdgcn_fence(__ATOMIC_ACQUIRE, "agent");
            xb_add(&bar[XB_XGEN(b.x)], 1u);
            asm volatile("s_waitcnt vmcnt(0)" ::: "memory");
        } else {
            XB_SPIN(xb_ld(&bar[XB_XGEN(b.x)]) == gen, bar);
            __builtin_amdgcn_fence(__ATOMIC_ACQUIRE, "agent");
            asm volatile("s_waitcnt vmcnt(0)" ::: "memory");
        }
    }
    __syncthreads();
}

template <int KSTEPS>
__device__ __forceinline__ f32x4 mm_tile(const LAS bf16* Am, int lda, const LAS bf16* Bn, int ldb, int m0, int n0, f32x4 acc, int fr, int fq) {
    const LAS bf16* ap = Am + (m0 + fr) * lda + fq * 8;
    const LAS bf16* bp = Bn + (n0 + fr) * ldb + fq * 8;
#pragma unroll
    for (int ks = 0; ks < KSTEPS; ++ks) {
        const bf16x8 a = *(const LAS bf16x8*)(ap + ks * 32);
        const bf16x8 b = *(const LAS bf16x8*)(bp + ks * 32);
        acc = __builtin_amdgcn_mfma_f32_16x16x32_bf16(b, a, acc, 0, 0, 0);
    }
    return acc;
}
__device__ __forceinline__ v2u pk4(f32x4 v) { v2u r; r.x = pk2(v[0], v[1]); r.y = pk2(v[2], v[3]); return r; }
constexpr int NWAVES = 8, NTHREADS = 512;
constexpr int BATCH = 2, T = 8192, D = 1024, M = BATCH * T;
constexpr int MIX_IN = 3072, DFF = 2816, NEXP = 8, DFE = 1408, NH = 16, HS = 64;
constexpr int NRW = 3328;
constexpr int XG_ROWS = 34816;
constexpr float RMS_EPS = 1e-6f, LN_EPS = 1e-5f, GN_EPS = 64e-5f;
constexpr size_t MiB = 1u << 20, KiB = 1024;
constexpr size_t WS_CTL = 0, CTL_ZERO_BYTES = 1 * MiB;
constexpr size_t WS_WSM = 1 * MiB;
constexpr size_t WS_LB = 1 * MiB + 128 * KiB;
constexpr size_t WS_WIN = 2 * MiB, WS_WOUT = 8 * MiB, WS_WGU = 10 * MiB, WS_WD = 21 * MiB, WS_WR = 26 * MiB + 512 * KiB, WS_WO = 39 * MiB + 512 * KiB, WS_W2T = 41 * MiB + 512 * KiB;
constexpr size_t WS_XN = 42 * MiB;
constexpr size_t WS_Z = 74 * MiB;
constexpr size_t WS_HGI = 170 * MiB, WS_HGS = 202 * MiB, WS_HGD = 234 * MiB;
constexpr size_t WS_HF = 74 * MiB;
constexpr size_t WS_A2 = 42 * MiB;
constexpr size_t WS_R = 106 * MiB, WS_K = 138 * MiB, WS_V = 170 * MiB, WS_LR = 202 * MiB, WS_RKS = 210 * MiB, WS_S0 = 211 * MiB;
constexpr size_t WS_OMT = 42 * MiB, WS_YL = 74 * MiB;
constexpr size_t WS_WEGU = 2 * MiB, WS_WED = 46 * MiB, WS_XG = 68 * MiB, WS_HE = 136 * MiB, WS_XN3 = 68 * MiB, WS_ROUTE = 240 * MiB;
constexpr size_t WS_END = 256 * MiB;
constexpr size_t RT_E = 0, RT_POS = 128 * KiB, RT_W = 256 * KiB, RT_P2T = 512 * KiB, RT_P2W = 1024 * KiB;
constexpr int CW_BAR = 4096;
constexpr int CW_CNT = 64;
constexpr int LDS_BYTES = 155648, MISC_OFF = 153600;
struct Frame {
    LAS unsigned char* lds;
    int tid, lane, wave, vcu, G;
    const float* in[37];
    float* out;
    unsigned char* ws;
};
template <class Tp> __device__ __forceinline__ Tp* wsp(const Frame& F, size_t off) { return (Tp*)(F.ws + off); }
__device__ __forceinline__ bf16* HBp(const Frame& F) { return (bf16*)F.out + (size_t)16384 * 1024; }

enum { I_X = 0, I_NMG, I_NFG, I_NOG, I_WIN, I_WOUT, I_GNG, I_GWS, I_GBS, I_LBL, I_ONG, I_FG, I_FU, I_FD,
       I_RMIX, I_RWR, I_RWK, I_RWV, I_RWO, I_RW0, I_RW1, I_RW2, I_RA0, I_RA1, I_RA2, I_RG1, I_RG2, I_RKK, I_RKA, I_RRK, I_RLG, I_RLB,
       I_MR, I_MRB, I_MG, I_MU, I_MD };

struct Job { const float* src; int K, N; bf16* dst; int ldd, rowbase, kofs; const float* scale; int ilv; };
__device__ __forceinline__ int job_items(const Job& j) { return (j.K / 64) * (j.N / 32); }
__device__ __forceinline__ void conv_item(const Job& J, int item, LAS float* scr, int lane) {
    const int nblk = J.N / 32, kb = item / nblk, nb = item % nblk, k0 = 64 * kb, n0 = 32 * nb;
    const int drow0 = J.ilv ? ((n0 >> 7) * 256 + (J.ilv - 1) * 128 + (n0 & 127)) : (J.rowbase + n0);
    float tmp[32];
#pragma unroll
    for (int i = 0; i < 32; ++i) { const int kk = 2 * i + (lane >> 5); tmp[i] = __builtin_nontemporal_load(J.src + (size_t)(k0 + kk) * J.N + n0 + (lane & 31)); }
    if (J.scale) {
#pragma unroll
        for (int i = 0; i < 32; ++i) tmp[i] *= J.scale[k0 + 2 * i + (lane >> 5)]; }
#pragma unroll
    for (int i = 0; i < 32; ++i) scr[(2 * i + (lane >> 5)) * 33 + (lane & 31)] = tmp[i];
    LDS_WAIT(); asm volatile("" ::: "memory");
    const int c = lane & 7;
#pragma unroll
    for (int j = 0; j < 4; ++j) { const int n = (lane >> 3) + 8 * j; const LAS float* s = scr + (8 * c) * 33 + n;
        v4u o; o.x = pk2(s[0 * 33], s[1 * 33]); o.y = pk2(s[2 * 33], s[3 * 33]); o.z = pk2(s[4 * 33], s[5 * 33]); o.w = pk2(s[6 * 33], s[7 * 33]);
        *(v4u*)(J.dst + (size_t)(drow0 + n) * J.ldd + J.kofs + k0 + 8 * c) = o; }
    LDS_WAIT(); asm volatile("" ::: "memory");
}
__device__ __forceinline__ Job p0_job(const Frame& F, int j) {
    Job J; J.scale = nullptr; J.ilv = 0; J.rowbase = 0; J.kofs = 0;
    const float* mix = F.in[I_RMIX];
    switch (j) {
    case 0: J.src = F.in[I_WIN]; J.K = 1024; J.N = 3072; J.dst = wsp<bf16>(F, WS_WIN); J.ldd = 1024; break;
    case 1: J.src = F.in[I_WOUT]; J.K = 1024; J.N = 1024; J.dst = wsp<bf16>(F, WS_WOUT); J.ldd = 1024; break;
    case 2: J.src = F.in[I_FG]; J.K = 1024; J.N = DFF; J.dst = wsp<bf16>(F, WS_WGU); J.ldd = 1024; J.ilv = 1; break;
    case 3: J.src = F.in[I_FU]; J.K = 1024; J.N = DFF; J.dst = wsp<bf16>(F, WS_WGU); J.ldd = 1024; J.ilv = 2; break;
    case 4: J.src = F.in[I_FD]; J.K = DFF; J.N = 1024; J.dst = wsp<bf16>(F, WS_WD); J.ldd = DFF; break;
    case 5: J.src = F.in[I_RWO]; J.K = 1024; J.N = 1024; J.dst = wsp<bf16>(F, WS_WO); J.ldd = 1024; break;
    case 6: J.src = F.in[I_RW2]; J.K = 64; J.N = 1024; J.dst = wsp<bf16>(F, WS_W2T); J.ldd = 64; break;
    case 7: J.src = F.in[I_RA2]; J.K = 64; J.N = 1024; J.dst = wsp<bf16>(F, WS_W2T) + 1024 * 64; J.ldd = 64; break;
    case 8: J.src = F.in[I_RG2]; J.K = 128; J.N = 1024; J.dst = wsp<bf16>(F, WS_W2T) + 2 * 1024 * 64; J.ldd = 128; break;
    default: {
        const int q = (j - 9) >> 1, sc = (j - 9) & 1;
        J.K = 1024; J.dst = wsp<bf16>(F, WS_WR); J.ldd = 2048; J.kofs = sc ? 1024 : 0;
        if (q == 0) { J.src = F.in[I_RWR]; J.N = 1024; J.rowbase = 0; if (sc) J.scale = mix + 0 * 1024; }
        else if (q == 1) { J.src = F.in[I_RWK]; J.N = 1024; J.rowbase = 1024; if (sc) J.scale = mix + 2 * 1024; }
        else if (q == 2) { J.src = F.in[I_RWV]; J.N = 1024; J.rowbase = 2048; if (sc) J.scale = mix + 3 * 1024; }
        else if (q == 3) { J.src = F.in[I_RW1]; J.N = 64; J.rowbase = 3072; if (sc) J.scale = mix + 1 * 1024; }
        else if (q == 4) { J.src = F.in[I_RA1]; J.N = 64; J.rowbase = 3136; if (sc) J.scale = mix + 4 * 1024; }
        else { J.src = F.in[I_RG1]; J.N = 128; J.rowbase = 3200; if (sc) J.scale = mix + 5 * 1024; }
    } }
    return J;
}
constexpr int P0_NJOBS = 21;
__device__ __forceinline__ Job moe_job(const Frame& F, int j) {
    Job J; J.scale = nullptr; J.rowbase = 0; J.kofs = 0; J.ilv = 0;
    const int e = j / 3, w = j % 3;
    if (w < 2) { J.src = F.in[w == 0 ? I_MG : I_MU] + (size_t)e * 1024 * DFE; J.K = 1024; J.N = DFE; J.dst = wsp<bf16>(F, WS_WEGU) + (size_t)e * 2 * DFE * 1024; J.ldd = 1024; J.ilv = w + 1; }
    else { J.src = F.in[I_MD] + (size_t)e * DFE * 1024; J.K = DFE; J.N = 1024; J.dst = wsp<bf16>(F, WS_WED) + (size_t)e * 1024 * DFE; J.ldd = DFE; }
    return J;
}
__device__ __forceinline__ void rms_row(const float* xrow, const float* g, int lane, f32x4 (&v)[4]) {
    const f32x4* xr = (const f32x4*)xrow + lane; float s = 0.f;
#pragma unroll
    for (int j = 0; j < 4; ++j) { v[j] = xr[64 * j]; s += (v[j].x * v[j].x + v[j].y * v[j].y) + (v[j].z * v[j].z + v[j].w * v[j].w); }
    const float rs = 1.f / sqrtf(wave_sum(s) * (1.f / D) + RMS_EPS);
    const f32x4* gr = (const f32x4*)g + lane;
#pragma unroll
    for (int j = 0; j < 4; ++j) v[j] = v[j] * rs * gr[64 * j];
}
__device__ __forceinline__ void load_row_bf16(const bf16* hrow, int lane, f32x4 (&v)[4]) {
    const v2u* hr = (const v2u*)hrow + lane;
#pragma unroll
    for (int j = 0; j < 4; ++j) { const v2u a = hr[64 * j]; v[j] = (f32x4){bflo(a.x), bfhi(a.x), bflo(a.y), bfhi(a.y)}; }
}
__device__ __forceinline__ void rms_row_h(const bf16* hrow, const float* g, int lane, f32x4 (&v)[4]) {
    load_row_bf16(hrow, lane, v); float s = 0.f;
#pragma unroll
    for (int j = 0; j < 4; ++j) s += (v[j].x * v[j].x + v[j].y * v[j].y) + (v[j].z * v[j].z + v[j].w * v[j].w);
    const float rs = 1.f / sqrtf(wave_sum(s) * (1.f / D) + RMS_EPS);
    const f32x4* gr = (const f32x4*)g + lane;
#pragma unroll
    for (int j = 0; j < 4; ++j) v[j] = v[j] * rs * gr[64 * j];
}
__device__ __forceinline__ void store_row_bf16(bf16* orow, int lane, const f32x4 (&v)[4]) {
    v2u* o8 = (v2u*)orow + lane;
#pragma unroll
    for (int j = 0; j < 4; ++j) o8[64 * j] = pk4(v[j]);
}
__device__ __forceinline__ void run_jobs(const Frame& F, bool moe) {
    LAS float* scr = (LAS float*)(F.lds + F.wave * 16384);
    const int gw = F.vcu * NWAVES + F.wave, NGW = F.G * NWAVES;
    const int njobs = moe ? 24 : P0_NJOBS;
    int base = 0;
    for (int j = 0; j < njobs; ++j) {
        const Job J = moe ? moe_job(F, j) : p0_job(F, j);
        const int n = job_items(J);
        int it = (gw - base % NGW + NGW) % NGW;
        for (; it < n; it += NGW) conv_item(J, it, scr, F.lane);
        base += n;
    }
}
__device__ __forceinline__ void p0_prologue(const Frame& F) {
    run_jobs(F, false);
    const int gt = F.vcu * NTHREADS + F.tid, NGT = F.G * NTHREADS;
    { const float* ws = F.in[I_GWS]; bf16* o = wsp<bf16>(F, WS_WSM);
      for (int i = gt; i < 4 * 128 * 128; i += NGT) { const int t = (i >> 7) & 127, s = i & 127; o[i] = (bf16)f2bf(s <= t ? ws[i] : 0.f); } }
    { const float* l = F.in[I_LBL]; float* o = wsp<float>(F, WS_LB);
      for (int i = gt; i < 512; i += NGT) { const float a = l[i], b = l[512 + i], mx = fmaxf(a, b), ea = expf(a - mx), eb = expf(b - mx); o[i] = ea / (ea + eb); } }
    const int gw = F.vcu * NWAVES + F.wave, NGW = F.G * NWAVES;
    bf16* XN = wsp<bf16>(F, WS_XN);
    for (int m = gw; m < M; m += NGW) { f32x4 v[4]; rms_row(F.in[I_X] + (size_t)m * D, F.in[I_NMG], F.lane, v); store_row_bf16(XN + (size_t)m * D, F.lane, v); }
}
namespace epi {
using pg8::Unit; using pg8::HALF; using pg8::BM;
typedef float f32x4 __attribute__((ext_vector_type(4)));
struct MixIn {
    static constexpr bool PERM = true;
    bf16* Z; const float* lb;
    __device__ __forceinline__ void operator()(const f32x4 (&acc)[2][2][4][2], const Unit& u, int wr, int wc, int fr, int fq) const {
        const int seg = u.pn >> 1;
        const int row0 = u.pm * BM + wr * 64 + fr, col0 = u.pn * BM + wc * 32 + 8 * fq;
#pragma unroll
        for (int ai = 0; ai < 2; ++ai)
#pragma unroll
            for (int m = 0; m < 4; ++m) { bf16* rowp = Z + (size_t)(row0 + ai * HALF + m * 16) * MIX_IN + col0;
#pragma unroll
                for (int bj = 0; bj < 2; ++bj) { float v[8];
#pragma unroll
                    for (int i = 0; i < 4; ++i) { v[i] = acc[ai][bj][m][0][i]; v[4 + i] = acc[ai][bj][m][1][i]; }
                    if (seg < 2) {
#pragma unroll
                        for (int i = 0; i < 8; ++i) v[i] = fgelu_tanh(v[i]);
                    } else if (seg == 2 || seg == 5) {
#pragma unroll
                        for (int i = 0; i < 8; ++i) v[i] = fsilu(v[i]);
                    } else if (seg == 3) {
                        const float* lbp = lb + (col0 + bj * HALF - 1536);
#pragma unroll
                        for (int i = 0; i < 8; ++i) { const float l = lbp[i]; v[i] = __logf(l + (1.f - l) * fsigmoid(v[i])); }
                    }
                    v4u w; w.x = pk2(v[0], v[1]); w.y = pk2(v[2], v[3]); w.z = pk2(v[4], v[5]); w.w = pk2(v[6], v[7]);
                    *(v4u*)(rowp + bj * HALF) = w; } }
    }
};
template <bool XF> struct Resid {
    static constexpr bool PERM = true;
    const float* xf; bf16* H;
    __device__ __forceinline__ void operator()(const f32x4 (&acc)[2][2][4][2], const Unit& u, int wr, int wc, int fr, int fq) const {
        const int row0 = u.pm * BM + wr * 64 + fr, col0 = u.pn * BM + wc * 32 + 8 * fq;
#pragma unroll
        for (int ai = 0; ai < 2; ++ai)
#pragma unroll
            for (int m = 0; m < 4; ++m) { const size_t off = (size_t)(row0 + ai * HALF + m * 16) * D + col0;
#pragma unroll
                for (int bj = 0; bj < 2; ++bj) { const size_t p = off + bj * HALF; f32x4 v0 = acc[ai][bj][m][0], v1 = acc[ai][bj][m][1];
                    if (XF) { v0 = v0 + *(const f32x4*)(xf + p); v1 = v1 + *(const f32x4*)(xf + p + 4); }
                    else { const v4u b = *(const v4u*)(H + p); v0[0] += bflo(b.x); v0[1] += bfhi(b.x); v0[2] += bflo(b.y); v0[3] += bfhi(b.y); v1[0] += bflo(b.z); v1[1] += bfhi(b.z); v1[2] += bflo(b.w); v1[3] += bfhi(b.w); }
                    v4u w; w.x = pk2(v0[0], v0[1]); w.y = pk2(v0[2], v0[3]); w.z = pk2(v1[0], v1[1]); w.w = pk2(v1[2], v1[3]);
                    *(v4u*)(H + p) = w; } }
    }
};
struct SwiGlu {
    static constexpr bool PERM = true;
    bf16* H; int ld; const float* rowscale;
    __device__ __forceinline__ void operator()(const f32x4 (&acc)[2][2][4][2], const Unit& u, int wr, int wc, int fr, int fq) const {
        const int row0 = u.pm * BM + wr * 64 + fr, col0 = u.pn * HALF + wc * 32 + 8 * fq;
#pragma unroll
        for (int ai = 0; ai < 2; ++ai)
#pragma unroll
            for (int m = 0; m < 4; ++m) { const int row = row0 + ai * HALF + m * 16; const float sc = rowscale ? rowscale[row + u.aux] : 1.f; float v[8];
#pragma unroll
                for (int i = 0; i < 4; ++i) { v[i] = fsilu(acc[ai][0][m][0][i]) * acc[ai][1][m][0][i] * sc; v[4 + i] = fsilu(acc[ai][0][m][1][i]) * acc[ai][1][m][1][i] * sc; }
                v4u w; w.x = pk2(v[0], v[1]); w.y = pk2(v[2], v[3]); w.z = pk2(v[4], v[5]); w.w = pk2(v[6], v[7]);
                *(v4u*)(H + (size_t)row * ld + col0) = w; }
    }
};
struct RwkvProj {
    static constexpr bool PERM = true;
    bf16* R; size_t split_stride; bf16* LR;
    __device__ __forceinline__ void operator()(const f32x4 (&acc)[2][2][4][2], const Unit& u, int wr, int wc, int fr, int fq) const {
        const int row0 = u.pm * BM + wr * 64 + fr;
        const bool lora = (u.pn == 12);
        bf16* base = lora ? LR : (R + (size_t)(u.pn >> 2) * split_stride);
        const int ld = lora ? 256 : D;
        const int col0 = (lora ? 0 : (u.pn & 3) * BM) + wc * 32 + 8 * fq;
#pragma unroll
        for (int ai = 0; ai < 2; ++ai)
#pragma unroll
            for (int m = 0; m < 4; ++m) { bf16* rowp = base + (size_t)(row0 + ai * HALF + m * 16) * ld + col0;
#pragma unroll
                for (int bj = 0; bj < 2; ++bj) { float v[8];
#pragma unroll
                    for (int i = 0; i < 4; ++i) { v[i] = acc[ai][bj][m][0][i]; v[4 + i] = acc[ai][bj][m][1][i]; }
                    if (lora) {
                        if (bj == 1) {
#pragma unroll
                            for (int i = 0; i < 8; ++i) v[i] = fsigmoid(v[i]);
                        } else if (wc < 2) {
#pragma unroll
                            for (int i = 0; i < 8; ++i) v[i] = ftanh(v[i]);
                        }
                    }
                    v4u w; w.x = pk2(v[0], v[1]); w.y = pk2(v[2], v[3]); w.z = pk2(v[4], v[5]); w.w = pk2(v[6], v[7]);
                    *(v4u*)(rowp + bj * HALF) = w; } }
    }
};
struct StoreBf16 {
    static constexpr bool PERM = true;
    bf16* O; int ld;
    __device__ __forceinline__ void operator()(const f32x4 (&acc)[2][2][4][2], const Unit& u, int wr, int wc, int fr, int fq) const {
        const int row0 = u.pm * BM + wr * 64 + fr, col0 = u.pn * BM + wc * 32 + 8 * fq;
#pragma unroll
        for (int ai = 0; ai < 2; ++ai)
#pragma unroll
            for (int m = 0; m < 4; ++m) { bf16* rowp = O + (size_t)(row0 + ai * HALF + m * 16) * ld + col0;
#pragma unroll
                for (int bj = 0; bj < 2; ++bj) { const f32x4 v0 = acc[ai][bj][m][0], v1 = acc[ai][bj][m][1];
                    v4u w; w.x = pk2(v0[0], v0[1]); w.y = pk2(v0[2], v0[3]); w.z = pk2(v1[0], v1[1]); w.w = pk2(v1[2], v1[3]);
                    *(v4u*)(rowp + bj * HALF) = w; } }
    }
};
}
constexpr int HG_L = 64, HG_NC = T / HG_L;
__device__ __forceinline__ void gmlp_unit(const Frame& F, int unit) {
    const int g = unit & 3, n = (unit >> 2) & 63, b = unit >> 8;
    const int m0 = b * T + n * 128;
    LAS bf16* WM = (LAS bf16*)F.lds; LAS bf16* VNT = (LAS bf16*)(F.lds + 34816);
    const bf16* Z = wsp<bf16>(F, WS_Z); bf16* Y = wsp<bf16>(F, WS_XN);
    const bf16* wsm = wsp<bf16>(F, WS_WSM) + g * 16384;
    const float* gng = F.in[I_GNG] + g * 128;
#pragma unroll
    for (int i = 0; i < 4; ++i) { const int id = F.tid + 512 * i, row = id >> 4, cc = id & 15;
        *(LAS v4u*)(WM + row * 136 + cc * 8) = *(const v4u*)(wsm + row * 128 + cc * 8); }
#pragma unroll
    for (int i = 0; i < 4; ++i) { const int id = F.tid + 512 * i, s = id >> 4, cc = id & 15;
        const v4u raw = *(const v4u*)(Z + (size_t)(m0 + s) * MIX_IN + 512 + g * 128 + cc * 8);
        float v[8]; v[0] = bflo(raw.x); v[1] = bfhi(raw.x); v[2] = bflo(raw.y); v[3] = bfhi(raw.y); v[4] = bflo(raw.z); v[5] = bfhi(raw.z); v[6] = bflo(raw.w); v[7] = bfhi(raw.w);
        float sm = 0.f;
#pragma unroll
        for (int j = 0; j < 8; ++j) sm += v[j];
        sm += __shfl_xor(sm, 1); sm += __shfl_xor(sm, 2); sm += __shfl_xor(sm, 4); sm += __shfl_xor(sm, 8);
        const float mu = sm * (1.f / 128.f); float sq = 0.f;
#pragma unroll
        for (int j = 0; j < 8; ++j) { v[j] -= mu; sq += v[j] * v[j]; }
        sq += __shfl_xor(sq, 1); sq += __shfl_xor(sq, 2); sq += __shfl_xor(sq, 4); sq += __shfl_xor(sq, 8);
        const float rstd = 1.f / sqrtf(sq * (1.f / 128.f) + LN_EPS);
#pragma unroll
        for (int j = 0; j < 8; ++j) VNT[(cc * 8 + j) * 136 + s] = (bf16)f2bf(v[j] * rstd * gng[cc * 8 + j]); }
    LBAR();
    const int fr = F.lane & 15, fq = F.lane >> 4, t0 = 16 * F.wave, nks = (F.wave >> 1) + 1;
    f32x4 acc[8];
#pragma unroll
    for (int j = 0; j < 8; ++j) acc[j] = (f32x4){0.f, 0.f, 0.f, 0.f};
    for (int ks = 0; ks < nks; ++ks) {
        const bf16x8 a = *(const LAS bf16x8*)(WM + (t0 + fr) * 136 + ks * 32 + fq * 8);
#pragma unroll
        for (int j = 0; j < 8; ++j) { const bf16x8 bb = *(const LAS bf16x8*)(VNT + (16 * j + fr) * 136 + ks * 32 + fq * 8);
            acc[j] = __builtin_amdgcn_mfma_f32_16x16x32_bf16(bb, a, acc[j], 0, 0, 0); }
    }
    const int t = t0 + fr; const float bs = F.in[I_GBS][g * 128 + t];
    const bf16* zr = Z + (size_t)(m0 + t) * MIX_IN + g * 128; bf16* yr = Y + (size_t)(m0 + t) * D + g * 128;
#pragma unroll
    for (int j = 0; j < 8; ++j) { const int c = 16 * j + 4 * fq; const v2u ur = *(const v2u*)(zr + c);
        f32x4 o; o[0] = bflo(ur.x) * (acc[j][0] + bs); o[1] = bfhi(ur.x) * (acc[j][1] + bs); o[2] = bflo(ur.y) * (acc[j][2] + bs); o[3] = bfhi(ur.y) * (acc[j][3] + bs);
        *(v2u*)(yr + c) = pk4(o); }
    LBAR();
}
__device__ __forceinline__ void hg_load_lf(const bf16* Z, int m0, int h, int k, int tq, float (&lf)[16]) {
#pragma unroll
    for (int i = 0; i < 16; ++i) lf[i] = bf2f(Z[(size_t)(m0 + 16 * tq + i) * MIX_IN + 1536 + h * 128 + k]);
}
struct HgRaw2 { v4u a[2], b[2]; };
struct HgRaw3 { v4u a[2], b[2], c[2]; };
__device__ __forceinline__ void hg_tile_load(const bf16* Z, int m0, int col0, int tid, v4u (&x)[2]) {
#pragma unroll
    for (int i = 0; i < 2; ++i) { const int id = tid + 512 * i, row = id >> 4, c2 = id & 15; x[i] = *(const v4u*)(Z + (size_t)(m0 + row) * MIX_IN + col0 + c2 * 8); }
}
__device__ __forceinline__ void hg_tile_store(LAS bf16* dst, int tid, const v4u (&x)[2]) {
#pragma unroll
    for (int i = 0; i < 2; ++i) { const int id = tid + 512 * i, row = id >> 4, c2 = id & 15; *(LAS v4u*)(dst + row * 136 + c2 * 8) = x[i]; }
}
__device__ __forceinline__ void hgrn_pre_phase(const Frame& F) {
    LAS bf16* KDT = (LAS bf16*)F.lds; LAS bf16* VT = (LAS bf16*)(F.lds + 18432); LAS float* PART = (LAS float*)(F.lds + 36864);
    LAS bf16* LFR = (LAS bf16*)(F.lds + 40960); LAS bf16* VR = (LAS bf16*)(F.lds + 58368);
    const bf16* Z = wsp<bf16>(F, WS_Z);
    const int k = F.tid & 127, tq = F.tid >> 7;
    HgRaw2 raw;
    if (F.vcu < 1024) { const int u = F.vcu, c = u & 127, h = (u >> 7) & 3, b = u >> 9, m0 = b * T + c * HG_L; hg_tile_load(Z, m0, 1536 + h * 128, F.tid, raw.a); hg_tile_load(Z, m0, 2048 + h * 128, F.tid, raw.b); }
    for (int unit = F.vcu; unit < 1024; unit += F.G) {
        hg_tile_store(LFR, F.tid, raw.a); hg_tile_store(VR, F.tid, raw.b);
        if (unit + F.G < 1024) { const int u = unit + F.G, c = u & 127, h = (u >> 7) & 3, b = u >> 9, m0 = b * T + c * HG_L; hg_tile_load(Z, m0, 1536 + h * 128, F.tid, raw.a); hg_tile_load(Z, m0, 2048 + h * 128, F.tid, raw.b); }
        LBAR();
        float lf[16], pre[16]; float run = 0.f;
#pragma unroll
        for (int i = 0; i < 16; ++i) { lf[i] = bf2f(LFR[(16 * tq + i) * 136 + k]); run += lf[i]; pre[i] = run; }
        PART[tq * 128 + k] = run;
        LBAR();
        float off = 0.f, bend = 0.f;
#pragma unroll
        for (int q = 0; q < 4; ++q) { const float p = PART[q * 128 + k]; bend += p; off += (q < tq) ? p : 0.f; }
        unsigned kd[8], vv[8];
#pragma unroll
        for (int i = 0; i < 8; ++i) {
            const float k0 = (1.f - fexp(lf[2 * i])) * fexp(bend - (off + pre[2 * i])), k1 = (1.f - fexp(lf[2 * i + 1])) * fexp(bend - (off + pre[2 * i + 1]));
            kd[i] = pk2(k0, k1);
            const unsigned v0 = VR[(16 * tq + 2 * i) * 136 + k], v1 = VR[(16 * tq + 2 * i + 1) * 136 + k];
            vv[i] = v0 | (v1 << 16);
        }
        *(LAS v4u*)(KDT + k * 72 + 16 * tq) = (v4u){kd[0], kd[1], kd[2], kd[3]}; *(LAS v4u*)(KDT + k * 72 + 16 * tq + 8) = (v4u){kd[4], kd[5], kd[6], kd[7]};
        *(LAS v4u*)(VT + k * 72 + 16 * tq) = (v4u){vv[0], vv[1], vv[2], vv[3]}; *(LAS v4u*)(VT + k * 72 + 16 * tq + 8) = (v4u){vv[4], vv[5], vv[6], vv[7]};
        if (tq == 0) wsp<float>(F, WS_HGD)[unit * 128 + k] = fexp(bend);
        LBAR();
        const int fr = F.lane & 15, fq = F.lane >> 4, v0 = 16 * F.wave;
        bf16* inc = wsp<bf16>(F, WS_HGI) + (size_t)unit * 16384;
#pragma unroll
        for (int j = 0; j < 8; ++j) { f32x4 acc = (f32x4){0.f, 0.f, 0.f, 0.f};
            acc = mm_tile<2>(VT, 72, KDT, 72, v0, 16 * j, acc, fr, fq);
            *(v2u*)(inc + (v0 + fr) * 128 + 16 * j + 4 * fq) = pk4(acc); }
        LBAR();
    }
}
__device__ __forceinline__ void hgrn_scan(const Frame& F) {
    const int nwg_scan = (F.G > 128) ? 64 : F.G;
    for (int gt = F.vcu * NTHREADS + F.tid; gt < 8 * 4096; gt += nwg_scan * NTHREADS) {
    const int bh = gt >> 12, e = (gt & 4095) * 4, k = e & 127;
    const bf16* __restrict__ inc = wsp<bf16>(F, WS_HGI) + (size_t)bh * HG_NC * 16384 + e;
    bf16* __restrict__ st = wsp<bf16>(F, WS_HGS) + (size_t)bh * HG_NC * 16384 + e;
    const float* __restrict__ dd = wsp<float>(F, WS_HGD) + (size_t)bh * HG_NC * 128 + k;
    f32x4 S = (f32x4){0.f, 0.f, 0.f, 0.f};
#pragma unroll 4
    for (int c = 0; c < HG_NC; ++c) {
        const v2u iv = *(const v2u*)(inc + (size_t)c * 16384); const f32x4 d = *(const f32x4*)(dd + c * 128);
        *(v2u*)(st + (size_t)c * 16384) = pk4(S);
        S[0] = d[0] * S[0] + bflo(iv.x); S[1] = d[1] * S[1] + bfhi(iv.x); S[2] = d[2] * S[2] + bflo(iv.y); S[3] = d[3] * S[3] + bfhi(iv.y);
    }
    }
}
__device__ __forceinline__ void hgrn_post_phase(const Frame& F) {
    LAS bf16* QD = (LAS bf16*)F.lds; LAS bf16* QP = (LAS bf16*)(F.lds + 17408); LAS bf16* KP = (LAS bf16*)(F.lds + 34816);
    LAS bf16* VT = (LAS bf16*)(F.lds + 52224); LAS bf16* SC = (LAS bf16*)(F.lds + 70656);
    LAS float* PART = (LAS float*)(F.lds + 79872); LAS float* RS = (LAS float*)(F.lds + 81920);
    LAS bf16* LFR = (LAS bf16*)(F.lds + 83968); LAS bf16* QR = (LAS bf16*)(F.lds + 101376); LAS bf16* VR = (LAS bf16*)(F.lds + 118784);
    const bf16* Z = wsp<bf16>(F, WS_Z); bf16* Y = wsp<bf16>(F, WS_XN);
    const int k = F.tid & 127, tq = F.tid >> 7;
    HgRaw3 raw;
    if (F.vcu < 1024) { const int u = F.vcu, c = u & 127, h = (u >> 7) & 3, b = u >> 9, m0 = b * T + c * HG_L;
        hg_tile_load(Z, m0, 1536 + h * 128, F.tid, raw.a); hg_tile_load(Z, m0, 1024 + h * 128, F.tid, raw.b); hg_tile_load(Z, m0, 2048 + h * 128, F.tid, raw.c); }
    for (int unit = F.vcu; unit < 1024; unit += F.G) {
    const int c = unit & 127, h = (unit >> 7) & 3, b = unit >> 9;
    const int m0 = b * T + c * HG_L;
    hg_tile_store(LFR, F.tid, raw.a); hg_tile_store(QR, F.tid, raw.b); hg_tile_store(VR, F.tid, raw.c);
    if (unit + F.G < 1024) { const int u = unit + F.G, c2 = u & 127, h2 = (u >> 7) & 3, b2 = u >> 9, m2 = b2 * T + c2 * HG_L;
        hg_tile_load(Z, m2, 1536 + h2 * 128, F.tid, raw.a); hg_tile_load(Z, m2, 1024 + h2 * 128, F.tid, raw.b); hg_tile_load(Z, m2, 2048 + h2 * 128, F.tid, raw.c); }
    LBAR();
    float lf[16], pre[16]; float run = 0.f;
#pragma unroll
    for (int i = 0; i < 16; ++i) { lf[i] = bf2f(LFR[(16 * tq + i) * 136 + k]); run += lf[i]; pre[i] = run; }
    PART[tq * 128 + k] = run;
    LBAR();
    const float p0 = PART[k], p1 = PART[128 + k], p2 = PART[256 + k];
    const float off = (tq > 0 ? p0 : 0.f) + (tq > 1 ? p1 : 0.f) + (tq > 2 ? p2 : 0.f), bm = p0 + p1;
    unsigned vv[8];
#pragma unroll
    for (int i = 0; i < 16; ++i) {
        const int t = 16 * tq + i; const float bb = off + pre[i];
        const float q = bf2f(QR[t * 136 + k]);
        const float kk = 1.f - fexp(lf[i]);
        const float dq = fminf(fmaxf(bb - bm, -80.f), 80.f);
        QD[t * 136 + k] = (bf16)f2bf(q * fexp(bb)); QP[t * 136 + k] = (bf16)f2bf(q * fexp(dq)); KP[t * 136 + k] = (bf16)f2bf(kk * fexp(-dq));
        const unsigned vr = VR[t * 136 + k];
        if (i & 1) vv[i >> 1] |= vr << 16; else vv[i >> 1] = vr;
    }
    *(LAS v4u*)(VT + k * 72 + 16 * tq) = (v4u){vv[0], vv[1], vv[2], vv[3]}; *(LAS v4u*)(VT + k * 72 + 16 * tq + 8) = (v4u){vv[4], vv[5], vv[6], vv[7]};
    LBAR();
    const int fr = F.lane & 15, fq = F.lane >> 4, t0 = 16 * (F.wave >> 1);
#pragma unroll
    for (int j = 0; j < 2; ++j) { const int s0 = 16 * (2 * (F.wave & 1) + j); f32x4 acc = (f32x4){0.f, 0.f, 0.f, 0.f};
        if (s0 <= t0) acc = mm_tile<4>(QP, 136, KP, 136, t0, s0, acc, fr, fq);
        const int t = t0 + fr, s = s0 + 4 * fq;
#pragma unroll
        for (int i = 0; i < 4; ++i) acc[i] = (s + i <= t) ? acc[i] : 0.f;
        *(LAS v2u*)(SC + t * 72 + s) = pk4(acc); }
    LBAR();
    const bf16* ST = wsp<bf16>(F, WS_HGS) + (size_t)unit * 16384;
    f32x4 o[4]; float ss = 0.f;
#pragma unroll
    for (int j = 0; j < 4; ++j) { const int v0 = 16 * (4 * (F.wave & 1) + j); f32x4 acc = (f32x4){0.f, 0.f, 0.f, 0.f};
        acc = mm_tile<2>(SC, 72, VT, 72, t0, v0, acc, fr, fq);
#pragma unroll
        for (int ks = 0; ks < 4; ++ks) { const bf16x8 a = *(const LAS bf16x8*)(QD + (t0 + fr) * 136 + ks * 32 + fq * 8);
            const bf16x8 bb = *(const bf16x8*)(ST + (v0 + fr) * 128 + ks * 32 + fq * 8);
            acc = __builtin_amdgcn_mfma_f32_16x16x32_bf16(bb, a, acc, 0, 0, 0); }
        o[j] = acc; ss += (acc[0] * acc[0] + acc[1] * acc[1]) + (acc[2] * acc[2] + acc[3] * acc[3]); }
    ss += __shfl_xor(ss, 16); ss += __shfl_xor(ss, 32);
    if (fq == 0) RS[(t0 + fr) * 2 + (F.wave & 1)] = ss;
    LBAR();
    const int t = t0 + fr; const float rstd = 1.f / sqrtf((RS[t * 2] + RS[t * 2 + 1]) * (1.f / 128.f) + RMS_EPS);
    const float* ong = F.in[I_ONG];
#pragma unroll
    for (int j = 0; j < 4; ++j) { const int v = 16 * (4 * (F.wave & 1) + j) + 4 * fq;
        const v2u sg = *(const v2u*)(Z + (size_t)(m0 + t) * MIX_IN + 2560 + h * 128 + v); const f32x4 gg = *(const f32x4*)(ong + v);
        f32x4 r; r[0] = o[j][0] * rstd * gg[0] * bflo(sg.x); r[1] = o[j][1] * rstd * gg[1] * bfhi(sg.x); r[2] = o[j][2] * rstd * gg[2] * bflo(sg.y); r[3] = o[j][3] * rstd * gg[3] * bfhi(sg.y);
        *(v2u*)(Y + (size_t)(m0 + t) * D + 512 + h * 128 + v) = pk4(r); }
    LBAR();
    }
}
constexpr int RW_L = 64, RW_NC = T / RW_L;
constexpr int SLOT = 9216;
constexpr int RW_MISC = 16 * SLOT;
#define RW_S(i) ((LAS bf16*)(F.lds + (i) * SLOT))
__device__ __forceinline__ float softplusf(float x) { return fmaxf(x, 0.f) + __logf(1.f + fexp(-fabsf(x))); }
__device__ __forceinline__ void wave_sum16(float (&v)[16], int lane) {
    const bool b5 = lane & 32, b4 = lane & 16, b3 = lane & 8, b2 = lane & 4;
    float w[8], x[4], y[2], z;
#pragma unroll
    for (int j = 0; j < 8; ++j) { const float send = b5 ? v[j] : v[j + 8], keep = b5 ? v[j + 8] : v[j]; w[j] = keep + __shfl_xor(send, 32); }
#pragma unroll
    for (int j = 0; j < 4; ++j) { const float send = b4 ? w[j] : w[j + 4], keep = b4 ? w[j + 4] : w[j]; x[j] = keep + __shfl_xor(send, 16); }
#pragma unroll
    for (int j = 0; j < 2; ++j) { const float send = b3 ? x[j] : x[j + 2], keep = b3 ? x[j + 2] : x[j]; y[j] = keep + __shfl_xor(send, 8); }
    { const float send = b2 ? y[0] : y[1], keep = b2 ? y[1] : y[0]; z = keep + __shfl_xor(send, 4); }
    z += __shfl_xor(z, 2); z += __shfl_xor(z, 1);
#pragma unroll
    for (int j = 0; j < 16; ++j) v[j] = __builtin_bit_cast(float, __builtin_amdgcn_readlane(__builtin_bit_cast(int, z), 4 * j));
}
struct RwRaw { v4u r, k, v, l0, l1; };
__device__ __forceinline__ void rwkv_pre_load(const Frame& F, int unit, RwRaw& x) {
    const int c = unit & 127, h = (unit >> 7) & 15, b = unit >> 11; const int m0 = b * T + c * RW_L, hc0 = h * 64;
    const int row = F.tid >> 3, cc = F.tid & 7; const size_t g = (size_t)(m0 + row) * D + hc0 + cc * 8;
    x.r = *(const v4u*)(wsp<bf16>(F, WS_R) + g); x.k = *(const v4u*)(wsp<bf16>(F, WS_K) + g); x.v = *(const v4u*)(wsp<bf16>(F, WS_V) + g);
    const bf16* LR = wsp<bf16>(F, WS_LR);
    { const int id = F.tid, r2 = id >> 4, c2 = id & 15; x.l0 = *(const v4u*)(LR + (size_t)(m0 + r2) * 256 + c2 * 8); }
    { const int id = F.tid + 512, r2 = id >> 4, c2 = id & 15; x.l1 = *(const v4u*)(LR + (size_t)(m0 + r2) * 256 + c2 * 8); }
}
__device__ __forceinline__ void rwkv_pre_phase(const Frame& F) {
    bf16* Rb = wsp<bf16>(F, WS_R); bf16* Kb = wsp<bf16>(F, WS_K);
    const bf16* w2t = wsp<bf16>(F, WS_W2T); const bf16* a2t = w2t + 1024 * 64;
    LAS float* LW = (LAS float*)(F.lds + 5 * SLOT); LAS float* AA = (LAS float*)(F.lds + 7 * SLOT);
    LAS float* PARTW = (LAS float*)(F.lds + RW_MISC); LAS float* WLs = PARTW + 512;
    const int tid = F.tid, lane = F.lane, wave = F.wave, fr = lane & 15, fq = lane >> 4;
    const int mt = wave >> 1, ntb = 2 * (wave & 1);
    RwRaw raw;
    const int per = (4096 + F.G - 1) / F.G, u_lo = F.vcu * per, u_hi = (u_lo + per < 4096) ? u_lo + per : 4096;
    if (u_lo < u_hi) rwkv_pre_load(F, u_lo, raw);
    for (int unit = u_lo; unit < u_hi; ++unit) {
    const int c = unit & 127, h = (unit >> 7) & 15, b = unit >> 11;
    const int m0 = b * T + c * RW_L, hc0 = h * 64;
    bf16x8 bwf[2][2], baf[2][2]; f32x4 w0f[2], a0f[2];
#pragma unroll
    for (int j = 0; j < 2; ++j) { const int n0 = 16 * (ntb + j);
#pragma unroll
        for (int ks = 0; ks < 2; ++ks) { bwf[j][ks] = *(const bf16x8*)(w2t + (size_t)(hc0 + n0 + fr) * 64 + ks * 32 + fq * 8); baf[j][ks] = *(const bf16x8*)(a2t + (size_t)(hc0 + n0 + fr) * 64 + ks * 32 + fq * 8); }
        w0f[j] = *(const f32x4*)(F.in[I_RW0] + hc0 + n0 + 4 * fq); a0f[j] = *(const f32x4*)(F.in[I_RA0] + hc0 + n0 + 4 * fq); }
    const float kkw = F.in[I_RKK][hc0 + lane], kaw = F.in[I_RKA][hc0 + lane], rkw = F.in[I_RRK][hc0 + lane];
    { const int row = tid >> 3, cc = tid & 7;
      *(LAS v4u*)(RW_S(0) + row * 72 + cc * 8) = raw.r; *(LAS v4u*)(RW_S(1) + row * 72 + cc * 8) = raw.k; *(LAS v4u*)(RW_S(2) + row * 72 + cc * 8) = raw.v;
      { const int id = tid, r2 = id >> 4, c2 = id & 15; *(LAS v4u*)(RW_S(3) + r2 * 136 + c2 * 8) = raw.l0; }
      { const int id = tid + 512, r2 = id >> 4, c2 = id & 15; *(LAS v4u*)(RW_S(3) + r2 * 136 + c2 * 8) = raw.l1; } }
    if (unit + 1 < u_hi) rwkv_pre_load(F, unit + 1, raw);
    LBAR();
    { LAS bf16* LRT = RW_S(3);
#pragma unroll
      for (int j = 0; j < 2; ++j) { const int n0 = 16 * (ntb + j); f32x4 aw = (f32x4){0.f, 0.f, 0.f, 0.f}, aa = aw;
#pragma unroll
          for (int ks = 0; ks < 2; ++ks) {
              const bf16x8 xw = *(const LAS bf16x8*)(LRT + (16 * mt + fr) * 136 + ks * 32 + fq * 8);
              const bf16x8 xa = *(const LAS bf16x8*)(LRT + (16 * mt + fr) * 136 + 64 + ks * 32 + fq * 8);
              aw = __builtin_amdgcn_mfma_f32_16x16x32_bf16(bwf[j][ks], xw, aw, 0, 0, 0);
              aa = __builtin_amdgcn_mfma_f32_16x16x32_bf16(baf[j][ks], xa, aa, 0, 0, 0); }
          const int t = 16 * mt + fr, cl = n0 + 4 * fq;
          const f32x4 w0 = w0f[j], a0 = a0f[j];
#pragma unroll
          for (int i = 0; i < 4; ++i) { const float wl = -softplusf(-(w0[i] + aw[i])) - 0.5f; LW[t * 68 + cl + i] = -fexp(wl); AA[t * 68 + cl + i] = fsigmoid(a0[i] + aa[i]); } } }
    LBAR();
    { const int cl = lane, tq = wave;
      float lw[8], pre[8]; float run = 0.f;
#pragma unroll
      for (int i = 0; i < 8; ++i) { lw[i] = LW[(8 * tq + i) * 68 + cl]; run += lw[i]; pre[i] = run; }
      PARTW[tq * 64 + cl] = run;
      float rr[8], kp[8], kkr[8], av[8], red[16]; unsigned vraw[8];
#pragma unroll
      for (int i = 0; i < 8; ++i) { const int t = 8 * tq + i;
          rr[i] = bf2f(RW_S(0)[t * 72 + cl]); const float k = bf2f(RW_S(1)[t * 72 + cl]); vraw[i] = RW_S(2)[t * 72 + cl];
          av[i] = AA[t * 68 + cl]; kkr[i] = k * kkw; kp[i] = k * (1.f + (av[i] - 1.f) * kaw);
          red[i] = kkr[i] * kkr[i]; red[8 + i] = rr[i] * kp[i] * rkw; }
      wave_sum16(red, lane);
      LBAR();
      float off = 0.f, cL = 0.f;
#pragma unroll
      for (int q = 0; q < 8; ++q) { const float p = PARTW[q * 64 + cl]; cL += p; off += (q < tq) ? p : 0.f; }
      if (tq == 0) WLs[cl] = fexp(cL);
      if (lane < 8) wsp<float>(F, WS_RKS)[(size_t)(m0 + 8 * tq + lane) * 16 + h] = red[8 + (lane & 7)];
      unsigned aht[4], btt[4], ktt[4], vt[4];
#pragma unroll
      for (int i = 0; i < 8; ++i) {
          const int t = 8 * tq + i;
          const float kk = kkr[i] * __builtin_amdgcn_rsqf(fmaxf(red[i], 1e-24f)), bb = kk * av[i];
          const float cs = off + pre[i];
          const float ep = fexp(cs), em = fexp(-cs), epv = fexp(cs - lw[i]), eL = fexp(cL - cs);
          const unsigned ah = f2bf(epv * kk), bh = f2bf(bb * em), kh = f2bf(kp[i] * em), rh = f2bf(rr[i] * ep), bt = f2bf(bb * eL), kt = f2bf(kp[i] * eL);
          RW_S(3)[t * 72 + cl] = (bf16)ah; RW_S(4)[t * 72 + cl] = (bf16)bh; RW_S(9)[t * 72 + cl] = (bf16)kh; RW_S(10)[t * 72 + cl] = (bf16)rh;
          if (i & 1) { aht[i >> 1] |= ah << 16; btt[i >> 1] |= bt << 16; ktt[i >> 1] |= kt << 16; vt[i >> 1] |= vraw[i] << 16; }
          else { aht[i >> 1] = ah; btt[i >> 1] = bt; ktt[i >> 1] = kt; vt[i >> 1] = vraw[i]; }
      }
      *(LAS v4u*)(RW_S(11) + cl * 72 + 8 * tq) = (v4u){aht[0], aht[1], aht[2], aht[3]};
      *(LAS v4u*)(RW_S(12) + cl * 72 + 8 * tq) = (v4u){btt[0], btt[1], btt[2], btt[3]};
      *(LAS v4u*)(RW_S(13) + cl * 72 + 8 * tq) = (v4u){ktt[0], ktt[1], ktt[2], ktt[3]};
      *(LAS v4u*)(RW_S(14) + cl * 72 + 8 * tq) = (v4u){vt[0], vt[1], vt[2], vt[3]}; }
    LBAR();
#pragma unroll
    for (int j = 0; j < 2; ++j) { const int n0 = 16 * (ntb + j), t = 16 * mt + fr, jj = n0 + 4 * fq; const f32x4 z = (f32x4){0.f, 0.f, 0.f, 0.f};
        f32x4 gab = mm_tile<2>(RW_S(3), 72, RW_S(4), 72, 16 * mt, n0, z, fr, fq);
        f32x4 gkb = mm_tile<2>(RW_S(3), 72, RW_S(9), 72, 16 * mt, n0, z, fr, fq);
        f32x4 gbr = mm_tile<2>(RW_S(10), 72, RW_S(4), 72, 16 * mt, n0, z, fr, fq);
        f32x4 gkr = mm_tile<2>(RW_S(10), 72, RW_S(9), 72, 16 * mt, n0, z, fr, fq);
#pragma unroll
        for (int i = 0; i < 4; ++i) { const bool st = (jj + i < t), inc = (jj + i <= t);
            gab[i] = st ? gab[i] : 0.f; gkb[i] = st ? gkb[i] : 0.f; gbr[i] = inc ? gbr[i] : 0.f; gkr[i] = inc ? gkr[i] : 0.f;
            RW_S(1)[(jj + i) * 72 + t] = (bf16)f2bf(gab[i]);
 }
        *(LAS v2u*)(RW_S(0) + t * 72 + jj) = pk4(gab); *(LAS v2u*)(RW_S(2) + t * 72 + jj) = pk4(gkb);
        *(LAS v2u*)(RW_S(5) + t * 72 + jj) = pk4(gbr); *(LAS v2u*)(RW_S(6) + t * 72 + jj) = pk4(gkr); }
    LBAR();
#define RW_MM1(Ap_, Bp_, c0) __builtin_amdgcn_mfma_f32_16x16x32_bf16(*(const LAS bf16x8*)((Bp_) + fr * 40 + fq * 8), *(const LAS bf16x8*)((Ap_) + fr * 40 + fq * 8), (c0), 0, 0, 0)
#define RW_WLOCAL() asm volatile("s_waitcnt lgkmcnt(0)" ::: "memory")
    if (wave < 4) {
        const int J = wave; LAS bf16* scr = (J < 2) ? RW_S(3 + J) : RW_S(5 + J);
        LAS bf16* DT = RW_S(15) + J * 640;
#pragma unroll
        for (int i = 0; i < 8; ++i) { const int idx = lane + 64 * i; if (idx < 480) *(LAS v4u*)(scr + idx * 8) = (v4u){0u, 0u, 0u, 0u}; }
        { const int idx = lane; *(LAS v4u*)(DT + idx * 8) = (v4u){0u, 0u, 0u, 0u}; if (lane < 16) *(LAS v4u*)(DT + (64 + lane) * 8) = (v4u){0u, 0u, 0u, 0u}; }
        LAS bf16* t0 = scr; LAS bf16* t1 = scr + 640; LAS bf16* t2 = scr + 1280; LAS bf16* t3 = scr + 1920; LAS bf16* t4 = scr + 2560; LAS bf16* t5 = scr + 3200;
        RW_WLOCAL();
        const v2u nn4 = *(const LAS v2u*)(RW_S(1) + (16 * J + fr) * 72 + 16 * J + 4 * fq), nt4 = *(const LAS v2u*)(RW_S(0) + (16 * J + fr) * 72 + 16 * J + 4 * fq);
        *(LAS v2u*)(t0 + fr * 40 + 4 * fq) = nn4; *(LAS v2u*)(t1 + fr * 40 + 4 * fq) = nt4;
        f32x4 p = (f32x4){-bflo(nn4.x), -bfhi(nn4.x), -bflo(nn4.y), -bfhi(nn4.y)};
#pragma unroll
        for (int i = 0; i < 4; ++i) p[i] += (fr == 4 * fq + i) ? 1.f : 0.f;
        *(LAS v2u*)(t2 + fr * 40 + 4 * fq) = pk4(p);
        RW_WLOCAL();
        const f32x4 z4 = (f32x4){0.f, 0.f, 0.f, 0.f};
        { const f32x4 c = RW_MM1(t0, t1, z4), ct = RW_MM1(t1, t0, z4); *(LAS v2u*)(t3 + fr * 40 + 4 * fq) = pk4(c); *(LAS v2u*)(t4 + fr * 40 + 4 * fq) = pk4(ct); }
        RW_WLOCAL();
        { p = RW_MM1(t2, t4, p); const f32x4 c = RW_MM1(t3, t4, z4), ct = RW_MM1(t4, t3, z4);
          *(LAS v2u*)(t5 + fr * 40 + 4 * fq) = pk4(p); *(LAS v2u*)(t0 + fr * 40 + 4 * fq) = pk4(c); *(LAS v2u*)(t1 + fr * 40 + 4 * fq) = pk4(ct); }
        RW_WLOCAL();
        { p = RW_MM1(t5, t1, p); const f32x4 ct = RW_MM1(t1, t0, z4);
          *(LAS v2u*)(t2 + fr * 40 + 4 * fq) = pk4(p); *(LAS v2u*)(t4 + fr * 40 + 4 * fq) = pk4(ct); }
        RW_WLOCAL();
        p = RW_MM1(t2, t4, p);
#pragma unroll
        for (int i = 0; i < 4; ++i) DT[(4 * fq + i) * 40 + fr] = (bf16)f2bf(p[i]);
    } else {
        const int w4 = wave - 4;
#pragma unroll
        for (int nt = 0; nt < 4; ++nt) { const f32x4 vm = mm_tile<2>(RW_S(14), 72, RW_S(2), 72, 16 * w4, 16 * nt, (f32x4){0.f, 0.f, 0.f, 0.f}, fr, fq);
            *(LAS v2u*)(RW_S(9) + (16 * w4 + fr) * 72 + 16 * nt + 4 * fq) = pk4(vm); }
    }
    LBAR();
    { LAS bf16* OUT = (wave < 4) ? RW_S(3) : RW_S(4); const LAS bf16* RHS = (wave < 4) ? RW_S(11) : RW_S(9); const int r0 = 16 * (wave & 3);
      LAS bf16* Zt = RW_S(7) + wave * 640;
#pragma unroll
      for (int i = 0; i < 3; ++i) { const int idx = lane + 64 * i; if (idx < 144) *(LAS v4u*)(OUT + r0 * 72 + idx * 8) = (v4u){0u, 0u, 0u, 0u}; }
      { *(LAS v4u*)(Zt + lane * 8) = (v4u){0u, 0u, 0u, 0u}; if (lane < 16) *(LAS v4u*)(Zt + (64 + lane) * 8) = (v4u){0u, 0u, 0u, 0u}; }
      RW_WLOCAL();
#pragma unroll
      for (int J = 0; J < 4; ++J) {
          f32x4 y = (f32x4){0.f, 0.f, 0.f, 0.f};
          if (J > 0) y = mm_tile<2>(OUT, 72, RW_S(0), 72, r0, 16 * J, y, fr, fq);
          const v2u rh = *(const LAS v2u*)(RHS + (r0 + fr) * 72 + 16 * J + 4 * fq);
          f32x4 z; z[0] = bflo(rh.x) - y[0]; z[1] = bfhi(rh.x) - y[1]; z[2] = bflo(rh.y) - y[2]; z[3] = bfhi(rh.y) - y[3];
          *(LAS v2u*)(Zt + fr * 40 + 4 * fq) = pk4(z);
          RW_WLOCAL();
          const f32x4 x = RW_MM1(Zt, RW_S(15) + J * 640, ((f32x4){0.f, 0.f, 0.f, 0.f}));
          *(LAS v2u*)(OUT + (r0 + fr) * 72 + 16 * J + 4 * fq) = pk4(x);
          RW_WLOCAL();
      } }
    LBAR();
#undef RW_MM1
#undef RW_WLOCAL
    bf16* OMT = wsp<bf16>(F, WS_OMT); bf16* YL = wsp<bf16>(F, WS_YL);
#pragma unroll
    for (int j = 0; j < 2; ++j) { const int nt = ntb + j, n0 = 16 * nt, m = 16 * mt + fr, nn = n0 + 4 * fq; const f32x4 z = (f32x4){0.f, 0.f, 0.f, 0.f};
        { f32x4 x = mm_tile<2>(RW_S(12), 72, RW_S(3), 72, 16 * mt, n0, z, fr, fq); const float wl = WLs[m];
#pragma unroll
          for (int i = 0; i < 4; ++i) x[i] = ((nn + i == m) ? wl : 0.f) - x[i];
          const int idx = (nt >> 1) * 32 + fq * 8 + (nt & 1) * 4;
          *(v2u*)(Rb + (size_t)(m0 + m) * D + hc0 + idx) = pk4(x); }
        { const f32x4 x1 = mm_tile<2>(RW_S(14), 72, RW_S(13), 72, 16 * mt, n0, z, fr, fq), x2 = mm_tile<2>(RW_S(4), 72, RW_S(12), 72, 16 * mt, n0, z, fr, fq);
          *(v2u*)(Kb + (size_t)(m0 + m) * D + hc0 + fq * 16 + nt * 4) = pk4(x1 - x2); }
        { const f32x4 x1 = mm_tile<2>(RW_S(6), 72, RW_S(14), 72, 16 * mt, n0, z, fr, fq), x2 = mm_tile<2>(RW_S(5), 72, RW_S(4), 72, 16 * mt, n0, z, fr, fq);
          *(v2u*)(YL + (size_t)(m0 + m) * D + hc0 + nn) = pk4(x1 - x2); }
        { const f32x4 x = mm_tile<2>(RW_S(5), 72, RW_S(3), 72, 16 * mt, n0, z, fr, fq);
          const v2u rr2 = *(const LAS v2u*)(RW_S(10) + m * 72 + nn);
          f32x4 o; o[0] = bflo(rr2.x) - x[0]; o[1] = bfhi(rr2.x) - x[1]; o[2] = bflo(rr2.y) - x[2]; o[3] = bfhi(rr2.y) - x[3];
          *(v2u*)(OMT + (size_t)(m0 + m) * D + hc0 + nn) = pk4(o); } }
    LBAR();
    }
}
constexpr int RW_SEG = 16, RW_NSEG = RW_NC / RW_SEG;
constexpr size_t WS_PSEG = 243 * MiB, WS_QSEG = 245 * MiB;
#define RW_STEP(A, ps, withpsi) do { v2u _pk[4]; \
        _Pragma("unroll") for (int mt = 0; mt < 4; ++mt) _pk[mt] = pk4(acc[mt]); \
        const v4u _b0 = (v4u){_pk[0].x, _pk[0].y, _pk[1].x, _pk[1].y}, _b1 = (v4u){_pk[2].x, _pk[2].y, _pk[3].x, _pk[3].y}; \
        const bf16x8 _sB0 = __builtin_bit_cast(bf16x8, _b0), _sB1 = __builtin_bit_cast(bf16x8, _b1); \
        _Pragma("unroll") for (int mt = 0; mt < 4; ++mt) { \
            f32x4 _a = (withpsi) ? (f32x4){bflo(ps[2 * mt]), bfhi(ps[2 * mt]), bflo(ps[2 * mt + 1]), bfhi(ps[2 * mt + 1])} : (f32x4){0.f, 0.f, 0.f, 0.f}; \
            _a = __builtin_amdgcn_mfma_f32_16x16x32_bf16(A[mt][0], _sB0, _a, 0, 0, 0); \
            _a = __builtin_amdgcn_mfma_f32_16x16x32_bf16(A[mt][1], _sB1, _a, 0, 0, 0); \
            acc[mt] = _a; } } while (0)
__device__ __forceinline__ void rwkv_scan_a(const Frame& F) {
    const bf16* Rb = wsp<bf16>(F, WS_R); const bf16* Kb = wsp<bf16>(F, WS_K);
    bf16* PSEG = wsp<bf16>(F, WS_PSEG); bf16* QSEG = wsp<bf16>(F, WS_QSEG);
    const int l15 = F.lane & 15, q = F.lane >> 4, w = F.wave;
    const size_t cstep = (size_t)RW_L * D * 2;
    for (int unit = F.vcu; unit < 32 * RW_NSEG; unit += F.G) {
        const int seg = unit & (RW_NSEG - 1), bh = unit >> 3, b = bh >> 4, h = bh & 15, hc0 = h * 64;
        const int mbase = b * T + seg * RW_SEG * RW_L;
        const char* src[2];
#pragma unroll
        for (int j = 0; j < 2; ++j) { const int p = w * 2 + j;
            if (p < 8) { const int mt = p >> 1, sk = p & 1; src[j] = (const char*)(Rb + (size_t)(mbase + 16 * mt + l15) * D + hc0 + sk * 32 + q * 8); }
            else { const int vg = (p - 8) >> 1, half = p & 1; src[j] = (const char*)(Kb + (size_t)(mbase + 16 * vg + l15) * D + hc0 + q * 16 + half * 8); } }
#define RA_ISSUE(c) do { const int _cc = (c) & (RW_SEG - 1); _Pragma("unroll") for (int j = 0; j < 2; ++j) \
        __builtin_amdgcn_global_load_lds((const unsigned*)(src[j] + (size_t)_cc * cstep), (LAS unsigned*)(F.lds + ((c) & 7) * 16384 + (w * 2 + j) * 1024), 16, 0, 0); } while (0)
        f32x4 acc[4];
        if (w < 4) {
#pragma unroll
            for (int i = 0; i < 4; ++i) acc[i] = (f32x4){0.f, 0.f, 0.f, 0.f};
        } else {
#pragma unroll
            for (int mt = 0; mt < 4; ++mt)
#pragma unroll
                for (int i = 0; i < 4; ++i) acc[mt][i] = (16 * mt + 4 * q + i == 16 * (w - 4) + l15) ? 1.f : 0.f;
        }
        for (int c = 0; c < 7; ++c) RA_ISSUE(c);
        asm volatile("s_waitcnt vmcnt(12)" ::: "memory");
        __builtin_amdgcn_s_barrier();
        for (int c = 0; c < RW_SEG; ++c) {
            RA_ISSUE(c + 7);
            LAS unsigned char* slot = F.lds + (c & 7) * 16384;
            bf16x8 A[4][2];
#pragma unroll
            for (int mt = 0; mt < 4; ++mt)
#pragma unroll
                for (int sk = 0; sk < 2; ++sk) A[mt][sk] = *(const LAS bf16x8*)(slot + (mt * 2 + sk) * 1024 + F.lane * 16);
            if (w < 4) {
                const v4u p01 = *(const LAS v4u*)(slot + (8 + w * 2) * 1024 + F.lane * 16), p23 = *(const LAS v4u*)(slot + (9 + w * 2) * 1024 + F.lane * 16);
                const unsigned ps[8] = {p01.x, p01.y, p01.z, p01.w, p23.x, p23.y, p23.z, p23.w};
                RW_STEP(A, ps, true);
            } else { const unsigned ps[8] = {0u, 0u, 0u, 0u, 0u, 0u, 0u, 0u}; RW_STEP(A, ps, false); }
            asm volatile("s_waitcnt vmcnt(12) lgkmcnt(0)" ::: "memory");
            __builtin_amdgcn_s_barrier();
        }
        asm volatile("s_waitcnt vmcnt(0)" ::: "memory");
#undef RA_ISSUE
        if (w < 4) {
#pragma unroll
            for (int mt = 0; mt < 4; ++mt) *(v2u*)(QSEG + ((size_t)unit * 64 + 16 * w + l15) * 64 + q * 16 + mt * 4) = pk4(acc[mt]);
        } else {
            const int pg = w - 4, idx = (pg >> 1) * 32 + (l15 >> 2) * 8 + (pg & 1) * 4 + (l15 & 3);
#pragma unroll
            for (int mt = 0; mt < 4; ++mt)
#pragma unroll
                for (int i = 0; i < 4; ++i) PSEG[((size_t)unit * 64 + 16 * mt + 4 * q + i) * 64 + idx] = (bf16)f2bf(acc[mt][i]);
        }
        __syncthreads();
    }
}
__device__ __forceinline__ void rwkv_scan_c(const Frame& F) {
    const bf16* Rb = wsp<bf16>(F, WS_R); const bf16* Kb = wsp<bf16>(F, WS_K); bf16* S0 = wsp<bf16>(F, WS_S0);
    const bf16* PSEG = wsp<bf16>(F, WS_PSEG); const bf16* QSEG = wsp<bf16>(F, WS_QSEG);
    const int l15 = F.lane & 15, q = F.lane >> 4;
    const size_t cstep = (size_t)RW_L * D * 2;
    for (int unit = F.vcu; unit < 32 * RW_NSEG; unit += F.G) {
        const int seg = unit & (RW_NSEG - 1), bh = unit >> 3, b = bh >> 4, h = bh & 15, hc0 = h * 64;
        const int mbase = b * T + seg * RW_SEG * RW_L;
        if (F.wave >= 4) {
            const int lw = F.wave - 4; const char* src[4];
#pragma unroll
            for (int j = 0; j < 4; ++j) { const int p = lw * 4 + j;
                if (p < 8) { const int mt = p >> 1, sk = p & 1; src[j] = (const char*)(Rb + (size_t)(mbase + 16 * mt + l15) * D + hc0 + sk * 32 + q * 8); }
                else { const int vg = (p - 8) >> 1, half = p & 1; src[j] = (const char*)(Kb + (size_t)(mbase + 16 * vg + l15) * D + hc0 + q * 16 + half * 8); } }
#define RS_ISSUE(c) do { const int _cc = (c) & (RW_SEG - 1); _Pragma("unroll") for (int j = 0; j < 4; ++j) \
        __builtin_amdgcn_global_load_lds((const unsigned*)(src[j] + (size_t)_cc * cstep), (LAS unsigned*)(F.lds + ((c) & 7) * 16384 + (lw * 4 + j) * 1024), 16, 0, 0); } while (0)
            for (int c = 0; c < 7; ++c) RS_ISSUE(c);
            asm volatile("s_waitcnt vmcnt(24)" ::: "memory");
            __builtin_amdgcn_s_barrier();
            for (int c = 0; c < RW_SEG; ++c) { RS_ISSUE(c + 7); asm volatile("s_waitcnt vmcnt(24)" ::: "memory"); __builtin_amdgcn_s_barrier(); }
            asm volatile("s_waitcnt vmcnt(0)" ::: "memory");
#undef RS_ISSUE
        } else {
            const int vg = F.wave;
            f32x4 acc[4];
#pragma unroll
            for (int i = 0; i < 4; ++i) acc[i] = (f32x4){0.f, 0.f, 0.f, 0.f};
            for (int j = 0; j < seg; ++j) { const size_t uj = (size_t)(unit - seg + j);
                bf16x8 A[4][2];
#pragma unroll
                for (int mt = 0; mt < 4; ++mt)
#pragma unroll
                    for (int sk = 0; sk < 2; ++sk) A[mt][sk] = *(const bf16x8*)(PSEG + (uj * 64 + 16 * mt + l15) * 64 + sk * 32 + q * 8);
                const v4u p01 = *(const v4u*)(QSEG + (uj * 64 + 16 * vg + l15) * 64 + q * 16), p23 = *(const v4u*)(QSEG + (uj * 64 + 16 * vg + l15) * 64 + q * 16 + 8);
                const unsigned ps[8] = {p01.x, p01.y, p01.z, p01.w, p23.x, p23.y, p23.z, p23.w};
                RW_STEP(A, ps, true); }
            __builtin_amdgcn_s_barrier();
            for (int c = 0; c < RW_SEG; ++c) {
                const int m0 = mbase + c * RW_L; LAS unsigned char* slot = F.lds + (c & 7) * 16384;
                bf16x8 A[4][2];
#pragma unroll
                for (int mt = 0; mt < 4; ++mt)
#pragma unroll
                    for (int sk = 0; sk < 2; ++sk) A[mt][sk] = *(const LAS bf16x8*)(slot + (mt * 2 + sk) * 1024 + F.lane * 16);
                const v4u p01 = *(const LAS v4u*)(slot + (8 + vg * 2) * 1024 + F.lane * 16), p23 = *(const LAS v4u*)(slot + (9 + vg * 2) * 1024 + F.lane * 16);
#pragma unroll
                for (int mt = 0; mt < 4; ++mt) *(v2u*)(S0 + (size_t)(m0 + 16 * vg + l15) * D + hc0 + 16 * mt + 4 * q) = pk4(acc[mt]);
                const unsigned ps[8] = {p01.x, p01.y, p01.z, p01.w, p23.x, p23.y, p23.z, p23.w};
                RW_STEP(A, ps, true);
                asm volatile("s_waitcnt lgkmcnt(0)" ::: "memory");
                __builtin_amdgcn_s_barrier();
            }
        }
        __syncthreads();
    }
}
struct PostIn { bf16x8 om[2], lg[4], sb[4][2]; v2u yl[4], vr[4]; float rk; };
__device__ __forceinline__ void rwkv_post_load(const Frame& F, int unit, int mt, int fr, int fq, PostIn& x) {
    const bf16* Vb = wsp<bf16>(F, WS_V); const bf16* LR = wsp<bf16>(F, WS_LR);
    const bf16* OMT = wsp<bf16>(F, WS_OMT); const bf16* YL = wsp<bf16>(F, WS_YL); const bf16* S0 = wsp<bf16>(F, WS_S0);
    const int c = unit & 127, h = (unit >> 7) & 15, b = unit >> 11;
    const int m0 = b * T + c * RW_L, hc0 = h * 64, t = 16 * mt + fr; const size_t rowt = (size_t)(m0 + t);
#pragma unroll
    for (int ks = 0; ks < 2; ++ks) x.om[ks] = *(const bf16x8*)(OMT + rowt * D + hc0 + ks * 32 + fq * 8);
#pragma unroll
    for (int ks = 0; ks < 4; ++ks) x.lg[ks] = *(const bf16x8*)(LR + rowt * 256 + 128 + ks * 32 + fq * 8);
#pragma unroll
    for (int nt = 0; nt < 4; ++nt) { x.yl[nt] = *(const v2u*)(YL + rowt * D + hc0 + 16 * nt + 4 * fq); x.vr[nt] = *(const v2u*)(Vb + rowt * D + hc0 + 16 * nt + 4 * fq);
#pragma unroll
        for (int ks = 0; ks < 2; ++ks) x.sb[nt][ks] = *(const bf16x8*)(S0 + (size_t)(m0 + 16 * nt + fr) * D + hc0 + ks * 32 + fq * 8); }
    x.rk = wsp<float>(F, WS_RKS)[rowt * 16 + h];
}
__device__ __forceinline__ void rwkv_post(const Frame& F) {
    const int fr = F.lane & 15, fq = F.lane >> 4;
    bf16* Rb = wsp<bf16>(F, WS_R);
    const bf16* g2t = wsp<bf16>(F, WS_W2T) + 2 * 1024 * 64;
    LAS bf16* G2 = (LAS bf16*)F.lds;
    const int per = (4096 + F.G - 1) / F.G, u_lo = F.vcu * per, u_hi = (u_lo + per < 4096) ? u_lo + per : 4096;
    const int nitems = (u_hi > u_lo) ? (u_hi - u_lo) * 4 : 0;
    int h_cur = -1; f32x4 lgv[4], lbv[4];
    PostIn cur, nxt;
    if (F.wave < nitems) rwkv_post_load(F, u_lo + (F.wave >> 2), F.wave & 3, fr, fq, cur);
    for (int it = F.wave; it < ((nitems + 7) & ~7); it += NWAVES) {
        const bool active = it < nitems;
        const int unit = active ? u_lo + (it >> 2) : u_lo, mt = it & 3;
        const int c = unit & 127, h = (unit >> 7) & 15, b = unit >> 11;
        const int m0 = b * T + c * RW_L, hc0 = h * 64, t = 16 * mt + fr; const size_t rowt = (size_t)(m0 + t);
        if (h != h_cur) {
            __syncthreads();
#pragma unroll
            for (int i = 0; i < 2; ++i) { const int id = F.tid + 512 * i, row = id >> 4, c2 = id & 15; *(LAS v4u*)(G2 + row * 136 + c2 * 8) = *(const v4u*)(g2t + (size_t)(hc0 + row) * 128 + c2 * 8); }
#pragma unroll
            for (int nt = 0; nt < 4; ++nt) { lgv[nt] = *(const f32x4*)(F.in[I_RLG] + hc0 + 16 * nt + 4 * fq); lbv[nt] = *(const f32x4*)(F.in[I_RLB] + hc0 + 16 * nt + 4 * fq); }
            __syncthreads(); h_cur = h; }
        if (it + NWAVES < nitems) rwkv_post_load(F, u_lo + ((it + NWAVES) >> 2), (it + NWAVES) & 3, fr, fq, nxt);
        if (active) {
        f32x4 y[4], g[4];
#pragma unroll
        for (int nt = 0; nt < 4; ++nt) {
            f32x4 a = (f32x4){bflo(cur.yl[nt].x), bfhi(cur.yl[nt].x), bflo(cur.yl[nt].y), bfhi(cur.yl[nt].y)};
#pragma unroll
            for (int ks = 0; ks < 2; ++ks) a = __builtin_amdgcn_mfma_f32_16x16x32_bf16(cur.sb[nt][ks], cur.om[ks], a, 0, 0, 0);
            y[nt] = a;
            f32x4 gg = (f32x4){0.f, 0.f, 0.f, 0.f};
#pragma unroll
            for (int ks = 0; ks < 4; ++ks) { const bf16x8 gb = *(const LAS bf16x8*)(G2 + (16 * nt + fr) * 136 + ks * 32 + fq * 8);
                gg = __builtin_amdgcn_mfma_f32_16x16x32_bf16(gb, cur.lg[ks], gg, 0, 0, 0); }
            g[nt] = gg; }
        float s = 0.f;
#pragma unroll
        for (int nt = 0; nt < 4; ++nt) s += (y[nt][0] + y[nt][1]) + (y[nt][2] + y[nt][3]);
        s += __shfl_xor(s, 16); s += __shfl_xor(s, 32);
        const float mu = s * (1.f / 64.f); float qv = 0.f;
#pragma unroll
        for (int nt = 0; nt < 4; ++nt) { y[nt] = y[nt] - mu; qv += (y[nt][0] * y[nt][0] + y[nt][1] * y[nt][1]) + (y[nt][2] * y[nt][2] + y[nt][3] * y[nt][3]); }
        qv += __shfl_xor(qv, 16); qv += __shfl_xor(qv, 32);
        const float rstd = 1.f / sqrtf(qv * (1.f / 64.f) + GN_EPS);
        const float rk = cur.rk;
#pragma unroll
        for (int nt = 0; nt < 4; ++nt) { const int v = hc0 + 16 * nt + 4 * fq; const v2u vr = cur.vr[nt];
            f32x4 o; o[0] = (y[nt][0] * rstd * lgv[nt][0] + lbv[nt][0] + rk * bflo(vr.x)) * g[nt][0]; o[1] = (y[nt][1] * rstd * lgv[nt][1] + lbv[nt][1] + rk * bfhi(vr.x)) * g[nt][1];
            o[2] = (y[nt][2] * rstd * lgv[nt][2] + lbv[nt][2] + rk * bflo(vr.y)) * g[nt][2]; o[3] = (y[nt][3] * rstd * lgv[nt][3] + lbv[nt][3] + rk * bfhi(vr.y)) * g[nt][3];
            *(v2u*)(Rb + rowt * D + v) = pk4(o); }
        }
        cur = nxt;
    }
    __syncthreads();
}
__device__ __forceinline__ void norm_phase(const Frame& F, const float* g, bf16* XN) {
    const int gw = F.vcu * NWAVES + F.wave, NGW = F.G * NWAVES;
    for (int m = gw; m < M; m += NGW) { f32x4 v[4]; rms_row_h(HBp(F) + (size_t)m * D, g, F.lane, v); store_row_bf16(XN + (size_t)m * D, F.lane, v); }
}
__device__ __forceinline__ void a2_phase(const Frame& F) {
    const int gw = F.vcu * NWAVES + F.wave, NGW = F.G * NWAVES; const float* g = F.in[I_NMG] + D; bf16* A2 = wsp<bf16>(F, WS_A2);
    for (int blk = gw; blk < M / 8; blk += NGW) {
        const int r0 = 8 * blk; f32x4 prev[4];
        if ((r0 & (T - 1)) == 0) {
#pragma unroll
            for (int j = 0; j < 4; ++j) prev[j] = (f32x4){0.f, 0.f, 0.f, 0.f};
        } else rms_row_h(HBp(F) + (size_t)(r0 - 1) * D, g, F.lane, prev);
        for (int i = 0; i < 8; ++i) { f32x4 cur[4]; rms_row_h(HBp(F) + (size_t)(r0 + i) * D, g, F.lane, cur);
            store_row_bf16(A2 + (size_t)(r0 + i) * 2048, F.lane, cur);
            f32x4 dx[4];
#pragma unroll
            for (int j = 0; j < 4; ++j) { dx[j] = prev[j] - cur[j]; prev[j] = cur[j]; }
            store_row_bf16(A2 + (size_t)(r0 + i) * 2048 + D, F.lane, dx); }
    }
}
__device__ __forceinline__ void wave_sum8(float (&v)[8], int lane) {
    const bool b5 = lane & 32, b4 = lane & 16, b3 = lane & 8;
    float x[4], y[2], z;
#pragma unroll
    for (int j = 0; j < 4; ++j) { const float send = b5 ? v[j] : v[j + 4], keep = b5 ? v[j + 4] : v[j]; x[j] = keep + __shfl_xor(send, 32); }
#pragma unroll
    for (int j = 0; j < 2; ++j) { const float send = b4 ? x[j] : x[j + 2], keep = b4 ? x[j + 2] : x[j]; y[j] = keep + __shfl_xor(send, 16); }
    { const float send = b3 ? y[0] : y[1], keep = b3 ? y[1] : y[0]; z = keep + __shfl_xor(send, 8); }
    z += __shfl_xor(z, 4); z += __shfl_xor(z, 2); z += __shfl_xor(z, 1);
#pragma unroll
    for (int j = 0; j < 8; ++j) v[j] = __builtin_bit_cast(float, __builtin_amdgcn_readlane(__builtin_bit_cast(int, z), 8 * j));
}
__device__ __forceinline__ void router_rows(const Frame& F, int blk, LAS int* wgc, LAS int* TE, LAS int* TL, LAS float* TW) {
    const float* g = F.in[I_NFG] + D; const float* rw = F.in[I_MR]; const float* rb = F.in[I_MRB]; bf16* XN3 = wsp<bf16>(F, WS_XN3);
    float rwr[16][8];
#pragma unroll
    for (int j = 0; j < 4; ++j)
#pragma unroll
        for (int x = 0; x < 4; ++x) { const int k = 4 * F.lane + 256 * j + x; const f32x4 r0 = *(const f32x4*)(rw + k * 8), r1 = *(const f32x4*)(rw + k * 8 + 4);
            rwr[4 * j + x][0] = r0[0]; rwr[4 * j + x][1] = r0[1]; rwr[4 * j + x][2] = r0[2]; rwr[4 * j + x][3] = r0[3]; rwr[4 * j + x][4] = r1[0]; rwr[4 * j + x][5] = r1[1]; rwr[4 * j + x][6] = r1[2]; rwr[4 * j + x][7] = r1[3]; }
    float rbv[8];
#pragma unroll
    for (int e = 0; e < 8; ++e) rbv[e] = rb[e];
    const f32x4* gr = (const f32x4*)g + F.lane; f32x4 gv[4];
#pragma unroll
    for (int j = 0; j < 4; ++j) gv[j] = gr[64 * j];
    f32x4 hv[4], hn[4];
    load_row_bf16(HBp(F) + (size_t)(64 * blk + 8 * F.wave) * D, F.lane, hv);
    for (int i = 0; i < 8; ++i) {
        const int tl = 8 * F.wave + i, m = 64 * blk + tl;
        if (i + 1 < 8) load_row_bf16(HBp(F) + (size_t)(m + 1) * D, F.lane, hn);
        float ssq = 0.f;
#pragma unroll
        for (int j = 0; j < 4; ++j) ssq += (hv[j].x * hv[j].x + hv[j].y * hv[j].y) + (hv[j].z * hv[j].z + hv[j].w * hv[j].w);
        const float rs = 1.f / sqrtf(wave_sum(ssq) * (1.f / D) + RMS_EPS);
        f32x4 v[4];
#pragma unroll
        for (int j = 0; j < 4; ++j) v[j] = hv[j] * rs * gv[j];
        store_row_bf16(XN3 + (size_t)m * D, F.lane, v);
        float lg[8];
#pragma unroll
        for (int e = 0; e < 8; ++e) lg[e] = 0.f;
#pragma unroll
        for (int j = 0; j < 4; ++j)
#pragma unroll
            for (int x = 0; x < 4; ++x) { const float xv = v[j][x];
#pragma unroll
                for (int e = 0; e < 8; ++e) lg[e] += xv * rwr[4 * j + x][e]; }
        wave_sum8(lg, F.lane);
#pragma unroll
        for (int e = 0; e < 8; ++e) lg[e] += rbv[e];
        int e1 = 0; float l1 = lg[0];
#pragma unroll
        for (int e = 1; e < 8; ++e) if (lg[e] > l1) { l1 = lg[e]; e1 = e; }
        int e2 = (e1 + 1) & 7; float l2 = -3.0e38f;
#pragma unroll
        for (int e = 0; e < 8; ++e) if (e != e1 && lg[e] > l2) { l2 = lg[e]; e2 = e; }
        const float w1 = 1.f / (1.f + expf(l2 - l1)), w2 = 1.f - w1;
        if (F.lane == 0) { const int a = atomicAdd((int*)&wgc[e1], 1), bb = atomicAdd((int*)&wgc[e2], 1);
            TE[2 * tl] = e1; TE[2 * tl + 1] = e2; TL[2 * tl] = a; TL[2 * tl + 1] = bb; TW[2 * tl] = w1; TW[2 * tl + 1] = w2; }
#pragma unroll
        for (int j = 0; j < 4; ++j) hv[j] = hn[j];
    }
}
__device__ __forceinline__ void router_phase(const Frame& F) {
    LAS int* wgc = (LAS int*)(F.lds + 131072); LAS int* wbase = wgc + 8; LAS int* TE = wgc + 16; LAS int* TL = TE + 128; LAS float* TW = (LAS float*)(TL + 128);
    bool jobs_done = false;
    for (int blk = F.vcu; blk < M / 64; blk += F.G) {
    if (F.tid < 8) wgc[F.tid] = 0;
    __syncthreads();
    if ((F.wave & 1) && !jobs_done) run_jobs(F, true);
    router_rows(F, blk, wgc, TE, TL, TW);
    if (!(F.wave & 1) && !jobs_done) run_jobs(F, true);
    jobs_done = true;
    __syncthreads();
    if (F.tid < 8) wbase[F.tid] = (int)__hip_atomic_fetch_add((unsigned*)(F.ws + WS_CTL) + CW_CNT + F.tid, (unsigned)wgc[F.tid], RLX_AGENT);
    __syncthreads();
    if (F.tid < 128) { const int tl = F.tid >> 1, m = 64 * blk + tl;
        if (m < M) { unsigned char* rt = F.ws + WS_ROUTE; const int e = TE[F.tid];
            const int pos = wbase[e] + TL[F.tid];
            ((int*)(rt + RT_E))[2 * m + (F.tid & 1)] = e; ((int*)(rt + RT_POS))[2 * m + (F.tid & 1)] = pos;
            if ((unsigned)e < 8u && (unsigned)pos < 16384u) { ((int*)(rt + RT_P2T))[e * 16384 + pos] = m; ((float*)(rt + RT_P2W))[e * 16384 + pos] = TW[F.tid]; } } }
    __syncthreads();
    }
    if (!jobs_done) run_jobs(F, true);
}
__device__ __forceinline__ void moe_offsets(const Frame& F, int (&toff)[9], int (&cn)[8]) {
    const unsigned* cnt = (const unsigned*)(F.ws + WS_CTL) + CW_CNT; int acc = 0;
#pragma unroll
    for (int e = 0; e < 8; ++e) { int ce = (int)__hip_atomic_load(cnt + e, RLX_AGENT); ce = ce < 0 ? 0 : (ce > 16384 ? 16384 : ce); cn[e] = ce; toff[e] = acc; acc += (ce + 255) >> 8; }
    toff[8] = acc;
}
__device__ __forceinline__ void final_stage1(const Frame& F, int blk) {
    const v4u* src = (const v4u*)(HBp(F) + (size_t)blk * 64 * D);
#pragma unroll
    for (int i = 0; i < 16; ++i) { const int id = F.tid + 512 * i; *(LAS v4u*)(F.lds + id * 16) = src[id]; }
}
__device__ __forceinline__ void final_stage2(const Frame& F, int blk) {
    int toff[9], cn[8]; moe_offsets(F, toff, cn);
    unsigned char* rt = F.ws + WS_ROUTE; const bf16* YE = wsp<bf16>(F, WS_XG); const float* g = F.in[I_NOG];
    for (int i = 0; i < 8; ++i) {
        const int rl = 8 * F.wave + i, m = 64 * blk + rl;
        int s0, s1;
        { const int e0 = ((const int*)(rt + RT_E))[2 * m], e1 = ((const int*)(rt + RT_E))[2 * m + 1]; int t0 = 0, t1 = 0;
#pragma unroll
          for (int j = 0; j < 8; ++j) { t0 = (e0 == j) ? toff[j] : t0; t1 = (e1 == j) ? toff[j] : t1; }
          s0 = 256 * t0 + ((const int*)(rt + RT_POS))[2 * m]; s1 = 256 * t1 + ((const int*)(rt + RT_POS))[2 * m + 1]; }
        if ((unsigned)s0 >= (unsigned)XG_ROWS) s0 = XG_ROWS - 1; if ((unsigned)s1 >= (unsigned)XG_ROWS) s1 = XG_ROWS - 1;
        const LAS v2u* hr = (const LAS v2u*)(F.lds + rl * 2048) + F.lane; const v2u* y0 = (const v2u*)(YE + (size_t)s0 * D) + F.lane; const v2u* y1 = (const v2u*)(YE + (size_t)s1 * D) + F.lane;
        f32x4 v[4]; float s = 0.f;
#pragma unroll
        for (int j = 0; j < 4; ++j) { const v2u a = y0[64 * j], bq = y1[64 * j], hh = hr[64 * j];
            v[j][0] = bflo(hh.x) + bflo(a.x) + bflo(bq.x); v[j][1] = bfhi(hh.x) + bfhi(a.x) + bfhi(bq.x); v[j][2] = bflo(hh.y) + bflo(a.y) + bflo(bq.y); v[j][3] = bfhi(hh.y) + bfhi(a.y) + bfhi(bq.y);
            s += (v[j][0] * v[j][0] + v[j][1] * v[j][1]) + (v[j][2] * v[j][2] + v[j][3] * v[j][3]); }
        const float rs = 1.f / sqrtf(wave_sum(s) * (1.f / D) + RMS_EPS);
        f32x4* o = (f32x4*)(F.out + (size_t)m * D) + F.lane; const f32x4* gr = (const f32x4*)g + F.lane;
#pragma unroll
        for (int j = 0; j < 4; ++j) o[64 * j] = v[j] * rs * gr[64 * j];
    }
}
constexpr int N_PHASES = 19;
struct Args { const float* in[37]; float* out; unsigned char* ws; int ph_lo, ph_hi; };
__global__ void __launch_bounds__(NTHREADS, 2) fwd_kernel(Args args) {
    extern __shared__ __attribute__((aligned(16))) unsigned char lds_raw[];
    Frame F;
    F.lds = (LAS unsigned char*)lds_raw;
    F.tid = threadIdx.x; F.lane = F.tid & 63; F.wave = __builtin_amdgcn_readfirstlane(F.tid >> 6);
    F.G = gridDim.x; { const int bx = blockIdx.x; F.vcu = (F.G % 8 == 0) ? (bx % 8) * (F.G / 8) + bx / 8 : bx; }
#pragma unroll
    for (int i = 0; i < 37; ++i) F.in[i] = args.in[i];
    F.out = args.out; F.ws = args.ws;
    volatile LAS unsigned* MISC = (volatile LAS unsigned*)(F.lds + MISC_OFF);
    if (F.tid < 64) MISC[F.tid] = 0u;
    __syncthreads();
    const int lo = args.ph_lo, hi = args.ph_hi;
    const bool multi = (hi - lo) > 1;
    XcdBarrier bar; bar.bar = (unsigned*)(F.ws + WS_CTL) + CW_BAR; bar.x = 0; bar.st = nullptr;
    if (multi) bar = xcd_barrier_post((unsigned*)(F.ws + WS_CTL) + CW_BAR, MISC + 8);
#define IN(k) (lo <= (k) && (k) < hi)
#define SEAM(k) do { if (IN(k) && IN((k) + 1)) xcd_barrier(bar); } while (0)
    LAS unsigned char* lds = F.lds;
    const int cu = (int)blockIdx.x;

    if (IN(0)) { p0_prologue(F); } SEAM(0);
    if (IN(1)) { pg8::DenseOrder S; S.init(wsp<bf16>(F, WS_XN), wsp<bf16>(F, WS_WIN), M, MIX_IN, 1024, F.G, cu);
        epi::MixIn E{wsp<bf16>(F, WS_Z), wsp<float>(F, WS_LB)};
        pg8::gemm_phase(lds, 1024, S, E); } SEAM(1);
    if (IN(2)) { hgrn_pre_phase(F); } SEAM(2);
    if (IN(3)) {
        if (F.G > 128) { if (F.vcu < 64) hgrn_scan(F); else for (int u = F.vcu - 64; u < 512; u += F.G - 64) gmlp_unit(F, u); }
        else { hgrn_scan(F); for (int u = F.vcu; u < 512; u += F.G) gmlp_unit(F, u); } } SEAM(3);
    if (IN(4)) { hgrn_post_phase(F); } SEAM(4);
    if (IN(5)) { pg8::DenseOrder S; S.init(wsp<bf16>(F, WS_XN), wsp<bf16>(F, WS_WOUT), M, D, 1024, F.G, cu);
        epi::Resid<true> E{F.in[I_X], HBp(F)};
        pg8::gemm_phase(lds, 1024, S, E); } SEAM(5);
    if (IN(6)) { norm_phase(F, F.in[I_NFG], wsp<bf16>(F, WS_XN)); } SEAM(6);
    if (IN(7)) { pg8::DenseOrder S; S.init(wsp<bf16>(F, WS_XN), wsp<bf16>(F, WS_WGU), M, 2 * DFF, 1024, F.G, cu);
        epi::SwiGlu E{wsp<bf16>(F, WS_HF), DFF, nullptr};
        pg8::gemm_phase(lds, 1024, S, E); } SEAM(7);
    if (IN(8)) { pg8::DenseOrder S; S.init(wsp<bf16>(F, WS_HF), wsp<bf16>(F, WS_WD), M, D, DFF, F.G, cu);
        epi::Resid<false> E{nullptr, HBp(F)};
        pg8::gemm_phase(lds, DFF, S, E); } SEAM(8);
    if (IN(9)) { a2_phase(F); } SEAM(9);
    if (IN(10)) { pg8::DenseOrder S; S.init(wsp<bf16>(F, WS_A2), wsp<bf16>(F, WS_WR), M, NRW, 2048, F.G, cu);
        epi::RwkvProj E{wsp<bf16>(F, WS_R), (size_t)(WS_K - WS_R) / 2, wsp<bf16>(F, WS_LR)};
        pg8::gemm_phase(lds, 2048, S, E); } SEAM(10);
    if (IN(11)) { rwkv_pre_phase(F); } SEAM(11);
    if (IN(12)) { rwkv_scan_a(F); xcd_barrier(bar); rwkv_scan_c(F); } SEAM(12);
    if (IN(13)) { rwkv_post(F); } SEAM(13);
    if (IN(14)) { pg8::DenseOrder S; S.init(wsp<bf16>(F, WS_R), wsp<bf16>(F, WS_WO), M, D, 1024, F.G, cu);
        epi::Resid<false> E{nullptr, HBp(F)};
        pg8::gemm_phase(lds, 1024, S, E); } SEAM(14);
    if (IN(15)) { router_phase(F); } SEAM(15);
    if (IN(16)) { pg8::MoeOrder<true> S; moe_offsets(F, S.toff, S.cnt); S.ntiles = S.toff[8]; S.nN = 2 * DFE / 256; S.nwg = S.ntiles * S.nN; S.G = F.G; S.c = cu;
        S.A = (const char*)wsp<bf16>(F, WS_XN3); S.Bt = (const char*)wsp<bf16>(F, WS_WEGU); S.tstep = (size_t)256 * 1024 * 2; S.estride = (size_t)2 * DFE * 1024 * 2;
        S.p2t = (const int*)(F.ws + WS_ROUTE + RT_P2T); S.rowbytes = 1024 * 2;
        epi::SwiGlu E{wsp<bf16>(F, WS_HE), DFE, (const float*)(F.ws + WS_ROUTE + RT_P2W)};
        pg8::gemm_phase(lds, 1024, S, E); } SEAM(16);
    if (IN(17)) { pg8::MoeOrder<false> S; moe_offsets(F, S.toff, S.cnt); S.ntiles = S.toff[8]; S.nN = D / 256; S.nwg = S.ntiles * S.nN; S.G = F.G; S.c = cu;
        S.A = (const char*)wsp<bf16>(F, WS_HE); S.Bt = (const char*)wsp<bf16>(F, WS_WED); S.tstep = (size_t)256 * DFE * 2; S.estride = (size_t)1024 * DFE * 2; S.p2t = nullptr; S.rowbytes = 0;
        epi::StoreBf16 E{wsp<bf16>(F, WS_XG), D};
        pg8::gemm_phase(lds, DFE, S, E); } SEAM(17);
    if (IN(18)) {
        for (int b0 = 0; b0 < M / 64; b0 += F.G) { const int blk = b0 + F.vcu;
            if (blk < M / 64) final_stage1(F, blk);
            xcd_barrier(bar);
            if (blk < M / 64) final_stage2(F, blk);
            if (b0 + F.G < M / 64) xcd_barrier(bar); } }
#undef IN
#undef SEAM
}


struct DiagReg { size_t off; int rows, stride, col0, ncols, isf32; float lo, hi; };
struct DiagArgs { DiagReg r[12]; int n; int pad; };
__global__ void diag_count(unsigned char* ws, unsigned* cnt, DiagArgs da) {
    for (int ri = 0; ri < da.n; ++ri) { const DiagReg R = da.r[ri]; const long tot = (long)R.rows * R.ncols; float worst = 0.f;
        for (long i = (long)blockIdx.x * blockDim.x + threadIdx.x; i < tot; i += (long)gridDim.x * blockDim.x) { const long row = i / R.ncols; const int col = (int)(i % R.ncols);
            float v;
            if (R.isf32) v = ((const float*)(ws + R.off))[row * R.stride + R.col0 + col];
            else v = __builtin_bit_cast(float, (unsigned)((const unsigned short*)(ws + R.off))[row * R.stride + R.col0 + col] << 16);
            if (!(v <= R.hi && v >= R.lo)) { float a = fabsf(v); if (!(a < 1e30f)) a = 1e30f; if (a < 1e-30f) a = 1e-30f; worst = fmaxf(worst, a); } }
        if (worst > 0.f) atomicMax(cnt + ri, __float_as_uint(worst)); }
}
__global__ void diag_mark(float* out, unsigned* cnt, DiagArgs da, int total) {
    for (int i = blockIdx.x * blockDim.x + threadIdx.x; i < total; i += gridDim.x * blockDim.x) out[i] = 0.f;
    if (threadIdx.x == 0 && blockIdx.x == 0) { int first = -1; for (int i = da.n - 1; i >= 0; --i) if (cnt[i]) first = i;
        if (first >= 0) { const float w = __uint_as_float(cnt[first]), bound = fmaxf(fabsf(da.r[first].lo), fabsf(da.r[first].hi));
            float m = 1.f + log10f(fmaxf(w / bound, 1.f)) * 0.25f; if (m > 9.5f) m = 9.5f;
            out[0] = sqrtf(1.678e7f * m * powf(10.f, 2.f + first)); } }
}
extern "C" void kernel_launch(void* const* d_in, const int* in_sizes, int n_in, void* d_out, int out_size, void* d_ws, size_t ws_size, hipStream_t stream) {
    static int grid = 0;
    if (grid == 0) {
        if (n_in != 37 || out_size != M * D || ws_size < WS_END) { fprintf(stderr, "kernel_launch: unexpected shapes (n_in %d out %d ws %zu)\n", n_in, out_size, ws_size); grid = -1; return; }
        int dev = 0, cus = 0, per_cu = 0;
        hipGetDevice(&dev); hipDeviceGetAttribute(&cus, hipDeviceAttributeMultiprocessorCount, dev);
        hipFuncSetAttribute((const void*)fwd_kernel, hipFuncAttributeMaxDynamicSharedMemorySize, LDS_BYTES);
        hipOccupancyMaxActiveBlocksPerMultiprocessor(&per_cu, (const void*)fwd_kernel, NTHREADS, LDS_BYTES);
        (void)hipGetLastError();
        grid = cus;
        if (per_cu < 1) fprintf(stderr, "kernel_launch: occupancy query says %d blocks per CU\n", per_cu);
    }
    if (grid < 0) return;
    hipMemsetAsync((char*)d_ws + WS_CTL, 0, CTL_ZERO_BYTES, stream);
    Args a{};
    for (int i = 0; i < 37; ++i) a.in[i] = (const float*)d_in[i];
    a.out = (float*)d_out; a.ws = (unsigned char*)d_ws;
#if MK_N_LAUNCHES == 1
    a.ph_lo = 0; a.ph_hi = N_PHASES;
    hipLaunchKernelGGL(fwd_kernel, dim3(grid), dim3(NTHREADS), LDS_BYTES, stream, a);
#else
    for (int p = 0; p < MK_PH_HI; ++p) { a.ph_lo = p; a.ph_hi = p + 1; hipLaunchKernelGGL(fwd_kernel, dim3(grid), dim3(NTHREADS), LDS_BYTES, stream, a); }
#endif
}
```
